# Optimizing an MI355X kernel written in HIP

```python
import jax, jax.numpy as jnp
from jax import lax
import numpy as np

D_MODEL = 1024
BATCH = 8
SEQ = 2048
DEPTH = 4

MEM_LEN = 256
MIX_WIDTH = D_MODEL
HGRN_WIDTH = MIX_WIDTH // 2
MLSTM_WIDTH = MIX_WIDTH - HGRN_WIDTH
HGRN_HEADS = 4
HGRN_HEAD_DIM = HGRN_WIDTH // HGRN_HEADS
MLSTM_HEADS = 4
MLSTM_HEAD_DIM = MLSTM_WIDTH // MLSTM_HEADS
CONV_WIDTH = 5
XATTN_HEADS = 4
XATTN_HEAD_DIM = D_MODEL // XATTN_HEADS
D_FF = 4 * D_MODEL
CHUNK = 64
NORM_EPS = 1e-6
MLSTM_FGATE_BIAS = 3.0
IN_SPLITS = (HGRN_WIDTH, HGRN_WIDTH, HGRN_WIDTH, HGRN_WIDTH, HGRN_WIDTH,
             MLSTM_WIDTH, MLSTM_WIDTH, MLSTM_WIDTH, MLSTM_WIDTH,
             MLSTM_HEADS, MLSTM_HEADS, MLSTM_HEADS, MLSTM_HEADS)
D_IN = 5 * HGRN_WIDTH + 4 * MLSTM_WIDTH + 4 * MLSTM_HEADS

kernel_name = "bidir_hgrn2_mlstm_hybrid_encoder"


def rmsnorm(x, g):
    x32 = x.astype(jnp.float32)
    y = x32 * lax.rsqrt(jnp.mean(x32 * x32, axis=-1, keepdims=True) + NORM_EPS)
    return (y * g.astype(jnp.float32)).astype(x.dtype)


def head_rmsnorm(h, g, n_heads):
    b, s, w = h.shape
    h32 = h.astype(jnp.float32).reshape(b, s, n_heads, w // n_heads)
    h32 = h32 * lax.rsqrt(jnp.mean(h32 * h32, axis=-1, keepdims=True) + NORM_EPS)
    return (h32.reshape(b, s, w) * g.astype(jnp.float32)).astype(h.dtype)


def split_cols(t, sizes):
    idx = np.cumsum(np.array(sizes))[:-1].tolist()
    return jnp.split(t, idx, axis=-1)


def to_heads(t, n_heads):
    b, s, w = t.shape
    return t.reshape(b, s, n_heads, w // n_heads).transpose(0, 2, 1, 3)


def from_heads(t):
    b, h, s, d = t.shape
    return t.transpose(0, 2, 1, 3).reshape(b, s, h * d)


def to_chunks(t):
    b, h, s = t.shape[:3]
    t = t.reshape(b, h, s // CHUNK, CHUNK, *t.shape[3:])
    return jnp.moveaxis(t, 2, 0)


def from_chunks(t):
    t = jnp.moveaxis(t, 0, 2)
    b, h, n, c = t.shape[:4]
    return t.reshape(b, h, n * c, *t.shape[4:])


def flip_seq(t):
    return jnp.flip(t, axis=2)


def hgrn2_scan(q, k, v, log_f):
    b, h, _, dk = q.shape
    dv = v.shape[-1]
    tril = jnp.tril(jnp.ones((CHUNK, CHUNK), dtype=bool))

    def step(state, xs):
        qc, kc, vc, lfc = xs
        cum = jnp.cumsum(lfc, axis=-2)
        o_inter = jnp.einsum('bhtd,bhde->bhte', qc * jnp.exp(cum), state)
        diff = cum[:, :, :, None, :] - cum[:, :, None, :, :]
        decay = jnp.exp(jnp.where(tril[:, :, None], diff, -jnp.inf))
        scores = jnp.einsum('bhtd,bhsd,bhtsd->bhts', qc, kc, decay)
        o_intra = jnp.einsum('bhts,bhse->bhte', scores, vc)
        cum_last = cum[:, :, -1:, :]
        k_dec = kc * jnp.exp(cum_last - cum)
        state = (jnp.exp(cum_last[:, :, 0, :])[..., None] * state
                 + jnp.einsum('bhsd,bhse->bhde', k_dec, vc))
        return state, o_inter + o_intra

    s0 = jnp.zeros((b, h, dk, dv), jnp.float32)
    xs = tuple(to_chunks(t.astype(jnp.float32)) for t in (q, k, v, log_f))
    _, o = lax.scan(step, s0, xs)
    return from_chunks(o)


def mlstm_scan(q, k, v, ig, log_fg):
    b, h, _, d = q.shape
    tril = jnp.tril(jnp.ones((CHUNK, CHUNK), dtype=bool))

    def step(carry, xs):
        c_st, n_st, m = carry
        qc, kc, vc, igc, lfc = xs
        cum = jnp.cumsum(lfc, axis=-1)
        log_d = cum[..., :, None] - cum[..., None, :] + igc[..., None, :]
        log_d = jnp.where(tril, log_d, -jnp.inf)
        log_inter = cum + m[..., None]
        m_t = jnp.maximum(jnp.max(log_d, axis=-1), log_inter)
        d_mat = jnp.exp(log_d - m_t[..., None])
        w_inter = jnp.exp(log_inter - m_t)
        scores = jnp.einsum('bhtd,bhsd->bhts', qc, kc) * d_mat
        num = (jnp.einsum('bhts,bhse->bhte', scores, vc)
               + w_inter[..., None] * jnp.einsum('bhtd,bhde->bhte', qc, c_st))
        den = jnp.sum(scores, axis=-1) + w_inter * jnp.einsum('bhtd,bhd->bht', qc, n_st)
        h_out = num / jnp.maximum(jnp.abs(den), jnp.exp(-m_t))[..., None]
        cum_last = cum[..., -1]
        log_w = cum_last[..., None] - cum + igc
        m_new = jnp.maximum(cum_last + m, jnp.max(log_w, axis=-1))
        carry_w = jnp.exp(cum_last + m - m_new)
        k_w = kc * jnp.exp(log_w - m_new[..., None])[..., None]
        c_st = carry_w[..., None, None] * c_st + jnp.einsum('bhsd,bhse->bhde', k_w, vc)
        n_st = carry_w[..., None] * n_st + jnp.sum(k_w, axis=-2)
        return (c_st, n_st, m_new), h_out

    init = (jnp.zeros((b, h, d, d), jnp.float32),
            jnp.zeros((b, h, d), jnp.float32),
            jnp.zeros((b, h), jnp.float32))
    xs = tuple(to_chunks(t.astype(jnp.float32)) for t in (q, k, v, ig, log_fg))
    _, hs = lax.scan(step, init, xs)
    return from_chunks(hs)


def layer_lower_bounds(logits):
    p = jax.nn.softmax(logits.astype(jnp.float32), axis=1)
    c = jnp.cumsum(p, axis=1)
    return c - c[:, :1]


def lower_bounded_log_forget(z, lb):
    z = z.astype(jnp.float32)
    return jnp.logaddexp(jnp.log(lb), jnp.log1p(-lb) + jax.nn.log_sigmoid(z))


def centred_dwconv(x, w, b):
    y = lax.conv_general_dilated(
        x, w[:, None, :], window_strides=(1,),
        padding=[(CONV_WIDTH // 2, CONV_WIDTH // 2)],
        dimension_numbers=('NWC', 'WIO', 'NWC'),
        feature_group_count=x.shape[-1])
    return y + b


def token_mixer(xn, w_in, b_in, lb_fwd, lb_bwd, conv_w, conv_b, hgrn_g, mlstm_g, w_out):
    proj = xn @ w_in + b_in
    (h_q, h_f_fwd, h_f_bwd, h_i, h_g,
     m_q, m_k, m_v, m_o,
     m_ig_fwd, m_ig_bwd, m_fg_fwd, m_fg_bwd) = split_cols(proj, IN_SPLITS)

    q_h = to_heads(jax.nn.silu(h_q), HGRN_HEADS)
    v_h = to_heads(h_i, HGRN_HEADS)
    lf_fwd = to_heads(lower_bounded_log_forget(h_f_fwd, lb_fwd), HGRN_HEADS)
    lf_bwd = to_heads(lower_bounded_log_forget(h_f_bwd, lb_bwd), HGRN_HEADS)
    k_fwd = -jnp.expm1(lf_fwd)
    k_bwd = -jnp.expm1(lf_bwd)
    o_h = (hgrn2_scan(q_h, k_fwd, v_h, lf_fwd)
           + flip_seq(hgrn2_scan(flip_seq(q_h), flip_seq(k_bwd), flip_seq(v_h), flip_seq(lf_bwd))))
    hgrn_out = head_rmsnorm(from_heads(o_h).astype(xn.dtype), hgrn_g, HGRN_HEADS) * jax.nn.silu(h_g)

    qk = jax.nn.silu(centred_dwconv(jnp.concatenate([m_q, m_k], axis=-1), conv_w, conv_b))
    m_q, m_k = jnp.split(qk, 2, axis=-1)
    q_m = to_heads(m_q, MLSTM_HEADS)
    k_m = to_heads(m_k, MLSTM_HEADS) * (MLSTM_HEAD_DIM ** -0.5)
    v_m = to_heads(m_v, MLSTM_HEADS)
    ig_fwd = jnp.swapaxes(m_ig_fwd, 1, 2).astype(jnp.float32)
    ig_bwd = jnp.swapaxes(m_ig_bwd, 1, 2).astype(jnp.float32)
    lfg_fwd = jax.nn.log_sigmoid(jnp.swapaxes(m_fg_fwd, 1, 2).astype(jnp.float32))
    lfg_bwd = jax.nn.log_sigmoid(jnp.swapaxes(m_fg_bwd, 1, 2).astype(jnp.float32))
    h_m = (mlstm_scan(q_m, k_m, v_m, ig_fwd, lfg_fwd)
           + flip_seq(mlstm_scan(flip_seq(q_m), flip_seq(k_m), flip_seq(v_m),
                                 flip_seq(ig_bwd), flip_seq(lfg_bwd))))
    mlstm_out = head_rmsnorm(from_heads(h_m).astype(xn.dtype), mlstm_g, MLSTM_HEADS) * jax.nn.sigmoid(m_o)

    return jnp.concatenate([hgrn_out, mlstm_out], axis=-1) @ w_out


def cross_attention(xn, memn, w_q, w_kv, w_o):
    b, s, _ = xn.shape
    q = (xn @ w_q).reshape(b, s, XATTN_HEADS, XATTN_HEAD_DIM)
    k, v = jnp.split(memn @ w_kv, 2, axis=-1)
    k = k.reshape(b, -1, XATTN_HEADS, XATTN_HEAD_DIM)
    v = v.reshape(b, -1, XATTN_HEADS, XATTN_HEAD_DIM)
    scores = jnp.einsum('bqhd,bkhd->bhqk', q, k).astype(jnp.float32) * (XATTN_HEAD_DIM ** -0.5)
    p = jax.nn.softmax(scores, axis=-1).astype(v.dtype)
    o = jnp.einsum('bhqk,bkhd->bqhd', p, v).reshape(b, s, D_MODEL)
    return o @ w_o


def squared_relu_mlp(xn, w_up, w_down):
    return jnp.square(jax.nn.relu(xn @ w_up)) @ w_down


def setup_inputs(seed: int = 0) -> dict:
    key = jax.random.key(seed)
    ks = jax.random.split(key, 20)

    def nrm(k, shape, scale):
        return jax.random.normal(k, shape, jnp.float32) * scale

    def gain(k, shape):
        return 1.0 + 0.05 * jax.random.normal(k, shape, jnp.float32)

    fgate_offset = jnp.concatenate([jnp.zeros((D_IN - 2 * MLSTM_HEADS,), jnp.float32),
                                    jnp.full((2 * MLSTM_HEADS,), MLSTM_FGATE_BIAS, jnp.float32)])
    return {
        "x": nrm(ks[0], (BATCH, SEQ, D_MODEL), 1.0),
        "mem": nrm(ks[1], (BATCH, MEM_LEN, D_MODEL), 1.0),
        "norm_mix": gain(ks[2], (DEPTH, D_MODEL)),
        "norm_xattn": gain(ks[3], (DEPTH, D_MODEL)),
        "norm_mem": gain(ks[4], (DEPTH, D_MODEL)),
        "norm_mlp": gain(ks[5], (DEPTH, D_MODEL)),
        "norm_final": gain(ks[6], (D_MODEL,)),
        "w_in": nrm(ks[7], (DEPTH, D_MODEL, D_IN), D_MODEL ** -0.5),
        "b_in": nrm(ks[8], (DEPTH, D_IN), 0.02) + fgate_offset,
        "hgrn_lb_logits": nrm(ks[9], (2, DEPTH, HGRN_WIDTH), 0.5),
        "hgrn_norm": gain(ks[10], (DEPTH, HGRN_WIDTH)),
        "mlstm_conv_w": nrm(ks[11], (DEPTH, CONV_WIDTH, 2 * MLSTM_WIDTH), CONV_WIDTH ** -0.5),
        "mlstm_conv_b": nrm(ks[12], (DEPTH, 2 * MLSTM_WIDTH), 0.02),
        "mlstm_norm": gain(ks[13], (DEPTH, MLSTM_WIDTH)),
        "w_out": nrm(ks[14], (DEPTH, MIX_WIDTH, D_MODEL), MIX_WIDTH ** -0.5),
        "w_xq": nrm(ks[15], (DEPTH, D_MODEL, D_MODEL), D_MODEL ** -0.5),
        "w_xkv": nrm(ks[16], (DEPTH, D_MODEL, 2 * D_MODEL), D_MODEL ** -0.5),
        "w_xo": nrm(ks[17], (DEPTH, D_MODEL, D_MODEL), D_MODEL ** -0.5),
        "w_up": nrm(ks[18], (DEPTH, D_MODEL, D_FF), D_MODEL ** -0.5),
        "w_down": nrm(ks[19], (DEPTH, D_FF, D_MODEL), D_FF ** -0.5),
    }


def reference(x, mem, norm_mix, norm_xattn, norm_mem, norm_mlp, norm_final, w_in, b_in,
              hgrn_lb_logits, hgrn_norm, mlstm_conv_w, mlstm_conv_b, mlstm_norm, w_out,
              w_xq, w_xkv, w_xo, w_up, w_down):
    lb = layer_lower_bounds(hgrn_lb_logits)
    for l in range(DEPTH):
        x = x + token_mixer(rmsnorm(x, norm_mix[l]), w_in[l], b_in[l], lb[0, l], lb[1, l],
                            mlstm_conv_w[l], mlstm_conv_b[l], hgrn_norm[l], mlstm_norm[l], w_out[l])
        x = x + cross_attention(rmsnorm(x, norm_xattn[l]), rmsnorm(mem, norm_mem[l]),
                                w_xq[l], w_xkv[l], w_xo[l])
        x = x + squared_relu_mlp(rmsnorm(x, norm_mlp[l]), w_up[l], w_down[l])
    return rmsnorm(x, norm_final)
```

```cpp
#include <hip/hip_runtime.h>
#include <cstdio>
#include <cstdint>
namespace pg8 {
#define PG8_LAS __attribute__((address_space(3)))
typedef unsigned short bf16_t;
typedef short bf16x8 __attribute__((ext_vector_type(8)));
typedef float f32x4 __attribute__((ext_vector_type(4)));
typedef float f32x2 __attribute__((ext_vector_type(2)));
typedef unsigned u32x4 __attribute__((ext_vector_type(4)));
constexpr int WCS = 64, BJS = 32;
constexpr int BM = 256, BK = 64, HALF = 128, HTB = HALF * BK * 2  , STAGE_BYTES = 8 * HTB, NXCD = 8, WGM = 8;

__host__ __device__ __forceinline__ int lds_byte(int r, int c) { const int st = (r >> 4) * 2 + (c >> 5), rr = r & 15, cc = c & 31, ob = rr * 64 + cc * 2; return st * 1024 + (ob ^ (((ob >> 9) & 1) << 5)); }
__host__ __device__ __forceinline__ void stage_rc(int b, int& R, int& C) { const int st = b / 1024, sb = b % 1024, swz = sb ^ (((sb >> 9) & 1) << 5); R = (st >> 1) * 16 + swz / 64; C = (st & 1) * 32 + (swz % 64) / 2; }
__host__ __device__ __forceinline__ int perm32(int rho) { const int n = rho >> 4, i = rho & 15; return 8 * (i >> 2) + 4 * n + (i & 3); }

struct Unit { int pm, pn; };
struct Gemm { const bf16_t* A; const bf16_t* Bt; int lda, ldb, K; size_t ajump, am, am8, an3, bn, bm3, bm8; };
__device__ __forceinline__ Gemm plain_gemm(const bf16_t* A, const bf16_t* Bt, int lda, int ldb, int K) { Gemm g; g.A = A; g.Bt = Bt; g.lda = lda; g.ldb = ldb; g.K = K; g.ajump = 0; g.am = (size_t)512 * lda; g.am8 = 0; g.an3 = 0; g.bn = (size_t)512 * ldb; g.bm3 = 0; g.bm8 = 0; return g; }
template <int MODE> __device__ __forceinline__ const char* a_base(const Gemm& g, const Unit& u) { return (const char*)g.A + (size_t)u.pm * g.am + (size_t)(u.pm >> 3) * g.am8 + (size_t)(u.pn & 3) * g.an3; }
template <int MODE> __device__ __forceinline__ const char* b_base(const Gemm& g, const Unit& u) { return (const char*)g.Bt + (size_t)u.pn * g.bn + (size_t)(u.pm & 3) * g.bm3 + (size_t)(u.pm >> 3) * g.bm8; }

struct StaticOrder {
    int nM, nN, nwg, G, c;
    __host__ __device__ void init(int nM_, int nN_, int G_, int c_) { nM = nM_; nN = nN_; nwg = nM * nN; G = G_; c = c_; }
    __host__ __device__ bool next(int i, Unit& u) const {
        const long L = (long)i * G + c; if (L >= nwg) return false;
        int wgid = (int)L; { const int q = nwg / NXCD, r = nwg % NXCD, xcd = wgid % NXCD, off = wgid / NXCD; wgid = (xcd < r ? xcd * (q + 1) : r * (q + 1) + (xcd - r) * q) + off; }
        const int nig = WGM * nN, gid = wgid / nig, fm = gid * WGM, gsz = (nM - fm) < WGM ? (nM - fm) : WGM;
        u.pm = fm + ((wgid % nig) % gsz); u.pn = (wgid % nig) / gsz; return true;
    }
    __device__ __forceinline__ void a_ready(const Unit&) const {}
    __device__ __forceinline__ void done(const Unit&) const {}
};

struct OneUnit { Unit u; bool has;
    __device__ bool next(int i, Unit& o) const { if (i != 0 || !has) return false; o = u; return true; }
    __device__ __forceinline__ void a_ready(const Unit&) const {}
    __device__ __forceinline__ void done(const Unit&) const {}
};

typedef float f32x2_cv __attribute__((ext_vector_type(2)));
typedef __bf16 bf16x2_cv __attribute__((ext_vector_type(2)));
__device__ __forceinline__ unsigned cvt_pk_bf16(float lo, float hi) { const f32x2_cv v = {lo, hi}; const bf16x2_cv b = __builtin_convertvector(v, bf16x2_cv); return __builtin_bit_cast(unsigned, b); }
__device__ __forceinline__ u32x4 pack8(const f32x4 a, const f32x4 b) { u32x4 w; w.x = cvt_pk_bf16(a[0], a[1]); w.y = cvt_pk_bf16(a[2], a[3]); w.z = cvt_pk_bf16(b[0], b[1]); w.w = cvt_pk_bf16(b[2], b[3]); return w; }
constexpr float NORM_EPS = 1e-6f;
__device__ __forceinline__ float sx(float v, int k, int lane) { return __builtin_bit_cast(float, __builtin_amdgcn_ds_bpermute((lane ^ k) << 2, __builtin_bit_cast(int, v))); }
__device__ __forceinline__ float sx_up(float v, int o, int lane) { return __builtin_bit_cast(float, __builtin_amdgcn_ds_bpermute(((lane - o) & 63) << 2, __builtin_bit_cast(int, v))); }
__device__ __forceinline__ float sx_idx(float v, int src) { return __builtin_bit_cast(float, __builtin_amdgcn_ds_bpermute(src << 2, __builtin_bit_cast(int, v))); }
__device__ __forceinline__ float row_rstd(const float* SS, int row, int fq) {
    const f32x4 v = *(const f32x4*)(SS + (size_t)row * 16 + fq * 4);
    const int lane = fq * 16 + (row & 15);
    float s = (v[0] + v[1]) + (v[2] + v[3]); s += sx(s, 16, lane); s += sx(s, 32, lane);
    return __builtin_amdgcn_rsqf(s * (1.0f / 1024.0f) + NORM_EPS);
}
__device__ __forceinline__ void row_rstd8(const float* SS, int row0, int fr, int fq, float (&rs)[8]) {
    f32x4 v[8];
#pragma unroll
    for (int i = 0; i < 8; ++i) v[i] = *(const f32x4*)(SS + (size_t)(row0 + (i >> 2) * HALF + (i & 3) * 16) * 16 + fq * 4);
    const int lane = fq * 16 + fr; float s[8];
#pragma unroll
    for (int i = 0; i < 8; ++i) s[i] = (v[i][0] + v[i][1]) + (v[i][2] + v[i][3]);
#pragma unroll
    for (int i = 0; i < 8; ++i) s[i] += sx(s[i], 16, lane);
#pragma unroll
    for (int i = 0; i < 8; ++i) s[i] += sx(s[i], 32, lane);
#pragma unroll
    for (int i = 0; i < 8; ++i) rs[i] = __builtin_amdgcn_rsqf(s[i] * (1.0f / 1024.0f) + NORM_EPS);
    asm volatile("" : "+v"(rs[0]), "+v"(rs[1]), "+v"(rs[2]), "+v"(rs[3]), "+v"(rs[4]), "+v"(rs[5]), "+v"(rs[6]), "+v"(rs[7]));
    __builtin_amdgcn_sched_barrier(0);
}
__device__ __forceinline__ float logsig(float z) { return fminf(z, 0.f) - __logf(1.0f + __expf(-fabsf(z))); }
__device__ __forceinline__ float sigm(float z) { return __builtin_amdgcn_rcpf(1.0f + __expf(-z)); }

__device__ __forceinline__ f32x4 sel_acc(const f32x4 (&acc)[2][2][4][2], int ai, int bj, int m, int n) {
    f32x4 r = acc[0][bj][0][n];
#pragma unroll
    for (int a = 0; a < 2; ++a)
#pragma unroll
        for (int mm = 0; mm < 4; ++mm) if (a == ai && mm == m) r = acc[a][bj][mm][n];
    return r;
}
constexpr int MTOK = 16384;
constexpr size_t SL_MIB = 1u << 20, SLAB = 53 * (SL_MIB / 2);
constexpr size_t SL_GT = 14 * SL_MIB, SL_LF = SL_GT + SL_MIB / 4, SL_OF = SL_LF + 4 * SL_MIB, SL_OB = SL_OF + 4 * SL_MIB;
struct EpiInProj {
    static constexpr bool PERM = true, AFTER_DRAIN = false;
    const float* SS; const float* bias; const float* lb;
    unsigned char* RB;
    __device__ __forceinline__ void operator()(const f32x4 (&acc)[2][2][4][2], const Unit& u, int wr, int wc, int fr, int fq) const {
        const int seg = u.pn >> 1;
        const int row0 = u.pm * BM + wr * 64 + fr, lrow0 = (u.pm & 7) * BM + wr * 64 + fr;
        unsigned char* const SLB = RB + (size_t)(u.pm >> 3) * SLAB;
        const int cs0 = (u.pn & 1) * 256 + wc * WCS + 8 * fq;
        const int gc0 = u.pn * BM + wc * WCS + 8 * fq;
        if (seg == 9) {
            if (wc != 0) return;
            float rs8[8]; row_rstd8(SS, row0, fr, fq, rs8);
            f32x4 b0 = (f32x4){0.f, 0.f, 0.f, 0.f}, b1 = b0;
            if (fq < 2) { b0 = *(const f32x4*)(bias + gc0); b1 = *(const f32x4*)(bias + gc0 + 4); }
#pragma unroll
            for (int am = 0; am < 8; ++am) { const int ai = am >> 2, m = am & 3; const int lrow = lrow0 + ai * HALF + m * 16; const float rs = rs8[am]; float* const GATES = (float*)(SLB + SL_GT);
                f32x4 v0 = acc[ai][0][m][0] * rs + b0, v1 = acc[ai][0][m][1] * rs + b1;
                if (fq == 1) {
#pragma unroll
                    for (int j = 0; j < 4; ++j) { v0[j] = logsig(v0[j]); v1[j] = logsig(v1[j]); } }
                if (fq < 2) { *(f32x4*)(GATES + (size_t)lrow * 16 + 8 * fq) = v0; *(f32x4*)(GATES + (size_t)lrow * 16 + 8 * fq + 4) = v1; } }
            return;
        }
        f32x4 bv[2][2];
#pragma unroll
        for (int bj = 0; bj < 2; ++bj)
#pragma unroll
            for (int n = 0; n < 2; ++n) bv[bj][n] = *(const f32x4*)(bias + gc0 + bj * BJS + 4 * n);
        float rs8[8];
        if (seg == 1 || seg == 2) {
            f32x4 lv[2][2];
#pragma unroll
            for (int bj = 0; bj < 2; ++bj)
#pragma unroll
                for (int n = 0; n < 2; ++n) lv[bj][n] = *(const f32x4*)(lb + (seg - 1) * 512 + cs0 + bj * BJS + 4 * n);
            unsigned short* LFd = (unsigned short*)(SLB + SL_LF) + (size_t)(seg - 1) * 2048 * 512 + cs0;
            row_rstd8(SS, row0, fr, fq, rs8);
#pragma unroll
            for (int ai = 0; ai < 2; ++ai)
#pragma unroll
                for (int m = 0; m < 4; ++m) { const int row = row0 + ai * HALF + m * 16; const float rs = rs8[ai * 4 + m];
#pragma unroll
                    for (int bj = 0; bj < 2; ++bj) { f32x4 v0 = acc[ai][bj][m][0] * rs + bv[bj][0], v1 = acc[ai][bj][m][1] * rs + bv[bj][1];
#pragma unroll
                        for (int j = 0; j < 4; ++j) { const float a0 = lv[bj][0][j], a1 = lv[bj][1][j];
                            v0[j] = a0 + (1.f - a0) * sigm(fmaxf(v0[j], -80.f)); v1[j] = a1 + (1.f - a1) * sigm(fmaxf(v1[j], -80.f)); }
                        typedef _Float16 h2_t __attribute__((ext_vector_type(2))); u32x4 w;
                        w.x = __builtin_bit_cast(unsigned, (h2_t){(_Float16)v0[0], (_Float16)v0[1]}); w.y = __builtin_bit_cast(unsigned, (h2_t){(_Float16)v0[2], (_Float16)v0[3]});
                        w.z = __builtin_bit_cast(unsigned, (h2_t){(_Float16)v1[0], (_Float16)v1[1]}); w.w = __builtin_bit_cast(unsigned, (h2_t){(_Float16)v1[2], (_Float16)v1[3]});
                        *(u32x4*)(LFd + (size_t)(row - row0 + lrow0) * 512 + bj * BJS) = w; } }
            return;
        }
        const float ca = seg == 0 ? 0.f : 1.f, cb = 0.f, cc = seg == 0 ? 1.f : 0.f;
        bf16_t* dst = (bf16_t*)(SLB + ((size_t)(seg == 0 ? 0 : seg - 2) << 21)) + cs0;
        row_rstd8(SS, row0, fr, fq, rs8);
#pragma unroll
        for (int ai = 0; ai < 2; ++ai)
#pragma unroll
            for (int m = 0; m < 4; ++m) { const int row = row0 + ai * HALF + m * 16; const float rs = rs8[ai * 4 + m];
#pragma unroll
                for (int bj = 0; bj < 2; ++bj) { f32x4 v0 = acc[ai][bj][m][0] * rs + bv[bj][0], v1 = acc[ai][bj][m][1] * rs + bv[bj][1];
                    if (ca == 0.f) {
#pragma unroll
                        for (int j = 0; j < 4; ++j) { const float s0 = sigm(v0[j]), s1 = sigm(v1[j]); v0[j] = v0[j] * (cc * s0) + cb * s0; v1[j] = v1[j] * (cc * s1) + cb * s1; } }
                    *(u32x4*)(dst + (size_t)(row - row0 + lrow0) * 512 + bj * BJS) = pack8(v0, v1); } }
    }
};
struct EpiResid {
    static constexpr bool PERM = true, AFTER_DRAIN = false;
    bf16_t* xb; float* SS;
    __device__ __forceinline__ void operator()(const f32x4 (&acc)[2][2][4][2], const Unit& u, int wr, int wc, int fr, int fq) const {
        const int row0 = u.pm * BM + wr * 64 + fr, col0 = u.pn * BM + wc * WCS + 8 * fq;
        u32x4 xo[2][4][2];
#pragma unroll
        for (int ai = 0; ai < 2; ++ai)
#pragma unroll
            for (int m = 0; m < 4; ++m)
#pragma unroll
                for (int bj = 0; bj < 2; ++bj) xo[ai][m][bj] = *(const u32x4*)(xb + (size_t)(row0 + ai * HALF + m * 16) * 1024 + col0 + bj * BJS);
        __builtin_amdgcn_sched_barrier(0);
        float sq8[8];
#pragma unroll
        for (int ai = 0; ai < 2; ++ai)
#pragma unroll
            for (int m = 0; m < 4; ++m) { const int row = row0 + ai * HALF + m * 16; float sq = 0.f;
#pragma unroll
                for (int bj = 0; bj < 2; ++bj) { const size_t o = (size_t)row * 1024 + col0 + bj * BJS;
                    const u32x4 xw = xo[ai][m][bj];
                    f32x4 a = (f32x4){__builtin_bit_cast(float, xw.x << 16), __builtin_bit_cast(float, xw.x & 0xffff0000u), __builtin_bit_cast(float, xw.y << 16), __builtin_bit_cast(float, xw.y & 0xffff0000u)};
                    f32x4 b = (f32x4){__builtin_bit_cast(float, xw.z << 16), __builtin_bit_cast(float, xw.z & 0xffff0000u), __builtin_bit_cast(float, xw.w << 16), __builtin_bit_cast(float, xw.w & 0xffff0000u)};
                    a = a + acc[ai][bj][m][0]; b = b + acc[ai][bj][m][1];
                    *(u32x4*)(xb + o) = pack8(a, b);
                    sq += (a[0] * a[0] + a[1] * a[1]) + (a[2] * a[2] + a[3] * a[3]) + (b[0] * b[0] + b[1] * b[1]) + (b[2] * b[2] + b[3] * b[3]); }
                sq8[ai * 4 + m] = sq; }
        const int lane = fq * 16 + fr;
#pragma unroll
        for (int i = 0; i < 8; ++i) sq8[i] += sx(sq8[i], 16, lane);
#pragma unroll
        for (int i = 0; i < 8; ++i) sq8[i] += sx(sq8[i], 32, lane);
#pragma unroll
        for (int i = 0; i < 8; ++i) if (fq == 0) SS[(size_t)(row0 + (i >> 2) * HALF + (i & 3) * 16) * 16 + u.pn * 4 + wc] = sq8[i];
    }
};
template <int ACT> struct EpiRowBf16 {
    static constexpr bool PERM = true, AFTER_DRAIN = false;
    const float* SS; bf16_t* O; int ldc; int bshift; size_t corr;
    __device__ __forceinline__ void operator()(const f32x4 (&acc)[2][2][4][2], const Unit& u, int wr, int wc, int fr, int fq) const {
        const int row0 = u.pm * BM + wr * 64 + fr, col0 = u.pn * BM + wc * WCS + 8 * fq;
        float rs8[8]; if (ACT != 2) row_rstd8(SS, row0, fr, fq, rs8);
#pragma unroll
        for (int ai = 0; ai < 2; ++ai)
#pragma unroll
            for (int m = 0; m < 4; ++m) { const int row = row0 + ai * HALF + m * 16; const float rs = ACT == 2 ? 1.f : rs8[ai * 4 + m];
#pragma unroll
                for (int bj = 0; bj < 2; ++bj) { f32x4 v0 = acc[ai][bj][m][0] * rs, v1 = acc[ai][bj][m][1] * rs;
                    if (ACT == 1) {
#pragma unroll
                        for (int j = 0; j < 4; ++j) { const float t0 = fmaxf(v0[j], 0.f), t1 = fmaxf(v1[j], 0.f); v0[j] = t0 * t0; v1[j] = t1 * t1; } }
                    *(u32x4*)(O + (size_t)row * ldc + (size_t)(u.pm >> bshift) * corr + col0 + bj * BJS) = pack8(v0, v1); } }
    }
};
struct EpiKV {
    static constexpr bool PERM = true, AFTER_DRAIN = false;
    bf16_t* OK; bf16_t* OV;
    __device__ __forceinline__ void operator()(const f32x4 (&acc)[2][2][4][2], const Unit& u, int wr, int wc, int fr, int fq) const {
        const int pn = u.pn & 15; const int tile = ((pn >> 2) * 8 + u.pm) * 4 + (pn & 3);
        bf16_t* base = (u.pn >= 16 ? OV : OK) + (size_t)tile * 65536; const int r0 = wr * 64 + fr, c0 = wc * WCS + 8 * fq;
#pragma unroll
        for (int ai = 0; ai < 2; ++ai)
#pragma unroll
            for (int m = 0; m < 4; ++m)
#pragma unroll
                for (int bj = 0; bj < 2; ++bj) *(u32x4*)(base + (size_t)(r0 + ai * HALF + m * 16) * 256 + c0 + bj * BJS) = pack8(acc[ai][bj][m][0], acc[ai][bj][m][1]);
    }
};
struct EpiNt {
    static constexpr bool PERM = true, AFTER_DRAIN = false;
    bf16_t* O;
    __device__ __forceinline__ void operator()(const f32x4 (&acc)[2][2][4][2], const Unit& u, int wr, int wc, int fr, int fq) const {
        bf16_t* base = O + (size_t)(u.pn >> 2) * (SLAB / 2) + (size_t)u.pm * 256 * 1024 + (u.pn & 3) * 256; const int r0 = wr * 64 + fr, c0 = wc * WCS + 8 * fq;
#pragma unroll
        for (int ai = 0; ai < 2; ++ai)
#pragma unroll
            for (int m = 0; m < 4; ++m)
#pragma unroll
                for (int bj = 0; bj < 2; ++bj) *(u32x4*)(base + (size_t)(r0 + ai * HALF + m * 16) * 1024 + c0 + bj * BJS) = pack8(acc[ai][bj][m][0], acc[ai][bj][m][1]);
    }
};
struct EpiSoftmax {
    static constexpr bool PERM = true, AFTER_DRAIN = true;
    const float* SS; bf16_t* P;
    __device__ __forceinline__ void fused(f32x4 (&acc)[2][2][4][2], const Unit& u, int wr, int wc, int fr, int fq, PG8_LAS unsigned char* lds, int wid, int lane) const {
        PG8_LAS f32x2* T = (PG8_LAS f32x2*)lds;
        float rs8[8]; row_rstd8(SS, u.pm * BM + wr * 64 + fr, fr, fq, rs8);
#pragma unroll
        for (int ai = 0; ai < 2; ++ai)
#pragma unroll
            for (int m = 0; m < 4; ++m) { const float rs = rs8[ai * 4 + m];
#pragma unroll
                for (int bj = 0; bj < 2; ++bj)
#pragma unroll
                    for (int n = 0; n < 2; ++n) acc[ai][bj][m][n] = acc[ai][bj][m][n] * rs;
                float mx = -3.0e38f;
#pragma unroll
                for (int bj = 0; bj < 2; ++bj)
#pragma unroll
                    for (int n = 0; n < 2; ++n) { const f32x4 x = acc[ai][bj][m][n]; mx = fmaxf(mx, fmaxf(fmaxf(x[0], x[1]), fmaxf(x[2], x[3]))); }
                mx = fmaxf(mx, sx(mx, 16, lane)); mx = fmaxf(mx, sx(mx, 32, lane));
                float s = 0.f;
#pragma unroll
                for (int bj = 0; bj < 2; ++bj)
#pragma unroll
                    for (int n = 0; n < 2; ++n) { const f32x4 x = acc[ai][bj][m][n]; s += (__expf(x[0] - mx) + __expf(x[1] - mx)) + (__expf(x[2] - mx) + __expf(x[3] - mx)); }
                s += sx(s, 16, lane); s += sx(s, 32, lane);
                if (fq == 0) T[(ai * HALF + wr * 64 + m * 16 + fr) * 4 + wc] = (f32x2){mx, s}; }
        asm volatile("s_waitcnt lgkmcnt(0)" ::: "memory"); __builtin_amdgcn_s_barrier(); asm volatile("" ::: "memory");
        const int row0 = u.pm * BM + wr * 64 + fr, col0 = u.pn * BM + wc * WCS + 8 * fq;
#pragma unroll
        for (int ai = 0; ai < 2; ++ai)
#pragma unroll
            for (int m = 0; m < 4; ++m) { const int r = ai * HALF + wr * 64 + m * 16 + fr;
                const f32x2 t0 = T[r * 4 + 0], t1 = T[r * 4 + 1], t2 = T[r * 4 + 2], t3 = T[r * 4 + 3];
                const float M = fmaxf(fmaxf(t0.x, t1.x), fmaxf(t2.x, t3.x));
                const float L = (t0.y * __expf(t0.x - M) + t1.y * __expf(t1.x - M)) + (t2.y * __expf(t2.x - M) + t3.y * __expf(t3.x - M));
                const float inv = __builtin_amdgcn_rcpf(L);
#pragma unroll
                for (int bj = 0; bj < 2; ++bj) { f32x4 v0 = acc[ai][bj][m][0], v1 = acc[ai][bj][m][1];
#pragma unroll
                    for (int j = 0; j < 4; ++j) { v0[j] = __expf(v0[j] - M) * inv; v1[j] = __expf(v1[j] - M) * inv; }
                    *(u32x4*)(P + (size_t)(u.pm >> 3) * ((SLAB - 4 * SL_MIB) / 2) + (size_t)(row0 + ai * HALF + m * 16) * 1024 + col0 + bj * BJS) = pack8(v0, v1); } }
    }
};

template <class Epi, class Sched, bool ALIGN_EPI, bool SP2, int MODE>
__device__ __forceinline__ void gemm_phase(PG8_LAS unsigned char* lds, const Gemm g, const Sched& S, const Epi& E, const int tid) {
    const int wid = __builtin_amdgcn_readfirstlane(tid >> 6), lane = tid & 63, wr = wid >> 2, wc = wid & 3, fr = lane & 15, fq = lane >> 4;
    const int K = g.K, nt = K / BK;
    unsigned voffA[2], voffB[2];
#pragma unroll
    for (int i = 0; i < 2; ++i) { int R, C; stage_rc(tid * 16 + i * 8192, R, C); const int Rb = Epi::PERM ? ((R >> 5) * WCS + perm32(R & 31)) : R;
        voffA[i] = (unsigned)(R * g.lda + C) * 2u; voffB[i] = (unsigned)(Rb * g.ldb + C) * 2u; }
    const size_t kstep = (size_t)(BK * 2);
    const size_t hstepA = (size_t)HALF * g.lda * 2, hstepB = (size_t)(Epi::PERM ? BJS : HALF) * g.ldb * 2;
    const unsigned ldsw = (unsigned)wid * 1024u;
    const int aoff = lds_byte(wr * 64 + fr, fq * 8), boff = lds_byte(wc * 32 + fr, fq * 8);
#define PG8_SA(b, h) (((b) * 2 + (h)) * HTB)
#define PG8_SB(b, h) ((4 + (b) * 2 + (h)) * HTB)
#define PG8_STAGE(bufoff, gbase, voff) do { _Pragma("unroll") for (int _i = 0; _i < 2; ++_i) \
        __builtin_amdgcn_global_load_lds((const unsigned*)((const char*)(gbase) + (voff)[_i]), (PG8_LAS unsigned*)(lds + (bufoff) + ldsw + _i * 8192), 16, 0, 0); } while (0)
#define PG8_LDA(dst, b, h) do { _Pragma("unroll") for (int m = 0; m < 4; ++m) _Pragma("unroll") for (int k = 0; k < 2; ++k) dst[m][k] = *(const PG8_LAS bf16x8*)(lds + PG8_SA(b, h) + aoff + m * 2048 + k * 1024); } while (0)
#define PG8_LDB(dst, b, h) do { _Pragma("unroll") for (int n = 0; n < 2; ++n) _Pragma("unroll") for (int k = 0; k < 2; ++k) dst[n][k] = *(const PG8_LAS bf16x8*)(lds + PG8_SB(b, h) + boff + n * 2048 + k * 1024); } while (0)
#define PG8_MMA(ai, bj, At, Bt) do { __builtin_amdgcn_s_setprio(1); _Pragma("unroll") for (int m = 0; m < 4; ++m) _Pragma("unroll") for (int n = 0; n < 2; ++n) _Pragma("unroll") for (int k = 0; k < 2; ++k) \
        acc[ai][bj][m][n] = __builtin_amdgcn_mfma_f32_16x16x32_bf16(Bt[n][k], At[m][k], acc[ai][bj][m][n], 0, 0, 0); __builtin_amdgcn_s_setprio(0); } while (0)
#define PG8_WAIT_V(n) asm volatile("s_waitcnt vmcnt(" #n ")" ::: "memory")
#define PG8_WAIT_L(n) asm volatile("s_waitcnt lgkmcnt(" #n ")" ::: "memory")
#define PG8_BAR __builtin_amdgcn_s_barrier()
#define PG8_SCHED __builtin_amdgcn_sched_barrier(0)
    Unit cur, nxt; int ui = 0;
    if (!S.next(0, cur)) return;
    f32x4 acc[2][2][4][2];
#pragma unroll
    for (int a = 0; a < 2; ++a)
#pragma unroll
        for (int b = 0; b < 2; ++b)
#pragma unroll
            for (int m = 0; m < 4; ++m)
#pragma unroll
                for (int n = 0; n < 2; ++n) acc[a][b][m][n] = (f32x4){0.f, 0.f, 0.f, 0.f};
    bf16x8 At[4][2], B0[2][2], B1[2][2];
    const char* cA = a_base<MODE>(g, cur); const char* cB = b_base<MODE>(g, cur);
    S.a_ready(cur);
    if constexpr (SP2) {
        PG8_STAGE(PG8_SB(0, 0), cB, voffB); PG8_STAGE(PG8_SB(0, 1), cB + hstepB, voffB); PG8_STAGE(PG8_SA(0, 0), cA, voffA); PG8_STAGE(PG8_SA(0, 1), cA + hstepA, voffA);
        if (wr == 1) PG8_BAR;
        PG8_WAIT_V(2); PG8_BAR;
        PG8_STAGE(PG8_SB(1, 0), cB + kstep, voffB); PG8_STAGE(PG8_SA(1, 0), cA + kstep, voffA); PG8_STAGE(PG8_SB(1, 1), cB + hstepB + kstep, voffB);
        PG8_WAIT_V(6); PG8_BAR;
    } else {
        PG8_STAGE(PG8_SB(0, 0), cB, voffB); PG8_STAGE(PG8_SA(0, 0), cA, voffA); PG8_STAGE(PG8_SB(0, 1), cB + hstepB, voffB); PG8_STAGE(PG8_SA(0, 1), cA + hstepA, voffA);
        if (wr == 1) PG8_BAR;
        PG8_WAIT_V(4); PG8_BAR;
        PG8_STAGE(PG8_SB(1, 0), cB + kstep, voffB); PG8_STAGE(PG8_SA(1, 0), cA + kstep, voffA); PG8_STAGE(PG8_SB(1, 1), cB + hstepB + kstep, voffB);
        PG8_WAIT_V(6); PG8_BAR;
    }
    for (;;) {
        const bool has_next = S.next(ui + 1, nxt);
        const char* nA = has_next ? a_base<MODE>(g, nxt) : cA; const char* nB = has_next ? b_base<MODE>(g, nxt) : cB;
        for (int t = 0; t < nt; t += 2) {
            const bool last = (t == nt - 2);
            const char* a1 = cA + (size_t)(t + 1) * kstep + ((MODE == 2 && t + 1 >= 8) ? g.ajump : (size_t)0);
            const char* a2 = last ? nA : cA + (size_t)(t + 2) * kstep + ((MODE == 2 && t + 2 >= 8) ? g.ajump : (size_t)0); const char* b2 = last ? nB : cB + (size_t)(t + 2) * kstep;
            const char* a3 = (MODE == 2 && !last) ? cA + (size_t)(t + 3) * kstep + ((t + 3 >= 8) ? g.ajump : (size_t)0) : a2 + kstep; const char* b3 = b2 + kstep;
            if (last && has_next) S.a_ready(nxt);
            if constexpr (SP2) {
            PG8_LDB(B0, 0, 0); PG8_LDB(B1, 0, 1); PG8_SCHED; PG8_LDA(At, 0, 0); PG8_STAGE(PG8_SA(1, 1), a1 + hstepA, voffA);
            PG8_WAIT_V(8); PG8_WAIT_L(0); PG8_BAR; PG8_MMA(0, 0, At, B0); PG8_MMA(0, 1, At, B1); PG8_BAR; PG8_SCHED;
            PG8_LDA(At, 0, 1); PG8_STAGE(PG8_SB(0, 0), b2, voffB); PG8_STAGE(PG8_SB(0, 1), b2 + hstepB, voffB); PG8_STAGE(PG8_SA(0, 0), a2, voffA);
            PG8_WAIT_V(8); PG8_WAIT_L(0); PG8_BAR; PG8_MMA(1, 0, At, B0); PG8_MMA(1, 1, At, B1); PG8_BAR; PG8_SCHED;
            PG8_LDB(B0, 1, 0); PG8_LDB(B1, 1, 1); PG8_SCHED; PG8_LDA(At, 1, 0); PG8_STAGE(PG8_SA(0, 1), a2 + hstepA, voffA);
            PG8_WAIT_V(8); PG8_WAIT_L(0); PG8_BAR; PG8_MMA(0, 0, At, B0); PG8_MMA(0, 1, At, B1); PG8_BAR; PG8_SCHED;
            PG8_LDA(At, 1, 1); PG8_STAGE(PG8_SB(1, 0), b3, voffB); PG8_STAGE(PG8_SB(1, 1), b3 + hstepB, voffB); PG8_STAGE(PG8_SA(1, 0), a3, voffA);
            PG8_WAIT_V(8); PG8_WAIT_L(0); PG8_BAR; PG8_MMA(1, 0, At, B0); PG8_MMA(1, 1, At, B1); PG8_BAR; PG8_SCHED;
            } else {
            PG8_LDB(B0, 0, 0); PG8_SCHED; PG8_LDA(At, 0, 0); PG8_STAGE(PG8_SA(1, 1), a1 + hstepA, voffA);
            PG8_WAIT_L(8); PG8_BAR; PG8_WAIT_L(0); PG8_MMA(0, 0, At, B0); PG8_BAR; PG8_SCHED;
            PG8_LDB(B1, 0, 1); PG8_STAGE(PG8_SB(0, 0), b2, voffB);
            PG8_BAR; PG8_WAIT_L(0); PG8_MMA(0, 1, At, B1); PG8_BAR;
            PG8_LDA(At, 0, 1); PG8_STAGE(PG8_SA(0, 0), a2, voffA);
            PG8_BAR; PG8_WAIT_L(0); PG8_MMA(1, 0, At, B0); PG8_BAR; PG8_SCHED;
            PG8_STAGE(PG8_SB(0, 1), b2 + hstepB, voffB);
            PG8_WAIT_V(6); PG8_BAR; PG8_MMA(1, 1, At, B1); PG8_BAR;
            PG8_LDB(B0, 1, 0); PG8_SCHED; PG8_LDA(At, 1, 0); PG8_STAGE(PG8_SA(0, 1), a2 + hstepA, voffA);
            PG8_WAIT_L(8); PG8_BAR; PG8_WAIT_L(0); PG8_MMA(0, 0, At, B0); PG8_BAR; PG8_SCHED;
            PG8_LDB(B1, 1, 1); PG8_STAGE(PG8_SB(1, 0), b3, voffB);
            PG8_BAR; PG8_WAIT_L(0); PG8_MMA(0, 1, At, B1); PG8_BAR;
            PG8_LDA(At, 1, 1); PG8_STAGE(PG8_SA(1, 0), a3, voffA);
            PG8_BAR; PG8_WAIT_L(0); PG8_MMA(1, 0, At, B0); PG8_BAR; PG8_SCHED;
            PG8_STAGE(PG8_SB(1, 1), b3 + hstepB, voffB);
            PG8_WAIT_V(6); PG8_BAR; PG8_MMA(1, 1, At, B1); PG8_BAR;
            }
        }
        if constexpr (ALIGN_EPI) { if (wr == 0) PG8_BAR; }
        if constexpr (!Epi::AFTER_DRAIN) { int l2; asm volatile("v_mbcnt_lo_u32_b32 %0, -1, 0\n\tv_mbcnt_hi_u32_b32 %0, -1, %0" : "=v"(l2));
            E(acc, cur, wr, wc, l2 & 15, l2 >> 4); S.done(cur); }
        if (!has_next) break;
#pragma unroll
        for (int a = 0; a < 2; ++a)
#pragma unroll
            for (int b = 0; b < 2; ++b)
#pragma unroll
                for (int m = 0; m < 4; ++m)
#pragma unroll
                    for (int n = 0; n < 2; ++n) acc[a][b][m][n] = (f32x4){0.f, 0.f, 0.f, 0.f};
        cur = nxt; cA = nA; cB = nB; ++ui;
        if constexpr (ALIGN_EPI) { if (wr == 1) PG8_BAR; }
    }
    PG8_WAIT_V(0);
    if constexpr (!ALIGN_EPI) { if (wr == 0) PG8_BAR; }
    PG8_BAR;
    if constexpr (Epi::AFTER_DRAIN) { int l2; asm volatile("v_mbcnt_lo_u32_b32 %0, -1, 0\n\tv_mbcnt_hi_u32_b32 %0, -1, %0" : "=v"(l2)); E.fused(acc, cur, wr, wc, l2 & 15, l2 >> 4, lds, wid, l2); S.done(cur); }
#undef PG8_SA
#undef PG8_SB
#undef PG8_STAGE
#undef PG8_LDA
#undef PG8_LDB
#undef PG8_MMA
#undef PG8_WAIT_V
#undef PG8_WAIT_L
#undef PG8_BAR
#undef PG8_SCHED
}
}

constexpr int NWAVES = 8, NTHREADS = 512;
constexpr int DM = 1024, NB = 8, SEQ = 2048, DEPTH = 4, MEMLEN = 256, DIN = 4624, DINP = 4864, DFF = 4096;
constexpr int M = NB * SEQ;
constexpr int MMEM = NB * MEMLEN;

constexpr size_t MiB = 1u << 20;
constexpr size_t WS_CTL = 0, CTL_ZERO_BYTES = 1 * MiB;
constexpr size_t WS_SS = 2 * MiB;
constexpr size_t WS_LB = 3 * MiB;
constexpr size_t WS_W = 4 * MiB;
constexpr size_t WO_IN = 0, WO_OUT = 10 * MiB, WO_XQ = 12 * MiB, WO_XO = 14 * MiB, WO_UP = 16 * MiB, WO_DOWN = 24 * MiB;
constexpr size_t WS_KX = 36 * MiB, WS_VT = 52 * MiB;
constexpr size_t WS_XB = 68 * MiB;
constexpr size_t WS_R = 100 * MiB;
constexpr size_t SLAB = pg8::SLAB;
constexpr size_t S_QH = 0, S_VH = 2 * MiB, S_GG = 4 * MiB, S_MQ = 6 * MiB, S_MK = 8 * MiB, S_MV = 10 * MiB, S_MO = 12 * MiB,
                 S_GT = pg8::SL_GT, S_LF = pg8::SL_LF, S_OF = pg8::SL_OF, S_OB = pg8::SL_OB;
constexpr size_t S_P = 0, S_MT = S_MQ, S_NT = S_MK;
constexpr size_t S_H = 0;
constexpr size_t R_END = 8 * SLAB;
constexpr size_t OT_MEMB = 32 * MiB, OT_WKT = 36 * MiB, OT_WVT = 44 * MiB;
constexpr size_t WS_W2 = WS_R + R_END;
constexpr size_t WS_END = WS_W2 + 32 * MiB;
constexpr int CW_BAR = 4096;
constexpr int RING_BYTES = 131072, LDSCTL_OFF = 161792, MISC_OFF = LDSCTL_OFF + 320, LDS_BYTES = 163840;

#define GAS __attribute__((address_space(1)))
#define LAS __attribute__((address_space(3)))
typedef unsigned short bf16;
typedef unsigned v4u __attribute__((ext_vector_type(4)));
typedef float f32x4 __attribute__((ext_vector_type(4)));
#define LDS_WAIT() asm volatile("s_waitcnt lgkmcnt(0)" ::: "memory")
#define VM_WAIT() asm volatile("s_waitcnt vmcnt(0)" ::: "memory")
__device__ __forceinline__ unsigned f2bf(float f) { unsigned u = __builtin_bit_cast(unsigned, f); return (u + 0x7fffu + ((u >> 16) & 1u)) >> 16; }
__device__ __forceinline__ unsigned pk2(float lo, float hi) { return f2bf(lo) | (f2bf(hi) << 16); }
__device__ __forceinline__ float bf2f(unsigned short b) { return __builtin_bit_cast(float, (unsigned)b << 16); }
__device__ __forceinline__ float bflo(unsigned w) { return __builtin_bit_cast(float, w << 16); }
__device__ __forceinline__ float bfhi(unsigned w) { return __builtin_bit_cast(float, w & 0xffff0000u); }

#define XB_TMO      128
#define XB_XCNT(j)  (256  + 64 * (j))
#define XB_XSUB(j)  (1280 + 64 * (j))
#define XB_XGEN(j)  (2304 + 64 * (j))
#define XB_TOP      3328
#define XB_TOPGEN   3392
#define XCD_BAR_WORDS 3456
#define XB_LFLAG(j) (3456 + 64 * (j))
#define XB_SPIN_CAP (1u << 18)

__device__ __forceinline__ unsigned xb_ld(unsigned* p)              { return __hip_atomic_load(p, __ATOMIC_RELAXED, __HIP_MEMORY_SCOPE_AGENT); }
__device__ __forceinline__ unsigned xb_add(unsigned* p, unsigned v) { return __hip_atomic_fetch_add(p, v, __ATOMIC_RELAXED, __HIP_MEMORY_SCOPE_AGENT); }
__device__ __forceinline__ unsigned xb_xcc_id() { return (unsigned)__builtin_amdgcn_s_getreg((3 << 11) | 20) & 0xFu; }
#define XB_SPIN(cond, bar) do { unsigned _sp = 0; while (cond) { __builtin_amdgcn_s_sleep(1); \
    if ((++_sp & 255u) == 0u) { if (xb_ld(&(bar)[XB_TMO])) break; if (_sp > XB_SPIN_CAP) { atomicAdd(&(bar)[XB_TMO], 1u); break; } } } } while (0)

struct XcdBarrier {
    unsigned* bar; unsigned x;
    volatile LAS unsigned* st;
};

__device__ __forceinline__ XcdBarrier xcd_barrier_post(unsigned* bar, volatile LAS unsigned* st, int tid) {
    XcdBarrier b; b.bar = bar; b.x = xb_xcc_id(); b.st = st;
    if (tid == 0) st[3] = xb_add(&bar[XB_XCNT(b.x)], 1u);
    return b;
}
__device__ __forceinline__ void xcd_barrier_complete(unsigned* bar, unsigned x, unsigned& nloc, unsigned& nx, unsigned& uni) {
    const unsigned G = gridDim.x * gridDim.y * gridDim.z;
    unsigned sum, cnt, mine, sp = 0u;
    for (;;) {
        sum = 0u; cnt = 0u; mine = 0u; uni = 1u;
#pragma unroll
        for (unsigned j = 0; j < 16; ++j) { const unsigned c = xb_ld(&bar[XB_XCNT(j)]); sum += c; cnt += (c > 0u) ? 1u : 0u; mine = (j == x) ? c : mine; uni &= (c == (j < 8u ? 32u : 0u)) ? 1u : 0u; }
        if (sum == G) break;
        __builtin_amdgcn_s_sleep(1);
        if ((++sp & 255u) == 0u) { if (xb_ld(&bar[XB_TMO])) break; if (sp > XB_SPIN_CAP) { atomicAdd(&bar[XB_TMO], 1u); break; } }
    }
    nloc = mine > 0u ? mine : 1u; nx = cnt > 0u ? cnt : 1u; if (sum != G || G != 256u) uni = 0u;
}

template <bool LOCAL> __device__ __forceinline__ void xcd_barrier(const XcdBarrier& b, int tid) {
    if (LOCAL) {
        asm volatile("s_waitcnt vmcnt(0)" ::: "memory");
        __syncthreads();
        if (tid < 64) {
            unsigned* fl = b.bar + XB_LFLAG(b.x);
            const unsigned n = __builtin_amdgcn_readfirstlane(b.st[4]) + 1u;
            if (tid == 0) { b.st[4] = n; __hip_atomic_store(fl + b.st[3], n, __ATOMIC_RELAXED, __HIP_MEMORY_SCOPE_WORKGROUP); }
            unsigned sp = 0u;
            for (;;) { const unsigned v = tid < 32 ? xb_ld(fl + tid) : n;
                if (__builtin_amdgcn_ballot_w64(v < n) == 0ull) break;
                __builtin_amdgcn_s_sleep(1);
                if ((++sp & 255u) == 0u) { if (xb_ld(&b.bar[XB_TMO])) break; if (sp > XB_SPIN_CAP) { if (tid == 0) atomicAdd(&b.bar[XB_TMO], 1u); break; } } }
            __builtin_amdgcn_fence(__ATOMIC_ACQUIRE, "agent");
            asm volatile("s_waitcnt vmcnt(0)" ::: "memory");
        }
        __syncthreads();
        return;
    }
    asm volatile("s_waitcnt vmcnt(0)" ::: "memory");
    __syncthreads();
    if (tid == 0) {
        unsigned* bar = b.bar;
        __builtin_amdgcn_s_waitcnt(0);
        unsigned nloc = b.st[0], nx = b.st[1];
        if (nloc == 0u) { unsigned uni_; xcd_barrier_complete(bar, b.x, nloc, nx, uni_); b.st[0] = nloc; b.st[1] = nx; b.st[2] = uni_; }
        const unsigned old = xb_add(&bar[XB_XSUB(b.x)], 1u);
        const unsigned gen = old / nloc;
        if (old + 1u == (gen + 1u) * nloc) {
            __builtin_amdgcn_fence(__ATOMIC_RELEASE, "agent");
            asm volatile("s_waitcnt vmcnt(0)" ::: "memory");
            const unsigned og = xb_add(&bar[XB_TOP], 1u);
            const unsigned tg = og / nx;
            if (og + 1u == (tg + 1u) * nx) xb_add(&bar[XB_TOPGEN], 1u);
            else XB_SPIN(xb_ld(&bar[XB_TOPGEN]) == tg, bar);
            __builtin_amdgcn_fence(__ATOMIC_ACQUIRE, "agent");
            xb_add(&bar[XB_XGEN(b.x)], 1u);
            asm volatile("s_waitcnt vmcnt(0)" ::: "memory");
        } else {
            XB_SPIN(xb_ld(&bar[XB_XGEN(b.x)]) == gen, bar);
            __builtin_amdgcn_fence(__ATOMIC_ACQUIRE, "agent");
            asm volatile("s_waitcnt vmcnt(0)" ::: "memory");
        }
    }
    __syncthreads();
}

struct Args { const float* in[20]; float* out; unsigned char* ws; };
typedef const __attribute__((address_space(4))) Args* KArgs;
__device__ __forceinline__ KArgs fresh_args() { KArgs p = (KArgs)__builtin_amdgcn_kernarg_segment_ptr(); asm volatile("" : "+s"(p)); return p; }
__device__ __forceinline__ int fresh_tid(int wave_s) { int t; asm volatile("v_mbcnt_lo_u32_b32 %0, -1, 0\n\tv_mbcnt_hi_u32_b32 %0, -1, %0" : "=v"(t)); return (wave_s << 6) | t; }
enum { I_X = 0, I_MEM, I_NMIX, I_NXATTN, I_NMEM, I_NMLP, I_NFINAL, I_WIN, I_BIN, I_LBLOG, I_HNORM, I_CONVW, I_CONVB, I_MNORM, I_WOUT, I_WXQ, I_WXKV, I_WXO, I_WUP, I_WDOWN };

__device__ __forceinline__ float wave_sum(float v, int lane) {
#pragma unroll
    for (int o = 1; o < 64; o <<= 1) v += pg8::sx(v, o, lane);
    return v;
}
__device__ __forceinline__ void transpose_item(const float* W, int ldw, int nvalid, bf16* WT, int ldt, const float* g, float scale, float* scr, int item, int nblk, int lane) {
    const int kb = item / nblk, nb = item % nblk, k0 = 64 * kb, n0 = 32 * nb; const int n = n0 + (lane & 31);
    float vv_[32];
    const bool ok_ = n < nvalid; const float* wp_ = W + (size_t)(k0 + (lane >> 5)) * ldw + (ok_ ? n : 0);
#pragma unroll
    for (int i = 0; i < 32; ++i) vv_[i] = wp_[(size_t)(2 * i) * ldw];
#pragma unroll
    for (int i = 0; i < 32; ++i) { const int kk = 2 * i + (lane >> 5); float v = ok_ ? vv_[i] * scale : 0.f; if (g) v *= g[k0 + kk];
        scr[kk * 33 + (lane & 31)] = v; }
    LDS_WAIT(); asm volatile("" ::: "memory");
    const int c = lane & 7;
#pragma unroll
    for (int j = 0; j < 4; ++j) { const int nn = (lane >> 3) + 8 * j; const float* s = scr + (8 * c) * 33 + nn;
        v4u o; o.x = pk2(s[0 * 33], s[1 * 33]); o.y = pk2(s[2 * 33], s[3 * 33]); o.z = pk2(s[4 * 33], s[5 * 33]); o.w = pk2(s[6 * 33], s[7 * 33]);
        *(v4u*)(WT + (size_t)(n0 + nn) * ldt + k0 + 8 * c) = o; }
    LDS_WAIT(); asm volatile("" ::: "memory");
}
__device__ __forceinline__ void convert_layer(KArgs a, int l, unsigned char* lds, int gw, int ngw, int wave, int lane) {
    float* scr = (float*)(lds + wave * 16384);
    bf16* W = (bf16*)(a->ws + ((l & 1) ? WS_W2 : WS_W));
    constexpr int I_A = 16 * (DINP / 32), I_B = 16 * 32, I_U = 16 * (DFF / 32), I_D = 64 * 32;
    constexpr int NIT = I_A + 2 * I_B + I_U + I_D;
    for (int it = gw; it < NIT; it += ngw) {
        int r = it;
        if (r < I_A) { transpose_item(a->in[I_WIN] + (size_t)l * DM * DIN, DIN, DIN, W + WO_IN / 2, DM, a->in[I_NMIX] + l * DM, 1.f, scr, r, DINP / 32, lane); continue; } r -= I_A;
        if (r < I_B) { transpose_item(a->in[I_WOUT] + (size_t)l * DM * DM, DM, DM, W + WO_OUT / 2, DM, nullptr, 1.f, scr, r, 32, lane); continue; } r -= I_B;
        if (r < I_B) { transpose_item(a->in[I_WXO] + (size_t)l * DM * DM, DM, DM, W + WO_XO / 2, DM, nullptr, 1.f, scr, r, 32, lane); continue; } r -= I_B;
        if (r < I_U) { transpose_item(a->in[I_WUP] + (size_t)l * DM * DFF, DFF, DFF, W + WO_UP / 2, DM, a->in[I_NMLP] + l * DM, 1.f, scr, r, DFF / 32, lane); continue; } r -= I_U;
        transpose_item(a->in[I_WDOWN] + (size_t)l * DFF * DM, DM, DM, W + WO_DOWN / 2, DFF, nullptr, 1.f, scr, r, 32, lane);
    }
    { const float* Wq = a->in[I_WXQ] + (size_t)l * DM * DM; const float* gq = a->in[I_NXATTN] + l * DM; bf16* O = W + WO_XQ / 2;
      for (int k = gw; k < DM; k += ngw) { const f32x4* xr = (const f32x4*)(Wq + (size_t)k * DM) + lane; const float sc = gq[k] * 0.0625f; unsigned long long* o8 = (unsigned long long*)(O + (size_t)k * DM) + lane;
#pragma unroll
          for (int j = 0; j < 4; ++j) { const f32x4 v = xr[64 * j] * sc; o8[64 * j] = (unsigned long long)pk2(v[0], v[1]) | ((unsigned long long)pk2(v[2], v[3]) << 32); } } }
}
__device__ __forceinline__ void prologue(KArgs a, unsigned char* lds, int gw, int ngw, int wave, int lane, int tid) {
    if (blockIdx.x == 0) { float* LB = (float*)(a->ws + WS_LB);
        for (int i = tid; i < 2 * 512; i += NTHREADS) { const int dir = i >> 9, c = i & 511; const float* lg = a->in[I_LBLOG] + (size_t)dir * DEPTH * 512 + c;
            const float l0 = lg[0], l1 = lg[512], l2 = lg[1024], l3 = lg[1536]; const float mx = fmaxf(fmaxf(l0, l1), fmaxf(l2, l3));
            const float e0 = expf(l0 - mx), e1 = expf(l1 - mx), e2 = expf(l2 - mx), e3 = expf(l3 - mx); const float inv = 1.f / (e0 + e1 + e2 + e3);
            LB[(0 * 2 + dir) * 512 + c] = 0.f; LB[(1 * 2 + dir) * 512 + c] = e1 * inv; LB[(2 * 2 + dir) * 512 + c] = (e1 + e2) * inv; LB[(3 * 2 + dir) * 512 + c] = (e1 + e2 + e3) * inv; } }
    { bf16* XB = (bf16*)(a->ws + WS_XB); float* SS = (float*)(a->ws + WS_SS); const float* x = a->in[I_X];
      for (int m = gw; m < M; m += ngw) { const f32x4* xr = (const f32x4*)(x + (size_t)m * DM) + lane; f32x4 v[4]; float s = 0.f;
#pragma unroll
          for (int j = 0; j < 4; ++j) { v[j] = xr[64 * j]; s += (v[j][0] * v[j][0] + v[j][1] * v[j][1]) + (v[j][2] * v[j][2] + v[j][3] * v[j][3]); }
          s = wave_sum(s, lane);
          unsigned long long* o8 = (unsigned long long*)(XB + (size_t)m * DM) + lane;
#pragma unroll
          for (int j = 0; j < 4; ++j) o8[64 * j] = (unsigned long long)pk2(v[j][0], v[j][1]) | ((unsigned long long)pk2(v[j][2], v[j][3]) << 32);
          if (lane < 16) SS[(size_t)m * 16 + lane] = lane == 0 ? s : 0.f; } }
    { bf16* MB = (bf16*)((unsigned char*)a->out + OT_MEMB); const float* x = a->in[I_MEM];
      for (int m = gw; m < MMEM; m += ngw) { const f32x4* xr = (const f32x4*)(x + (size_t)m * DM) + lane; f32x4 v[4]; float s = 0.f;
#pragma unroll
          for (int j = 0; j < 4; ++j) { v[j] = xr[64 * j]; s += (v[j][0] * v[j][0] + v[j][1] * v[j][1]) + (v[j][2] * v[j][2] + v[j][3] * v[j][3]); }
          const float rs = 1.0f / sqrtf(wave_sum(s, lane) * (1.0f / DM) + 1e-6f);
          unsigned long long* o8 = (unsigned long long*)(MB + (size_t)m * DM) + lane;
#pragma unroll
          for (int j = 0; j < 4; ++j) o8[64 * j] = (unsigned long long)pk2(v[j][0] * rs, v[j][1] * rs) | ((unsigned long long)pk2(v[j][2] * rs, v[j][3] * rs) << 32); } }
    { float* scr = (float*)(lds + wave * 16384); bf16* WKT = (bf16*)((unsigned char*)a->out + OT_WKT); bf16* WVT = (bf16*)((unsigned char*)a->out + OT_WVT);
      for (int it = gw; it < DEPTH * 2 * 512; it += ngw) { const int l = it >> 10, part = (it >> 9) & 1, r = it & 511;
          transpose_item(a->in[I_WXKV] + (size_t)l * DM * 2048 + part * 1024, 2048, 1024, (part ? WVT : WKT) + (size_t)l * 1024 * DM, DM, a->in[I_NMEM] + l * DM, 1.f, scr, r, 32, lane); } }
    convert_layer(a, 0, lds, gw, ngw, wave, lane);
}
__device__ __forceinline__ void final_phase(KArgs a, int gw, int ngw, int lane) {
    const float* g = a->in[I_NFINAL] + lane * 16; const bf16* XB = (const bf16*)(a->ws + WS_XB);
    f32x4 gg[4];
#pragma unroll
    for (int j = 0; j < 4; ++j) gg[j] = *(const f32x4*)(g + 4 * j);
    for (int m = gw; m < M; m += ngw) { const v4u w0 = *(const v4u*)(XB + (size_t)m * DM + lane * 16), w1 = *(const v4u*)(XB + (size_t)m * DM + lane * 16 + 8);
        float x[16]; float s = 0.f;
#pragma unroll
        for (int j = 0; j < 4; ++j) { x[2 * j] = bflo(w0[j]); x[2 * j + 1] = bfhi(w0[j]); x[8 + 2 * j] = bflo(w1[j]); x[8 + 2 * j + 1] = bfhi(w1[j]); }
#pragma unroll
        for (int j = 0; j < 16; ++j) s += x[j] * x[j];
        const float rs = 1.0f / sqrtf(wave_sum(s, lane) * (1.0f / DM) + 1e-6f);
        f32x4* o = (f32x4*)(a->out + (size_t)m * DM + lane * 16);
#pragma unroll
        for (int j = 0; j < 4; ++j) o[j] = (f32x4){x[4 * j] * rs * gg[j][0], x[4 * j + 1] * rs * gg[j][1], x[4 * j + 2] * rs * gg[j][2], x[4 * j + 3] * rs * gg[j][3]}; }
}
namespace sc {
typedef short bf16x8 __attribute__((ext_vector_type(8)));
typedef float f32x4 __attribute__((ext_vector_type(4)));
typedef float f32x2 __attribute__((ext_vector_type(2)));
typedef unsigned u32x2 __attribute__((ext_vector_type(2)));
constexpr int LQ = 272, LS = 144;
constexpr int O_QS = 0, O_KS = O_QS + 64 * LQ, O_KDT = O_KS + 64 * LQ, O_VT = O_KDT + 128 * LS, O_KDT1 = O_VT + 64 * LS, O_VT1 = O_KDT1 + 128 * LS, O_P = O_VT1 + 64 * LS, O_ST = O_P + 64 * LS, O_SEG = O_ST + 80 * LQ,
              O_DEC = O_SEG + 4096, O_SCAL = O_DEC + 1024, O_NV = O_SCAL + 3072, O_PRE = O_NV + 1024, O_END = O_PRE + 3 * 32 * 64 * 4;
static_assert(O_END <= LDSCTL_OFF, "scan LDS map");
#define SC_BAR() do { __builtin_amdgcn_sched_barrier(0); asm volatile("s_waitcnt lgkmcnt(0)" ::: "memory"); __builtin_amdgcn_s_barrier(); asm volatile("" ::: "memory"); __builtin_amdgcn_sched_barrier(0); } while (0)
__device__ __forceinline__ bf16x8 frag(const unsigned char* base, int row, int pitch, int kbyte) { return *(const bf16x8*)(base + row * pitch + kbyte); }
__device__ __forceinline__ unsigned cvt2(float lo, float hi) { return pg8::cvt_pk_bf16(lo, hi); }
typedef _Float16 h2_t __attribute__((ext_vector_type(2)));
__device__ __forceinline__ f32x2 h2f(unsigned w) { return __builtin_convertvector(__builtin_bit_cast(h2_t, w), f32x2); }

constexpr int CW_CONV = 8192;
template <int NF> __device__ __forceinline__ void head_sync(unsigned* cnt, unsigned want, int slot, unsigned n, int mode, int tid, int uni);
__device__ __forceinline__ void mlstm_conv_part(KArgs a, int l, int b, int h, int part, int tid, int uni) {
    const int pair = tid & 127, which = pair >> 6, dp = pair & 63, rr = tid >> 7;
    unsigned char* R = a->ws + WS_R;
    const unsigned* src = (const unsigned*)((const bf16*)(R + (size_t)b * SLAB + (which ? S_MK : S_MQ)) + h * 128);
    unsigned* dst = (unsigned*)((bf16*)((unsigned char*)a->out + (which ? 16 * MiB : 0)) + h * 128) + (size_t)b * SEQ * 256;
    const float* cw = a->in[I_CONVW] + (size_t)l * 5 * 1024 + which * 512 + h * 128 + 2 * dp; const float* cb = a->in[I_CONVB] + (size_t)l * 1024 + which * 512 + h * 128 + 2 * dp;
    f32x2 w[5]; const f32x2 bias = *(const f32x2*)cb; const float sc = which ? 0.08838834764831845f : 1.0f;
#pragma unroll
    for (int j = 0; j < 5; ++j) w[j] = *(const f32x2*)(cw + j * 1024);
    const int t0 = 256 * part + 64 * rr;
    f32x2 x0, x1, x2, x3;
    { const unsigned z = 0u; const unsigned a0 = t0 >= 2 ? src[(size_t)(t0 - 2) * 256 + dp] : z, a1 = t0 >= 1 ? src[(size_t)(t0 - 1) * 256 + dp] : z, a2 = src[(size_t)t0 * 256 + dp], a3 = src[(size_t)(t0 + 1) * 256 + dp];
      x0 = (f32x2){bflo(a0), bfhi(a0)}; x1 = (f32x2){bflo(a1), bfhi(a1)}; x2 = (f32x2){bflo(a2), bfhi(a2)}; x3 = (f32x2){bflo(a3), bfhi(a3)}; }
#pragma unroll 1
    for (int tb = 0; tb < 64; tb += 8) { unsigned raw[8];
#pragma unroll
        for (int i = 0; i < 8; ++i) { const int tn = t0 + tb + i + 2; raw[i] = src[(size_t)(tn < SEQ ? tn : SEQ - 1) * 256 + dp]; }
#pragma unroll
        for (int i = 0; i < 8; ++i) { const int t = t0 + tb + i; const f32x2 x4 = (t + 2 < SEQ) ? (f32x2){bflo(raw[i]), bfhi(raw[i])} : (f32x2){0.f, 0.f};
            const f32x2 y = bias + w[0] * x0 + w[1] * x1 + w[2] * x2 + w[3] * x3 + w[4] * x4;
            dst[(size_t)t * 256 + dp] = cvt2(y.x * pg8::sigm(y.x) * sc, y.y * pg8::sigm(y.y) * sc);
            x0 = x1; x1 = x2; x2 = x3; x3 = x4; } }
    head_sync<8>((unsigned*)(a->ws + WS_CTL) + CW_CONV + 64 * (4 * b + h), 8u * (unsigned)(l + 1), part, (unsigned)(l + 1), 0, tid, uni);
}

constexpr int CW_MIX = 12288;
template <int NF> __device__ __forceinline__ void head_sync(unsigned* cnt, unsigned want, int slot, unsigned n, int mode, int tid, int uni) {
    const bool post = mode != 2, wait = mode != 0;
    if (post) { asm volatile("s_waitcnt vmcnt(0)" ::: "memory"); __syncthreads(); }
    if (uni) {
        if (tid < 64) { unsigned* fl = cnt + 8;
            if (tid == 0 && post) __hip_atomic_store(fl + slot, n, __ATOMIC_RELAXED, __HIP_MEMORY_SCOPE_WORKGROUP);
            unsigned spins = 0;
            if (wait) for (;;) { const unsigned v = tid < NF ? __hip_atomic_load(fl + tid, __ATOMIC_RELAXED, __HIP_MEMORY_SCOPE_AGENT) : n;
                if (__builtin_amdgcn_ballot_w64(v < n) == 0ull) break;
                __builtin_amdgcn_s_sleep(1); if (++spins > (1u << 22)) break; }
            if (wait) { __builtin_amdgcn_fence(__ATOMIC_ACQUIRE, "agent"); asm volatile("s_waitcnt vmcnt(0)" ::: "memory"); } }
    } else if (tid == 0) { if (post) { __builtin_amdgcn_fence(__ATOMIC_RELEASE, "agent"); asm volatile("s_waitcnt vmcnt(0)" ::: "memory");
        __hip_atomic_fetch_add(cnt, 1u, __ATOMIC_RELAXED, __HIP_MEMORY_SCOPE_AGENT); } unsigned spins = 0;
        if (wait) { while (__hip_atomic_load(cnt, __ATOMIC_RELAXED, __HIP_MEMORY_SCOPE_AGENT) < want) { __builtin_amdgcn_s_sleep(2); if (++spins > (1u << 22)) break; }
            __builtin_amdgcn_fence(__ATOMIC_ACQUIRE, "agent"); asm volatile("s_waitcnt vmcnt(0)" ::: "memory"); } }
    __syncthreads();
}
__device__ __forceinline__ void mix_quarter(KArgs a, int l, int type, int b, int h, int qi, int tid, int uni) {
    head_sync<4>((unsigned*)(a->ws + WS_CTL) + CW_MIX + 64 * (32 * type + 4 * b + h), 4u * (unsigned)(l + 1), qi, (unsigned)(l + 1), 1, tid, uni);
    const int lane = tid & 63, wave = tid >> 6, c16 = (lane & 7) * 16;
    unsigned char* R = a->ws + WS_R;
    unsigned char* SLB = R + (size_t)b * SLAB;
    const bf16* OF = (const bf16*)(SLB + S_OF) + type * 512 + h * 128 + c16; const bf16* OB = (const bf16*)(SLB + S_OB) + type * 512 + h * 128 + c16;
    bf16* GD = (bf16*)(SLB + (type ? S_MO : S_GG)) + h * 128 + c16;
    const float* gn = a->in[type ? I_MNORM : I_HNORM] + l * 512 + h * 128 + c16;
    float g[16];
#pragma unroll
    for (int j = 0; j < 16; ++j) g[j] = gn[j];
#pragma unroll 2
    for (int ps = 0; ps < 8; ++ps) { const size_t m = (size_t)(512 * qi + 64 * ps + 8 * wave + (lane >> 3));
        const v4u f0 = *(const v4u*)(OF + m * 1024), f1 = *(const v4u*)(OF + m * 1024 + 8), b0 = *(const v4u*)(OB + m * 1024), b1 = *(const v4u*)(OB + m * 1024 + 8);
        const v4u g0 = *(const v4u*)(GD + m * 512), g1 = *(const v4u*)(GD + m * 512 + 8);
        float o[16]; float s_ = 0.f;
#pragma unroll
        for (int j = 0; j < 16; ++j) { const unsigned fw = j < 8 ? f0[(j >> 1) & 3] : f1[(j >> 1) & 3], bw = j < 8 ? b0[(j >> 1) & 3] : b1[(j >> 1) & 3];
            o[j] = ((j & 1) ? bfhi(fw) : bflo(fw)) + ((j & 1) ? bfhi(bw) : bflo(bw)); s_ += o[j] * o[j]; }
        s_ += pg8::sx(s_, 1, lane); s_ += pg8::sx(s_, 2, lane); s_ += pg8::sx(s_, 4, lane);
        const float rs = __builtin_amdgcn_rsqf(s_ * (1.0f / 128.0f) + 1e-6f);
        v4u w0, w1;
#pragma unroll
        for (int j = 0; j < 16; j += 2) { const unsigned gw2 = j < 8 ? g0[(j >> 1) & 3] : g1[(j >> 1) & 3];
            const float z0 = bflo(gw2), z1 = bfhi(gw2), s0_ = pg8::sigm(z0), s1_ = pg8::sigm(z1);
            const unsigned pk = cvt2(o[j] * rs * g[j] * (type ? s0_ : z0 * s0_), o[j + 1] * rs * g[j + 1] * (type ? s1_ : z1 * s1_));
            if (j < 8) w0[(j >> 1) & 3] = pk; else w1[(j >> 1) & 3] = pk; }
        *(v4u*)(GD + m * 512) = w0; *(v4u*)(GD + m * 512 + 8) = w1; }
}

template <int TYPE> __device__ __forceinline__ void scan_s1b(unsigned char* lds, const int par, unsigned (&lfh)[8], unsigned (&qv)[8], unsigned (&kv)[8], unsigned (&vv)[4], const f32x2 cl7,
                                                        const int dp, const int rg, const int ep, const int sv, const f32x2* SEG, const float* SWKp) {
    const int okdt = par ? O_KDT1 : O_KDT, ovt = par ? O_VT1 : O_VT; float* DECp = (float*)(lds + O_DEC) + par * 128; (void)DECp; (void)SWKp; (void)cl7; (void)SEG;
    { asm volatile("" : "+v"(vv[0]), "+v"(vv[1]), "+v"(vv[2]), "+v"(vv[3]));
#pragma unroll
      for (int i = 0; i < 8; i += 4) { asm volatile("" : "+v"(qv[i]), "+v"(qv[i + 1]), "+v"(qv[i + 2]), "+v"(qv[i + 3])); if (TYPE == 1) asm volatile("" : "+v"(kv[i]), "+v"(kv[i + 1]), "+v"(kv[i + 2]), "+v"(kv[i + 3])); }
      unsigned kd0[4], kd1[4];
      if (TYPE == 0) { f32x2 pre = (f32x2){0.f, 0.f}, tot = pre;
#pragma unroll
          for (int j = 0; j < 8; ++j) { const f32x2 s_ = SEG[j * 64 + dp]; tot += s_; if (j < rg) pre += s_; }
          f32x2 f[8], kk[8];
#pragma unroll
          for (int i = 0; i < 8; ++i) { f[i] = h2f(lfh[i]); kk[i] = 1.0f - f[i]; }
          f32x2 E; E.x = __expf(pre.x); E.y = __expf(pre.y);
          f32x2 G; { const f32x2 ex = tot - (pre + cl7); G.x = __expf(ex.x); G.y = __expf(ex.y); }
          float kdx[8], kdy[8];
#pragma unroll
          for (int i = 7; i >= 0; --i) { const f32x2 kd = kk[i] * G; kdx[i] = kd.x; kdy[i] = kd.y; G = G * f[i]; }
#pragma unroll
          for (int i = 0; i < 8; ++i) { const int p = 8 * rg + i; E = E * f[i];
              const f32x2 qs = (f32x2){bflo(qv[i]), bfhi(qv[i])} * E;
              f32x2 ks; ks.x = kk[i].x * __builtin_amdgcn_rcpf(fmaxf(E.x, 1e-35f)); ks.y = kk[i].y * __builtin_amdgcn_rcpf(fmaxf(E.y, 1e-35f));
              *(unsigned*)(lds + O_QS + p * LQ + dp * 4) = cvt2(qs.x, qs.y);
              *(unsigned*)(lds + O_KS + p * LQ + dp * 4) = cvt2(ks.x, ks.y); }
#pragma unroll
          for (int i = 0; i < 4; ++i) { kd0[i] = cvt2(kdx[2 * i], kdx[2 * i + 1]); kd1[i] = cvt2(kdy[2 * i], kdy[2 * i + 1]); }
          if (rg == 0) { f32x2 dd; dd.x = __expf(tot.x); dd.y = __expf(tot.y); *(f32x2*)(DECp + 2 * dp) = dd; }
      } else {
          const f32x4 wk0 = *(const f32x4*)(SWKp + 8 * rg), wk1 = *(const f32x4*)(SWKp + 8 * rg + 4);
          float kdx[8], kdy[8];
#pragma unroll
          for (int i = 0; i < 8; ++i) { const int p = 8 * rg + i;
              *(unsigned*)(lds + O_QS + p * LQ + dp * 4) = qv[i];
              *(unsigned*)(lds + O_KS + p * LQ + dp * 4) = kv[i];
              const float w_ = i < 4 ? wk0[i & 3] : wk1[i & 3]; kdx[i] = bflo(kv[i]) * w_; kdy[i] = bfhi(kv[i]) * w_; }
#pragma unroll
          for (int i = 0; i < 4; ++i) { kd0[i] = cvt2(kdx[2 * i], kdx[2 * i + 1]); kd1[i] = cvt2(kdy[2 * i], kdy[2 * i + 1]); }
      }
      *(v4u*)(lds + okdt + (2 * dp) * LS + 16 * rg) = (v4u){kd0[0], kd0[1], kd0[2], kd0[3]};
      *(v4u*)(lds + okdt + (2 * dp + 1) * LS + 16 * rg) = (v4u){kd1[0], kd1[1], kd1[2], kd1[3]};
      u32x2 w0, w1; w0.x = (vv[0] & 0xffffu) | (vv[1] << 16); w0.y = (vv[2] & 0xffffu) | (vv[3] << 16); w1.x = (vv[0] >> 16) | (vv[1] & 0xffff0000u); w1.y = (vv[2] >> 16) | (vv[3] & 0xffff0000u);
      *(u32x2*)(lds + ovt + (2 * ep) * LS + 8 * sv) = w0; *(u32x2*)(lds + ovt + (2 * ep + 1) * LS + 8 * sv) = w1; }
}

template <int TYPE> __device__ __forceinline__ void scan_item(KArgs a, int l, int item, unsigned char* lds, int tid, int uni) {
    const int lane = tid & 63, wave = __builtin_amdgcn_readfirstlane(tid >> 6), fr = lane & 15, fq = lane >> 4;
    const int dir = (item >> 6) & 1, b = (item >> 3) & 7, h = (item >> 1) & 3, half = item & 1;
    unsigned char* R = a->ws + WS_R + (size_t)b * SLAB;
    bf16* OUT = (bf16*)(R + (dir ? S_OB : S_OF)) + TYPE * 512 + h * 128 + half * 64;
    const int dp = lane, rg = wave;
    const int ep = tid & 31, sv = tid >> 5;
    const int rstep = dir ? -1 : 1;
    const int row00 = dir ? SEQ - 1 : 0;
#define SC_RLO(c) (dir ? row00 - ((c) * 64 + 63) : row00 + (c) * 64)
#define SC_LR(p) (dir ? 63 - (p) : (p))
    unsigned lfh[2][8], qv[2][8], kv[2][8], vv[2][4];
    const unsigned* Qb = (const unsigned*)((const bf16*)(TYPE == 0 ? R + S_QH : (unsigned char*)a->out + (size_t)b * SEQ * 1024) + h * 128);
    const unsigned* Kb = (const unsigned*)((const bf16*)((unsigned char*)a->out + 16 * MiB + (size_t)b * SEQ * 1024) + h * 128);
    const unsigned* Vb = (const unsigned*)((const bf16*)(R + (TYPE == 0 ? S_VH : S_MV)) + h * 128 + half * 64);
    const unsigned* Lb = (const unsigned*)((const unsigned short*)(R + S_LF) + (size_t)dir * SEQ * 512 + h * 128);
    const float* GT = (const float*)(R + S_GT) + dir * 4 + h;
    const unsigned voffv = (unsigned)(SC_LR(4 * sv) * 256 + ep);
    const unsigned voffg = (unsigned)(SC_LR(lane) * 16);
#define SC_LOAD(c, u) do { long rlo_ = SC_RLO(c); asm volatile("" : "+s"(rlo_));     \
        if (TYPE == 0) { _Pragma("unroll") for (int i = 0; i < 8; ++i) { const long r = (rlo_ + SC_LR(8 * rg + i)) * 256; lfh[u][i] = Lb[r + dp]; qv[u][i] = Qb[r + dp]; } } \
        else { _Pragma("unroll") for (int i = 0; i < 8; ++i) { const long r = (rlo_ + SC_LR(8 * rg + i)) * 256; qv[u][i] = Qb[r + dp]; kv[u][i] = Kb[r + dp]; } \
        } \
        _Pragma("unroll") for (int i = 0; i < 4; ++i) { const unsigned vo_ = voffv + (unsigned)(rstep * i * 256); vv[u][i] = Vb[rlo_ * 256 + vo_]; } } while (0)
    f32x4 Sacc[4], Sx = (f32x4){0.f, 0.f, 0.f, 0.f};
#pragma unroll
    for (int et = 0; et < 4; ++et) Sacc[et] = (f32x4){0.f, 0.f, 0.f, 0.f};
    bf16x8 ONES; { const short o_ = (fr & 3) == 0 ? (short)0x3F80 : (short)0; ONES = (bf16x8){o_, o_, o_, o_, o_, o_, o_, o_}; }
    float m_prev = 0.f;
    for (int i = tid; i < 80 * LQ / 4; i += NTHREADS) ((unsigned*)(lds + O_ST))[i] = 0u;
    f32x2* SEG = (f32x2*)(lds + O_SEG); float* DEC = (float*)(lds + O_DEC); float* SCL = (float*)(lds + O_SCAL);
    float* PRE = (float*)(lds + O_PRE);
    if (TYPE == 1) {
        for (int cc = wave; cc < SEQ / 64; cc += NWAVES) { const long rl = SC_RLO(cc); const float gi_ = GT[rl * 16 + voffg], gf_ = GT[rl * 16 + voffg + 8];
            float cum = gf_;
#pragma unroll
            for (int o = 1; o < 64; o <<= 1) { const float t_ = pg8::sx_up(cum, o, lane); if (lane >= o) cum += t_; }
            const float bb = gi_ - cum; float pm = bb;
#pragma unroll
            for (int o = 1; o < 64; o <<= 1) { const float t_ = pg8::sx_up(pm, o, lane); if (lane >= o) pm = fmaxf(pm, t_); }
            PRE[cc * 64 + lane] = cum; PRE[2048 + cc * 64 + lane] = bb; PRE[4096 + cc * 64 + lane] = pm; } }
    if (TYPE == 1) head_sync<8>((unsigned*)(a->ws + WS_CTL) + CW_CONV + 64 * (4 * b + h), 8u * (unsigned)(l + 1), 0, (unsigned)(l + 1), 2, tid, uni);
    SC_LOAD(0, 0); SC_LOAD(1, 1);
    SC_BAR();
    f32x2 cl7 = (f32x2){0.f, 0.f};
#define SC_S1A(cn, u) do { if (TYPE == 0) { f32x2 p_ = (f32x2){1.f, 1.f}; _Pragma("unroll") for (int i = 0; i < 8; ++i) p_ = p_ * h2f(lfh[u][i]); f32x2 c_; c_.x = __logf(fmaxf(p_.x, 1e-37f)); c_.y = __logf(fmaxf(p_.y, 1e-37f)); cl7 = c_; SEG[rg * 64 + dp] = c_; } \
        else if (wave == 0) { const float cum = PRE[(cn) * 64 + lane], bb = PRE[2048 + (cn) * 64 + lane], pm = PRE[4096 + (cn) * 64 + lane], cum_last = PRE[(cn) * 64 + 63], pm_last = PRE[4096 + (cn) * 64 + 63]; \
            const float li = cum + m_prev, mt = fmaxf(cum + pm, li); \
            const float m_new = fmaxf(cum_last + m_prev, cum_last + pm_last); \
            float* W_ = SCL + ((cn) & 1) * 384; W_[lane] = cum - mt; W_[64 + lane] = bb; W_[128 + lane] = __expf(li - mt); W_[192 + lane] = __expf(-mt); W_[256 + lane] = __expf(cum_last + bb - m_new); if (lane == 0) W_[320] = __expf(cum_last + m_prev - m_new); \
            m_prev = m_new; } } while (0)
    SC_S1A(0, 0);
    SC_BAR();
    constexpr bool FOLD = TYPE == 1;
    if (FOLD) { scan_s1b<TYPE>(lds, 0, lfh[0], qv[0], kv[0], vv[0], cl7, dp, rg, ep, sv, SEG, SCL + 256);
        SC_LOAD(2, 0);
        SC_BAR(); }
#pragma unroll 1
    for (int c0 = 0; c0 < SEQ / 64; c0 += 2)
#pragma unroll
    for (int u = 0; u < 2; ++u) { const int c = c0 + u;
        const float* SA = SCL + (c & 1) * 384; const float* SB = SA + 64; const float* SWI = SA + 128; const float* SEM = SA + 192; const float* SWK = SA + 256; const float* SCAR = SA + 320;
        (void)SB; (void)SWI; (void)SEM; (void)SWK; (void)SCAR;
        if (!FOLD) { scan_s1b<TYPE>(lds, u, lfh[u], qv[u], kv[u], vv[u], cl7, dp, rg, ep, sv, SEG, SCL + u * 384 + 256);
            SC_BAR();
            if (c + 2 < SEQ / 64) SC_LOAD(c + 2, u); }
        const int tt = wave >> 1, c2 = (wave & 1) * 2;
        f32x4 oacc[2]; float dqv = 0.f;
        { f32x4 sacc[2]; sacc[0] = sacc[1] = oacc[0] = oacc[1] = (f32x4){0.f, 0.f, 0.f, 0.f};
          bf16x8 Bq[4], Ak[2][4], As[2][4], Ax[4];
#pragma unroll
          for (int ks = 0; ks < 4; ++ks) { const int kb = (32 * ks + 8 * fq) * 2; Bq[ks] = frag(lds + O_QS, 16 * tt + fr, LQ, kb);
#pragma unroll
              for (int j = 0; j < 2; ++j) { Ak[j][ks] = frag(lds + O_KS, 16 * (c2 + j) + fr, LQ, kb); As[j][ks] = frag(lds + O_ST, 16 * (c2 + j) + fr, LQ, kb); }
              if (TYPE == 1) Ax[ks] = frag(lds + O_ST, 64 + fr, LQ, kb); }
#pragma unroll
          for (int ks = 0; ks < 4; ++ks)
#pragma unroll
              for (int j = 0; j < 2; ++j) { sacc[j] = __builtin_amdgcn_mfma_f32_16x16x32_bf16(Ak[j][ks], Bq[ks], sacc[j], 0, 0, 0);
                                            oacc[j] = __builtin_amdgcn_mfma_f32_16x16x32_bf16(As[j][ks], Bq[ks], oacc[j], 0, 0, 0); }
          if (TYPE == 1) { f32x4 ox = (f32x4){0.f, 0.f, 0.f, 0.f};
#pragma unroll
              for (int ks = 0; ks < 4; ++ks) ox = __builtin_amdgcn_mfma_f32_16x16x32_bf16(Ax[ks], Bq[ks], ox, 0, 0, 0);
              dqv = ox[0]; }
          const int t_ = 16 * tt + fr; const float sa = TYPE == 1 ? SA[t_] : 0.f;
#pragma unroll
          for (int j = 0; j < 2; ++j) { const int s0 = 16 * (c2 + j) + 4 * fq; f32x4 pv = sacc[j];
              if (TYPE == 1) { const f32x4 sb = *(const f32x4*)(SB + s0);
#pragma unroll
                  for (int r = 0; r < 4; ++r) pv[r] *= __expf(fminf(sa + sb[r], 0.f)); }
#pragma unroll
              for (int r = 0; r < 4; ++r) pv[r] = (s0 + r <= t_) ? pv[r] : 0.f;
              u32x2 w; w.x = cvt2(pv[0], pv[1]); w.y = cvt2(pv[2], pv[3]);
              *(u32x2*)(lds + O_P + t_ * LS + s0 * 2) = w; } }
        if (FOLD && c + 1 < SEQ / 64) SC_S1A(c + 1, u ^ 1);
        SC_BAR();
        { const int t_ = 16 * tt + fr;
          bf16x8 Bp[2], Vf[2][2], Vs[4][2], Kd[2];
#pragma unroll
          for (int ks = 0; ks < 2; ++ks) { const int kb = (32 * ks + 8 * fq) * 2; Bp[ks] = frag(lds + O_P, t_, LS, kb);
#pragma unroll
              for (int j = 0; j < 2; ++j) Vf[j][ks] = frag(lds + (u ? O_VT1 : O_VT), 16 * (c2 + j) + fr, LS, kb); }
#pragma unroll
          for (int ks = 0; ks < 2; ++ks) { const int kb = (32 * ks + 8 * fq) * 2; Kd[ks] = frag(lds + (u ? O_KDT1 : O_KDT), 16 * wave + fr, LS, kb);
#pragma unroll
              for (int et = 0; et < 4; ++et) Vs[et][ks] = frag(lds + (u ? O_VT1 : O_VT), 16 * et + fr, LS, kb); }
          float wi = 1.f, sem = 0.f; f32x4 dv;
          if (TYPE == 0) dv = *(const f32x4*)(DEC + u * 128 + 16 * wave + 4 * fq); else { wi = SWI[t_]; sem = SEM[t_]; const float cr = SCAR[0]; dv = (f32x4){cr, cr, cr, cr}; }
          if (FOLD && c + 1 < SEQ / 64) { scan_s1b<TYPE>(lds, u ^ 1, lfh[u ^ 1], qv[u ^ 1], kv[u ^ 1], vv[u ^ 1], cl7, dp, rg, ep, sv, SEG, SCL + (u ^ 1) * 384 + 256);
              if (c + 3 < SEQ / 64) SC_LOAD(c + 3, u ^ 1); }
          f32x4 pacc[2], px; pacc[0] = pacc[1] = px = (f32x4){0.f, 0.f, 0.f, 0.f};
#pragma unroll
          for (int ks = 0; ks < 2; ++ks) {
              pacc[0] = __builtin_amdgcn_mfma_f32_16x16x32_bf16(Vf[0][ks], Bp[ks], pacc[0], 0, 0, 0);
              pacc[1] = __builtin_amdgcn_mfma_f32_16x16x32_bf16(Vf[1][ks], Bp[ks], pacc[1], 0, 0, 0);
              if (TYPE == 1) px = __builtin_amdgcn_mfma_f32_16x16x32_bf16(ONES, Bp[ks], px, 0, 0, 0); }
#pragma unroll
          for (int et = 0; et < 4; ++et) Sacc[et] = Sacc[et] * dv;
          if (TYPE == 1) Sx = Sx * dv;
#pragma unroll
          for (int ks = 0; ks < 2; ++ks) {
#pragma unroll
              for (int et = 0; et < 4; ++et) Sacc[et] = __builtin_amdgcn_mfma_f32_16x16x32_bf16(Kd[ks], Vs[et][ks], Sacc[et], 0, 0, 0);
              if (TYPE == 1) Sx = __builtin_amdgcn_mfma_f32_16x16x32_bf16(Kd[ks], ONES, Sx, 0, 0, 0); }
          float rden = 1.f;
          if (TYPE == 1) { const float dn = px[0] + wi * dqv;
              rden = __builtin_amdgcn_rcpf(fmaxf(fabsf(dn), sem)); }
          bf16* orow = OUT + (size_t)SC_RLO(c) * 1024 + (unsigned)(SC_LR(t_) * 1024 + 4 * fq);
#pragma unroll
          for (int j = 0; j < 2; ++j) { f32x4 o;
              if (TYPE == 0) o = pacc[j] + oacc[j]; else o = (pacc[j] + oacc[j] * wi) * rden;
              u32x2 w; w.x = cvt2(o[0], o[1]); w.y = cvt2(o[2], o[3]);
              *(u32x2*)(orow + 16 * (c2 + j)) = w; }
#pragma unroll
          for (int et = 0; et < 4; ++et) { u32x2 w; w.x = cvt2(Sacc[et][0], Sacc[et][1]); w.y = cvt2(Sacc[et][2], Sacc[et][3]);
              *(u32x2*)(lds + O_ST + (16 * et + fr) * LQ + (16 * wave + 4 * fq) * 2) = w; }
          if (TYPE == 1) { u32x2 w; w.x = cvt2(Sx[0], Sx[1]); w.y = cvt2(Sx[2], Sx[3]);
              *(u32x2*)(lds + O_ST + (64 + fr) * LQ + (16 * wave + 4 * fq) * 2) = w; } }
        if (!FOLD && c + 1 < SEQ / 64) SC_S1A(c + 1, u ^ 1);
        SC_BAR();
    }
#undef SC_LOAD
#undef SC_RLO
#undef SC_LR
#undef SC_S1A
}
}
#define PH_BEGIN KArgs ap = fresh_args(); const int tid = fresh_tid(wave_s), lane = tid & 63, wave = __builtin_amdgcn_readfirstlane(tid >> 6); \
    const int gw = (int)blockIdx.x * NWAVES + wave, ngw = G * NWAVES; unsigned char* ws = ap->ws; unsigned char* R = ws + WS_R; \
    (void)lane; (void)gw; (void)ngw; (void)R;
__global__ void __launch_bounds__(NTHREADS, 2) fwd_kernel(Args args_unused) {
    extern __shared__ __attribute__((aligned(16))) unsigned char lds[];
    const int G = gridDim.x;
    const int wave_s = __builtin_amdgcn_readfirstlane(threadIdx.x >> 6);
    { PH_BEGIN
      for (int u = tid; u < (LDS_BYTES - LDSCTL_OFF) / 4; u += NTHREADS) ((unsigned*)(lds + LDSCTL_OFF))[u] = 0u;
      __syncthreads();
      (void)xcd_barrier_post((unsigned*)(ws + WS_CTL) + CW_BAR, (volatile LAS unsigned*)(lds + MISC_OFF) + 8, tid);
      prologue(ap, lds, gw, ngw, wave, lane, tid);
      }
#define BAR_OBJ() XcdBarrier b_; b_.bar = (unsigned*)(fresh_args()->ws + WS_CTL) + CW_BAR; b_.x = xb_xcc_id(); b_.st = (volatile LAS unsigned*)(lds + MISC_OFF) + 8
#define GRID_BAR() do { BAR_OBJ(); xcd_barrier<false>(b_, fresh_tid(wave_s)); } while (0)
#define BATCH_BAR() do { BAR_OBJ(); if (uni) xcd_barrier<true>(b_, fresh_tid(wave_s)); else xcd_barrier<false>(b_, fresh_tid(wave_s)); } while (0)
#define RING ((PG8_LAS unsigned char*)lds)
    typedef pg8::bf16_t bt;
    GRID_BAR();
    int vb, uni;
    { volatile LAS unsigned* st_ = (volatile LAS unsigned*)(lds + MISC_OFF) + 8;
      uni = __builtin_amdgcn_readfirstlane((int)st_[2]);
      vb = uni ? __builtin_amdgcn_readfirstlane((int)(st_[3] * 8u + xb_xcc_id())) : (int)blockIdx.x; }
#pragma unroll 1
    for (int l = 0; l < DEPTH; ++l) {
        const size_t WOFF = (l & 1) ? WS_W2 : WS_W;
        { PH_BEGIN
          pg8::Gemm g = pg8::plain_gemm((const bt*)(ws + WS_XB), (const bt*)(ws + WOFF + WO_IN), DM, DM, DM); pg8::StaticOrder S; S.init(M / 256, DINP / 256, G, vb);
          pg8::EpiInProj E{(const float*)(ws + WS_SS), ap->in[I_BIN] + (size_t)l * DIN, (const float*)(ws + WS_LB) + l * 1024,
                           R};
          pg8::gemm_phase<pg8::EpiInProj, pg8::StaticOrder, true, true, 0>(RING, g, S, E, tid); }
        if (l + 1 < DEPTH && G == 256 && vb >= 192) { PH_BEGIN convert_layer(ap, l + 1, lds, (vb - 192) * NWAVES + wave, 64 * NWAVES, wave, lane); }
        else if (l + 1 < DEPTH && G != 256) { PH_BEGIN convert_layer(ap, l + 1, lds, gw, ngw, wave, lane); }
        if (l == 0) {
            if (uni) { PH_BEGIN
              pg8::Gemm g = pg8::plain_gemm((const bt*)((unsigned char*)ap->out + OT_MEMB), (const bt*)((unsigned char*)ap->out + OT_WKT), DM, DM, DM);
              pg8::OneUnit S; S.has = true; S.u.pm = vb & 7; S.u.pn = vb >> 3;
              pg8::EpiKV E{(bt*)(ws + WS_KX), (bt*)(ws + WS_VT)};
              pg8::gemm_phase<pg8::EpiKV, pg8::OneUnit, true, true, 0>(RING, g, S, E, tid); }
            else { PH_BEGIN
              pg8::Gemm g = pg8::plain_gemm((const bt*)((unsigned char*)ap->out + OT_MEMB), (const bt*)((unsigned char*)ap->out + OT_WKT), DM, DM, DM); pg8::StaticOrder S; S.init(MMEM / 256, 2 * DEPTH * DM / 256, G, (int)blockIdx.x);
              pg8::EpiKV E{(bt*)(ws + WS_KX), (bt*)(ws + WS_VT)};
              pg8::gemm_phase<pg8::EpiKV, pg8::StaticOrder, true, true, 0>(RING, g, S, E, tid); }
        }
        BATCH_BAR();
        { const int y_ = vb & 127, r_ = y_ >> 3; const int it_ = (r_ >> 3) * 64 + (y_ & 7) * 8 + ((r_ >> 1) & 3) * 2 + (r_ & 1);
          const int bb_ = (it_ >> 3) & 7, hh_ = (it_ >> 1) & 3, qi_ = ((it_ >> 6) & 1) * 2 + (it_ & 1);
          if (vb < 128) { { PH_BEGIN sc::mlstm_conv_part(ap, l, bb_, hh_, qi_, tid, uni); }
                 { PH_BEGIN sc::scan_item<0>(ap, l, it_, lds, tid, uni); }
                 { PH_BEGIN sc::mix_quarter(ap, l, 0, bb_, hh_, qi_, tid, uni); } }
          else { { PH_BEGIN sc::mlstm_conv_part(ap, l, bb_, hh_, 4 + qi_, tid, uni); }
                 { PH_BEGIN sc::scan_item<1>(ap, l, it_, lds, tid, uni); }
                 { PH_BEGIN sc::mix_quarter(ap, l, 1, bb_, hh_, qi_, tid, uni); } } }
        BATCH_BAR();
        { PH_BEGIN
          pg8::Gemm g; g.A = (const bt*)(ws + WS_KX) + (size_t)l * 32 * 65536; g.Bt = (const bt*)(ws + WOFF + WO_XQ); g.lda = 256; g.ldb = DM; g.K = 256; g.ajump = 0;
          g.am = (size_t)65536 * 2; g.am8 = 0; g.an3 = 0; g.bn = (size_t)256 * DM * 2; g.bm3 = 512; g.bm8 = 0;
          pg8::OneUnit S; S.has = (vb >> 3) < 16; S.u.pm = (vb & 7) * 4 + ((vb >> 5) & 3); S.u.pn = (vb >> 3) & 3;
          pg8::EpiRowBf16<2> E{nullptr, (bt*)(R + S_MT), DM, 2, (SLAB - 2 * MiB) / 2};
          pg8::gemm_phase<pg8::EpiRowBf16<2>, pg8::OneUnit, true, true, 0>(RING, g, S, E, tid); }
        { PH_BEGIN
          pg8::Gemm g; g.A = (const bt*)(ws + WOFF + WO_XO); g.Bt = (const bt*)(ws + WS_VT) + (size_t)l * 32 * 65536; g.lda = DM; g.ldb = 256; g.K = 256; g.ajump = 0;
          g.am = (size_t)256 * DM * 2; g.am8 = 0; g.an3 = 512; g.bn = (size_t)65536 * 2; g.bm3 = 0; g.bm8 = 0;
          pg8::OneUnit S; S.has = (vb >> 3) >= 16; S.u.pm = ((vb >> 3) - 16) >> 2; S.u.pn = (vb & 7) * 4 + ((vb >> 3) & 3);
          pg8::EpiNt E{(bt*)(R + S_NT)};
          pg8::gemm_phase<pg8::EpiNt, pg8::OneUnit, true, true, 0>(RING, g, S, E, tid); }
        { PH_BEGIN
          pg8::Gemm g = pg8::plain_gemm((const bt*)(R + S_GG), (const bt*)(ws + WOFF + WO_OUT), 512, DM, DM); g.ajump = (size_t)(S_MO - S_GG) - 1024; g.am8 = SLAB - 2 * MiB; pg8::StaticOrder S; S.init(M / 256, DM / 256, G, vb);
          pg8::EpiResid E{(bt*)(ws + WS_XB), (float*)(ws + WS_SS)};
          pg8::gemm_phase<pg8::EpiResid, pg8::StaticOrder, true, true, 2>(RING, g, S, E, tid); }
        BATCH_BAR();
        { PH_BEGIN
          pg8::Gemm g = pg8::plain_gemm((const bt*)(ws + WS_XB), (const bt*)(R + S_MT), DM, DM, DM); g.bm8 = SLAB; pg8::StaticOrder S; S.init(M / 256, 4, G, vb);
          pg8::EpiSoftmax E{(const float*)(ws + WS_SS), (bt*)(R + S_P)};
          pg8::gemm_phase<pg8::EpiSoftmax, pg8::StaticOrder, false, true, 0>(RING, g, S, E, tid); }
        BATCH_BAR();
        { PH_BEGIN
          pg8::Gemm g = pg8::plain_gemm((const bt*)(R + S_P), (const bt*)(R + S_NT), DM, DM, DM); g.am8 = SLAB - 4 * MiB; g.bm8 = SLAB; pg8::StaticOrder S; S.init(M / 256, DM / 256, G, vb);
          pg8::EpiResid E{(bt*)(ws + WS_XB), (float*)(ws + WS_SS)};
          pg8::gemm_phase<pg8::EpiResid, pg8::StaticOrder, true, true, 0>(RING, g, S, E, tid); }
        BATCH_BAR();
        { PH_BEGIN
          pg8::Gemm g = pg8::plain_gemm((const bt*)(ws + WS_XB), (const bt*)(ws + WOFF + WO_UP), DM, DM, DM); pg8::StaticOrder S; S.init(M / 256, DFF / 256, G, vb);
          pg8::EpiRowBf16<1> E{(const float*)(ws + WS_SS), (bt*)(R + S_H), DFF, 3, (SLAB - 16 * MiB) / 2};
          pg8::gemm_phase<pg8::EpiRowBf16<1>, pg8::StaticOrder, true, true, 0>(RING, g, S, E, tid); }
        BATCH_BAR();
        { PH_BEGIN
          pg8::Gemm g = pg8::plain_gemm((const bt*)(R + S_H), (const bt*)(ws + WOFF + WO_DOWN), DFF, DFF, DFF); g.am8 = SLAB - 16 * MiB; pg8::StaticOrder S; S.init(M / 256, DM / 256, G, vb);
          pg8::EpiResid E{(bt*)(ws + WS_XB), (float*)(ws + WS_SS)};
          pg8::gemm_phase<pg8::EpiResid, pg8::StaticOrder, true, true, 0>(RING, g, S, E, tid); }
        GRID_BAR();
    }
    { PH_BEGIN final_phase(ap, gw, ngw, lane); }
}

extern "C" void kernel_launch(void* const* d_in, const int* in_sizes, int n_in, void* d_out, int out_size, void* d_ws, size_t ws_size, hipStream_t stream) {
    static int grid = 0;
    if (grid == 0) {
        if (n_in != 20 || out_size != M * DM || ws_size < WS_END) { fprintf(stderr, "kernel_launch: unexpected shapes (n_in %d, out %d, ws %zu < %zu); nothing launched\n", n_in, out_size, ws_size, (size_t)WS_END); grid = -1; return; }
        int dev = 0, cus = 0;
        if (hipGetDevice(&dev) != hipSuccess || hipDeviceGetAttribute(&cus, hipDeviceAttributeMultiprocessorCount, dev) != hipSuccess) { grid = -1; return; }
        if (hipFuncSetAttribute((const void*)fwd_kernel, hipFuncAttributeMaxDynamicSharedMemorySize, LDS_BYTES) != hipSuccess) { fprintf(stderr, "kernel_launch: hipFuncSetAttribute failed\n"); grid = -1; return; }
        int occ = 0;
        if (hipOccupancyMaxActiveBlocksPerMultiprocessor(&occ, (const void*)fwd_kernel, NTHREADS, LDS_BYTES) != hipSuccess || occ < 1) { fprintf(stderr, "kernel_launch: occupancy query failed or zero\n"); grid = -1; return; }
        (void)hipGetLastError();
        grid = cus;
        if (grid != 256) fprintf(stderr, "kernel_launch: %d CUs; this kernel is built for 256\n", grid);
    }
    if (grid < 0) return;
    if (hipMemsetAsync((char*)d_ws + WS_CTL, 0, CTL_ZERO_BYTES, stream) != hipSuccess) return;
    Args a{};
    for (int i = 0; i < 20; ++i) a.in[i] = (const float*)d_in[i];
    a.out = (float*)d_out; a.ws = (unsigned char*)d_ws;
    hipLaunchKernelGGL(fwd_kernel, dim3(grid), dim3(NTHREADS), LDS_BYTES, stream, a);
}
```

```cpp
#include <hip/hip_runtime.h>
#include <cstdio>
#include <cstdint>
namespace pg8 {
#define PG8_LAS __attribute__((address_space(3)))
typedef unsigned short bf16_t;
typedef short bf16x8 __attribute__((ext_vector_type(8)));
typedef float f32x4 __attribute__((ext_vector_type(4)));
typedef float f32x2 __attribute__((ext_vector_type(2)));
typedef unsigned u32x4 __attribute__((ext_vector_type(4)));
constexpr int WCS = 64, BJS = 32;
constexpr int BM = 256, BK = 64, HALF = 128, HTB = HALF * BK * 2  , STAGE_BYTES = 8 * HTB, NXCD = 8, WGM = 8;

__host__ __device__ __forceinline__ int lds_byte(int r, int c) { const int st = (r >> 4) * 2 + (c >> 5), rr = r & 15, cc = c & 31, ob = rr * 64 + cc * 2; return st * 1024 + (ob ^ (((ob >> 9) & 1) << 5)); }
__host__ __device__ __forceinline__ void stage_rc(int b, int& R, int& C) { const int st = b / 1024, sb = b % 1024, swz = sb ^ (((sb >> 9) & 1) << 5); R = (st >> 1) * 16 + swz / 64; C = (st & 1) * 32 + (swz % 64) / 2; }
__host__ __device__ __forceinline__ int perm32(int rho) { const int n = rho >> 4, i = rho & 15; return 8 * (i >> 2) + 4 * n + (i & 3); }

struct Unit { int pm, pn; };
struct Gemm { const bf16_t* A; const bf16_t* Bt; int lda, ldb, K; size_t ajump, am, am8, an3, bn, bm3, bm8; };
__device__ __forceinline__ Gemm plain_gemm(const bf16_t* A, const bf16_t* Bt, int lda, int ldb, int K) { Gemm g; g.A = A; g.Bt = Bt; g.lda = lda; g.ldb = ldb; g.K = K; g.ajump = 0; g.am = (size_t)512 * lda; g.am8 = 0; g.an3 = 0; g.bn = (size_t)512 * ldb; g.bm3 = 0; g.bm8 = 0; return g; }
template <int MODE> __device__ __forceinline__ const char* a_base(const Gemm& g, const Unit& u) { return (const char*)g.A + (size_t)u.pm * g.am + (size_t)(u.pm >> 3) * g.am8 + (size_t)(u.pn & 3) * g.an3; }
template <int MODE> __device__ __forceinline__ const char* b_base(const Gemm& g, const Unit& u) { return (const char*)g.Bt + (size_t)u.pn * g.bn + (size_t)(u.pm & 3) * g.bm3 + (size_t)(u.pm >> 3) * g.bm8; }

struct StaticOrder {
    int nM, nN, nwg, G, c;
    __host__ __device__ void init(int nM_, int nN_, int G_, int c_) { nM = nM_; nN = nN_; nwg = nM * nN; G = G_; c = c_; }
    __host__ __device__ bool next(int i, Unit& u) const {
        const long L = (long)i * G + c; if (L >= nwg) return false;
        int wgid = (int)L; { const int q = nwg / NXCD, r = nwg % NXCD, xcd = wgid % NXCD, off = wgid / NXCD; wgid = (xcd < r ? xcd * (q + 1) : r * (q + 1) + (xcd - r) * q) + off; }
        const int nig = WGM * nN, gid = wgid / nig, fm = gid * WGM, gsz = (nM - fm) < WGM ? (nM - fm) : WGM;
        u.pm = fm + ((wgid % nig) % gsz); u.pn = (wgid % nig) / gsz; return true;
    }
    __device__ __forceinline__ void a_ready(const Unit&) const {}
    __device__ __forceinline__ void done(const Unit&) const {}
};

struct OneUnit { Unit u; bool has;
    __device__ bool next(int i, Unit& o) const { if (i != 0 || !has) return false; o = u; return true; }
    __device__ __forceinline__ void a_ready(const Unit&) const {}
    __device__ __forceinline__ void done(const Unit&) const {}
};

typedef float f32x2_cv __attribute__((ext_vector_type(2)));
typedef __bf16 bf16x2_cv __attribute__((ext_vector_type(2)));
__device__ __forceinline__ unsigned cvt_pk_bf16(float lo, float hi) { const f32x2_cv v = {lo, hi}; const bf16x2_cv b = __builtin_convertvector(v, bf16x2_cv); return __builtin_bit_cast(unsigned, b); }
__device__ __forceinline__ u32x4 pack8(const f32x4 a, const f32x4 b) { u32x4 w; w.x = cvt_pk_bf16(a[0], a[1]); w.y = cvt_pk_bf16(a[2], a[3]); w.z = cvt_pk_bf16(b[0], b[1]); w.w = cvt_pk_bf16(b[2], b[3]); return w; }
constexpr float NORM_EPS = 1e-6f;
__device__ __forceinline__ float sx(float v, int k, int lane) { return __builtin_bit_cast(float, __builtin_amdgcn_ds_bpermute((lane ^ k) << 2, __builtin_bit_cast(int, v))); }
__device__ __forceinline__ float sx_up(float v, int o, int lane) { return __builtin_bit_cast(float, __builtin_amdgcn_ds_bpermute(((lane - o) & 63) << 2, __builtin_bit_cast(int, v))); }
__device__ __forceinline__ float sx_idx(float v, int src) { return __builtin_bit_cast(float, __builtin_amdgcn_ds_bpermute(src << 2, __builtin_bit_cast(int, v))); }
__device__ __forceinline__ float row_rstd(const float* SS, int row, int fq) {
    const f32x4 v = *(const f32x4*)(SS + (size_t)row * 16 + fq * 4);
    const int lane = fq * 16 + (row & 15);
    float s = (v[0] + v[1]) + (v[2] + v[3]); s += sx(s, 16, lane); s += sx(s, 32, lane);
    return __builtin_amdgcn_rsqf(s * (1.0f / 1024.0f) + NORM_EPS);
}
__device__ __forceinline__ void row_rstd8(const float* SS, int row0, int fr, int fq, float (&rs)[8]) {
    f32x4 v[8];
#pragma unroll
    for (int i = 0; i < 8; ++i) v[i] = *(const f32x4*)(SS + (size_t)(row0 + (i >> 2) * HALF + (i & 3) * 16) * 16 + fq * 4);
    const int lane = fq * 16 + fr; float s[8];
#pragma unroll
    for (int i = 0; i < 8; ++i) s[i] = (v[i][0] + v[i][1]) + (v[i][2] + v[i][3]);
#pragma unroll
    for (int i = 0; i < 8; ++i) s[i] += sx(s[i], 16, lane);
#pragma unroll
    for (int i = 0; i < 8; ++i) s[i] += sx(s[i], 32, lane);
#pragma unroll
    for (int i = 0; i < 8; ++i) rs[i] = __builtin_amdgcn_rsqf(s[i] * (1.0f / 1024.0f) + NORM_EPS);
    asm volatile("" : "+v"(rs[0]), "+v"(rs[1]), "+v"(rs[2]), "+v"(rs[3]), "+v"(rs[4]), "+v"(rs[5]), "+v"(rs[6]), "+v"(rs[7]));
    __builtin_amdgcn_sched_barrier(0);
}
__device__ __forceinline__ float logsig(float z) { return fminf(z, 0.f) - __logf(1.0f + __expf(-fabsf(z))); }
__device__ __forceinline__ float sigm(float z) { return __builtin_amdgcn_rcpf(1.0f + __expf(-z)); }

__device__ __forceinline__ f32x4 sel_acc(const f32x4 (&acc)[2][2][4][2], int ai, int bj, int m, int n) {
    f32x4 r = acc[0][bj][0][n];
#pragma unroll
    for (int a = 0; a < 2; ++a)
#pragma unroll
        for (int mm = 0; mm < 4; ++mm) if (a == ai && mm == m) r = acc[a][bj][mm][n];
    return r;
}
constexpr int MTOK = 16384;
constexpr size_t SL_MIB = 1u << 20, SLAB = 53 * (SL_MIB / 2);
constexpr size_t SL_GT = 14 * SL_MIB, SL_LF = SL_GT + SL_MIB / 4, SL_OF = SL_LF + 4 * SL_MIB, SL_OB = SL_OF + 4 * SL_MIB;
struct EpiInProj {
    static constexpr bool PERM = true, AFTER_DRAIN = false;
    const float* SS; const float* bias; const float* lb;
    unsigned char* RB;
    __device__ __forceinline__ void operator()(const f32x4 (&acc)[2][2][4][2], const Unit& u, int wr, int wc, int fr, int fq) const {
        const int seg = u.pn >> 1;
        const int row0 = u.pm * BM + wr * 64 + fr, lrow0 = (u.pm & 7) * BM + wr * 64 + fr;
        unsigned char* const SLB = RB + (size_t)(u.pm >> 3) * SLAB;
        const int cs0 = (u.pn & 1) * 256 + wc * WCS + 8 * fq;
        const int gc0 = u.pn * BM + wc * WCS + 8 * fq;
        if (seg == 9) {
            if (wc != 0) return;
            float rs8[8]; row_rstd8(SS, row0, fr, fq, rs8);
            f32x4 b0 = (f32x4){0.f, 0.f, 0.f, 0.f}, b1 = b0;
            if (fq < 2) { b0 = *(const f32x4*)(bias + gc0); b1 = *(const f32x4*)(bias + gc0 + 4); }
#pragma unroll
            for (int am = 0; am < 8; ++am) { const int ai = am >> 2, m = am & 3; const int lrow = lrow0 + ai * HALF + m * 16; const float rs = rs8[am]; float* const GATES = (float*)(SLB + SL_GT);
                f32x4 v0 = acc[ai][0][m][0] * rs + b0, v1 = acc[ai][0][m][1] * rs + b1;
                if (fq == 1) {
#pragma unroll
                    for (int j = 0; j < 4; ++j) { v0[j] = logsig(v0[j]); v1[j] = logsig(v1[j]); } }
                if (fq < 2) { *(f32x4*)(GATES + (size_t)lrow * 16 + 8 * fq) = v0; *(f32x4*)(GATES + (size_t)lrow * 16 + 8 * fq + 4) = v1; } }
            return;
        }
        f32x4 bv[2][2];
#pragma unroll
        for (int bj = 0; bj < 2; ++bj)
#pragma unroll
            for (int n = 0; n < 2; ++n) bv[bj][n] = *(const f32x4*)(bias + gc0 + bj * BJS + 4 * n);
        float rs8[8];
        if (seg == 1 || seg == 2) {
            f32x4 lv[2][2];
#pragma unroll
            for (int bj = 0; bj < 2; ++bj)
#pragma unroll
                for (int n = 0; n < 2; ++n) lv[bj][n] = *(const f32x4*)(lb + (seg - 1) * 512 + cs0 + bj * BJS + 4 * n);
            unsigned short* LFd = (unsigned short*)(SLB + SL_LF) + (size_t)(seg - 1) * 2048 * 512 + cs0;
            row_rstd8(SS, row0, fr, fq, rs8);
#pragma unroll
            for (int ai = 0; ai < 2; ++ai)
#pragma unroll
                for (int m = 0; m < 4; ++m) { const int row = row0 + ai * HALF + m * 16; const float rs = rs8[ai * 4 + m];
#pragma unroll
                    for (int bj = 0; bj < 2; ++bj) { f32x4 v0 = acc[ai][bj][m][0] * rs + bv[bj][0], v1 = acc[ai][bj][m][1] * rs + bv[bj][1];
#pragma unroll
                        for (int j = 0; j < 4; ++j) { const float a0 = lv[bj][0][j], a1 = lv[bj][1][j];
                            v0[j] = a0 + (1.f - a0) * sigm(fmaxf(v0[j], -80.f)); v1[j] = a1 + (1.f - a1) * sigm(fmaxf(v1[j], -80.f)); }
                        typedef _Float16 h2_t __attribute__((ext_vector_type(2))); u32x4 w;
                        w.x = __builtin_bit_cast(unsigned, (h2_t){(_Float16)v0[0], (_Float16)v0[1]}); w.y = __builtin_bit_cast(unsigned, (h2_t){(_Float16)v0[2], (_Float16)v0[3]});
                        w.z = __builtin_bit_cast(unsigned, (h2_t){(_Float16)v1[0], (_Float16)v1[1]}); w.w = __builtin_bit_cast(unsigned, (h2_t){(_Float16)v1[2], (_Float16)v1[3]});
                        *(u32x4*)(LFd + (size_t)(row - row0 + lrow0) * 512 + bj * BJS) = w; } }
            return;
        }
        const float ca = seg == 0 ? 0.f : 1.f, cb = 0.f, cc = seg == 0 ? 1.f : 0.f;
        bf16_t* dst = (bf16_t*)(SLB + ((size_t)(seg == 0 ? 0 : seg - 2) << 21)) + cs0;
        row_rstd8(SS, row0, fr, fq, rs8);
#pragma unroll
        for (int ai = 0; ai < 2; ++ai)
#pragma unroll
            for (int m = 0; m < 4; ++m) { const int row = row0 + ai * HALF + m * 16; const float rs = rs8[ai * 4 + m];
#pragma unroll
                for (int bj = 0; bj < 2; ++bj) { f32x4 v0 = acc[ai][bj][m][0] * rs + bv[bj][0], v1 = acc[ai][bj][m][1] * rs + bv[bj][1];
                    if (ca == 0.f) {
#pragma unroll
                        for (int j = 0; j < 4; ++j) { const float s0 = sigm(v0[j]), s1 = sigm(v1[j]); v0[j] = v0[j] * (cc * s0) + cb * s0; v1[j] = v1[j] * (cc * s1) + cb * s1; } }
                    *(u32x4*)(dst + (size_t)(row - row0 + lrow0) * 512 + bj * BJS) = pack8(v0, v1); } }
    }
};
struct EpiResid {
    static constexpr bool PERM = true, AFTER_DRAIN = false;
    bf16_t* xb; float* SS;
    __device__ __forceinline__ void operator()(const f32x4 (&acc)[2][2][4][2], const Unit& u, int wr, int wc, int fr, int fq) const {
        const int row0 = u.pm * BM + wr * 64 + fr, col0 = u.pn * BM + wc * WCS + 8 * fq;
        u32x4 xo[2][4][2];
#pragma unroll
        for (int ai = 0; ai < 2; ++ai)
#pragma unroll
            for (int m = 0; m < 4; ++m)
#pragma unroll
                for (int bj = 0; bj < 2; ++bj) xo[ai][m][bj] = *(const u32x4*)(xb + (size_t)(row0 + ai * HALF + m * 16) * 1024 + col0 + bj * BJS);
        __builtin_amdgcn_sched_barrier(0);
        float sq8[8];
#pragma unroll
        for (int ai = 0; ai < 2; ++ai)
#pragma unroll
            for (int m = 0; m < 4; ++m) { const int row = row0 + ai * HALF + m * 16; float sq = 0.f;
#pragma unroll
                for (int bj = 0; bj < 2; ++bj) { const size_t o = (size_t)row * 1024 + col0 + bj * BJS;
                    const u32x4 xw = xo[ai][m][bj];
                    f32x4 a = (f32x4){__builtin_bit_cast(float, xw.x << 16), __builtin_bit_cast(float, xw.x & 0xffff0000u), __builtin_bit_cast(float, xw.y << 16), __builtin_bit_cast(float, xw.y & 0xffff0000u)};
                    f32x4 b = (f32x4){__builtin_bit_cast(float, xw.z << 16), __builtin_bit_cast(float, xw.z & 0xffff0000u), __builtin_bit_cast(float, xw.w << 16), __builtin_bit_cast(float, xw.w & 0xffff0000u)};
                    a = a + acc[ai][bj][m][0]; b = b + acc[ai][bj][m][1];
                    *(u32x4*)(xb + o) = pack8(a, b);
                    sq += (a[0] * a[0] + a[1] * a[1]) + (a[2] * a[2] + a[3] * a[3]) + (b[0] * b[0] + b[1] * b[1]) + (b[2] * b[2] + b[3] * b[3]); }
                sq8[ai * 4 + m] = sq; }
        const int lane = fq * 16 + fr;
#pragma unroll
        for (int i = 0; i < 8; ++i) sq8[i] += sx(sq8[i], 16, lane);
#pragma unroll
        for (int i = 0; i < 8; ++i) sq8[i] += sx(sq8[i], 32, lane);
#pragma unroll
        for (int i = 0; i < 8; ++i) if (fq == 0) SS[(size_t)(row0 + (i >> 2) * HALF + (i & 3) * 16) * 16 + u.pn * 4 + wc] = sq8[i];
    }
};
template <int ACT> struct EpiRowBf16 {
    static constexpr bool PERM = true, AFTER_DRAIN = false;
    const float* SS; bf16_t* O; int ldc; int bshift; size_t corr;
    __device__ __forceinline__ void operator()(const f32x4 (&acc)[2][2][4][2], const Unit& u, int wr, int wc, int fr, int fq) const {
        const int row0 = u.pm * BM + wr * 64 + fr, col0 = u.pn * BM + wc * WCS + 8 * fq;
        float rs8[8]; if (ACT != 2) row_rstd8(SS, row0, fr, fq, rs8);
#pragma unroll
        for (int ai = 0; ai < 2; ++ai)
#pragma unroll
            for (int m = 0; m < 4; ++m) { const int row = row0 + ai * HALF + m * 16; const float rs = ACT == 2 ? 1.f : rs8[ai * 4 + m];
#pragma unroll
                for (int bj = 0; bj < 2; ++bj) { f32x4 v0 = acc[ai][bj][m][0] * rs, v1 = acc[ai][bj][m][1] * rs;
                    if (ACT == 1) {
#pragma unroll
                        for (int j = 0; j < 4; ++j) { const float t0 = fmaxf(v0[j], 0.f), t1 = fmaxf(v1[j], 0.f); v0[j] = t0 * t0; v1[j] = t1 * t1; } }
                    *(u32x4*)(O + (size_t)row * ldc + (size_t)(u.pm >> bshift) * corr + col0 + bj * BJS) = pack8(v0, v1); } }
    }
};
struct EpiKV {
    static constexpr bool PERM = true, AFTER_DRAIN = false;
    bf16_t* OK; bf16_t* OV;
    __device__ __forceinline__ void operator()(const f32x4 (&acc)[2][2][4][2], const Unit& u, int wr, int wc, int fr, int fq) const {
        const int pn = u.pn & 15; const int tile = ((pn >> 2) * 8 + u.pm) * 4 + (pn & 3);
        bf16_t* base = (u.pn >= 16 ? OV : OK) + (size_t)tile * 65536; const int r0 = wr * 64 + fr, c0 = wc * WCS + 8 * fq;
#pragma unroll
        for (int ai = 0; ai < 2; ++ai)
#pragma unroll
            for (int m = 0; m < 4; ++m)
#pragma unroll
                for (int bj = 0; bj < 2; ++bj) *(u32x4*)(base + (size_t)(r0 + ai * HALF + m * 16) * 256 + c0 + bj * BJS) = pack8(acc[ai][bj][m][0], acc[ai][bj][m][1]);
    }
};
struct EpiNt {
    static constexpr bool PERM = true, AFTER_DRAIN = false;
    bf16_t* O;
    __device__ __forceinline__ void operator()(const f32x4 (&acc)[2][2][4][2], const Unit& u, int wr, int wc, int fr, int fq) const {
        bf16_t* base = O + (size_t)(u.pn >> 2) * (SLAB / 2) + (size_t)u.pm * 256 * 1024 + (u.pn & 3) * 256; const int r0 = wr * 64 + fr, c0 = wc * WCS + 8 * fq;
#pragma unroll
        for (int ai = 0; ai < 2; ++ai)
#pragma unroll
            for (int m = 0; m < 4; ++m)
#pragma unroll
                for (int bj = 0; bj < 2; ++bj) *(u32x4*)(base + (size_t)(r0 + ai * HALF + m * 16) * 1024 + c0 + bj * BJS) = pack8(acc[ai][bj][m][0], acc[ai][bj][m][1]);
    }
};
struct EpiSoftmax {
    static constexpr bool PERM = true, AFTER_DRAIN = true;
    const float* SS; bf16_t* P;
    __device__ __forceinline__ void fused(f32x4 (&acc)[2][2][4][2], const Unit& u, int wr, int wc, int fr, int fq, PG8_LAS unsigned char* lds, int wid, int lane) const {
        PG8_LAS f32x2* T = (PG8_LAS f32x2*)lds;
        float rs8[8]; row_rstd8(SS, u.pm * BM + wr * 64 + fr, fr, fq, rs8);
#pragma unroll
        for (int ai = 0; ai < 2; ++ai)
#pragma unroll
            for (int m = 0; m < 4; ++m) { const float rs = rs8[ai * 4 + m];
#pragma unroll
                for (int bj = 0; bj < 2; ++bj)
#pragma unroll
                    for (int n = 0; n < 2; ++n) acc[ai][bj][m][n] = acc[ai][bj][m][n] * rs;
                float mx = -3.0e38f;
#pragma unroll
                for (int bj = 0; bj < 2; ++bj)
#pragma unroll
                    for (int n = 0; n < 2; ++n) { const f32x4 x = acc[ai][bj][m][n]; mx = fmaxf(mx, fmaxf(fmaxf(x[0], x[1]), fmaxf(x[2], x[3]))); }
                mx = fmaxf(mx, sx(mx, 16, lane)); mx = fmaxf(mx, sx(mx, 32, lane));
                float s = 0.f;
#pragma unroll
                for (int bj = 0; bj < 2; ++bj)
#pragma unroll
                    for (int n = 0; n < 2; ++n) { const f32x4 x = acc[ai][bj][m][n]; s += (__expf(x[0] - mx) + __expf(x[1] - mx)) + (__expf(x[2] - mx) + __expf(x[3] - mx)); }
                s += sx(s, 16, lane); s += sx(s, 32, lane);
                if (fq == 0) T[(ai * HALF + wr * 64 + m * 16 + fr) * 4 + wc] = (f32x2){mx, s}; }
        asm volatile("s_waitcnt lgkmcnt(0)" ::: "memory"); __builtin_amdgcn_s_barrier(); asm volatile("" ::: "memory");
        const int row0 = u.pm * BM + wr * 64 + fr, col0 = u.pn * BM + wc * WCS + 8 * fq;
#pragma unroll
        for (int ai = 0; ai < 2; ++ai)
#pragma unroll
            for (int m = 0; m < 4; ++m) { const int r = ai * HALF + wr * 64 + m * 16 + fr;
                const f32x2 t0 = T[r * 4 + 0], t1 = T[r * 4 + 1], t2 = T[r * 4 + 2], t3 = T[r * 4 + 3];
                const float M = fmaxf(fmaxf(t0.x, t1.x), fmaxf(t2.x, t3.x));
                const float L = (t0.y * __expf(t0.x - M) + t1.y * __expf(t1.x - M)) + (t2.y * __expf(t2.x - M) + t3.y * __expf(t3.x - M));
                const float inv = __builtin_amdgcn_rcpf(L);
#pragma unroll
                for (int bj = 0; bj < 2; ++bj) { f32x4 v0 = acc[ai][bj][m][0], v1 = acc[ai][bj][m][1];
#pragma unroll
                    for (int j = 0; j < 4; ++j) { v0[j] = __expf(v0[j] - M) * inv; v1[j] = __expf(v1[j] - M) * inv; }
                    *(u32x4*)(P + (size_t)(u.pm >> 3) * ((SLAB - 4 * SL_MIB) / 2) + (size_t)(row0 + ai * HALF + m * 16) * 1024 + col0 + bj * BJS) = pack8(v0, v1); } }
    }
};

template <class Epi, class Sched, bool ALIGN_EPI, bool SP2, int MODE>
__device__ __forceinline__ void gemm_phase(PG8_LAS unsigned char* lds, const Gemm g, const Sched& S, const Epi& E, const int tid) {
    const int wid = __builtin_amdgcn_readfirstlane(tid >> 6), lane = tid & 63, wr = wid >> 2, wc = wid & 3, fr = lane & 15, fq = lane >> 4;
    const int K = g.K, nt = K / BK;
    unsigned voffA[2], voffB[2];
#pragma unroll
    for (int i = 0; i < 2; ++i) { int R, C; stage_rc(tid * 16 + i * 8192, R, C); const int Rb = Epi::PERM ? ((R >> 5) * WCS + perm32(R & 31)) : R;
        voffA[i] = (unsigned)(R * g.lda + C) * 2u; voffB[i] = (unsigned)(Rb * g.ldb + C) * 2u; }
    const size_t kstep = (size_t)(BK * 2);
    const size_t hstepA = (size_t)HALF * g.lda * 2, hstepB = (size_t)(Epi::PERM ? BJS : HALF) * g.ldb * 2;
    const unsigned ldsw = (unsigned)wid * 1024u;
    const int aoff = lds_byte(wr * 64 + fr, fq * 8), boff = lds_byte(wc * 32 + fr, fq * 8);
#define PG8_SA(b, h) (((b) * 2 + (h)) * HTB)
#define PG8_SB(b, h) ((4 + (b) * 2 + (h)) * HTB)
#define PG8_STAGE(bufoff, gbase, voff) do { _Pragma("unroll") for (int _i = 0; _i < 2; ++_i) \
        __builtin_amdgcn_global_load_lds((const unsigned*)((const char*)(gbase) + (voff)[_i]), (PG8_LAS unsigned*)(lds + (bufoff) + ldsw + _i * 8192), 16, 0, 0); } while (0)
#define PG8_LDA(dst, b, h) do { _Pragma("unroll") for (int m = 0; m < 4; ++m) _Pragma("unroll") for (int k = 0; k < 2; ++k) dst[m][k] = *(const PG8_LAS bf16x8*)(lds + PG8_SA(b, h) + aoff + m * 2048 + k * 1024); } while (0)
#define PG8_LDB(dst, b, h) do { _Pragma("unroll") for (int n = 0; n < 2; ++n) _Pragma("unroll") for (int k = 0; k < 2; ++k) dst[n][k] = *(const PG8_LAS bf16x8*)(lds + PG8_SB(b, h) + boff + n * 2048 + k * 1024); } while (0)
#define PG8_MMA(ai, bj, At, Bt) do { __builtin_amdgcn_s_setprio(1); _Pragma("unroll") for (int m = 0; m < 4; ++m) _Pragma("unroll") for (int n = 0; n < 2; ++n) _Pragma("unroll") for (int k = 0; k < 2; ++k) \
        acc[ai][bj][m][n] = __builtin_amdgcn_mfma_f32_16x16x32_bf16(Bt[n][k], At[m][k], acc[ai][bj][m][n], 0, 0, 0); __builtin_amdgcn_s_setprio(0); } while (0)
#define PG8_WAIT_V(n) asm volatile("s_waitcnt vmcnt(" #n ")" ::: "memory")
#define PG8_WAIT_L(n) asm volatile("s_waitcnt lgkmcnt(" #n ")" ::: "memory")
#define PG8_BAR __builtin_amdgcn_s_barrier()
#define PG8_SCHED __builtin_amdgcn_sched_barrier(0)
    Unit cur, nxt; int ui = 0;
    if (!S.next(0, cur)) return;
    f32x4 acc[2][2][4][2];
#pragma unroll
    for (int a = 0; a < 2; ++a)
#pragma unroll
        for (int b = 0; b < 2; ++b)
#pragma unroll
            for (int m = 0; m < 4; ++m)
#pragma unroll
                for (int n = 0; n < 2; ++n) acc[a][b][m][n] = (f32x4){0.f, 0.f, 0.f, 0.f};
    bf16x8 At[4][2], B0[2][2], B1[2][2];
    const char* cA = a_base<MODE>(g, cur); const char* cB = b_base<MODE>(g, cur);
    S.a_ready(cur);
    if constexpr (SP2) {
        PG8_STAGE(PG8_SB(0, 0), cB, voffB); PG8_STAGE(PG8_SB(0, 1), cB + hstepB, voffB); PG8_STAGE(PG8_SA(0, 0), cA, voffA); PG8_STAGE(PG8_SA(0, 1), cA + hstepA, voffA);
        if (wr == 1) PG8_BAR;
        PG8_WAIT_V(2); PG8_BAR;
        PG8_STAGE(PG8_SB(1, 0), cB + kstep, voffB); PG8_STAGE(PG8_SA(1, 0), cA + kstep, voffA); PG8_STAGE(PG8_SB(1, 1), cB + hstepB + kstep, voffB);
        PG8_WAIT_V(6); PG8_BAR;
    } else {
        PG8_STAGE(PG8_SB(0, 0), cB, voffB); PG8_STAGE(PG8_SA(0, 0), cA, voffA); PG8_STAGE(PG8_SB(0, 1), cB + hstepB, voffB); PG8_STAGE(PG8_SA(0, 1), cA + hstepA, voffA);
        if (wr == 1) PG8_BAR;
        PG8_WAIT_V(4); PG8_BAR;
        PG8_STAGE(PG8_SB(1, 0), cB + kstep, voffB); PG8_STAGE(PG8_SA(1, 0), cA + kstep, voffA); PG8_STAGE(PG8_SB(1, 1), cB + hstepB + kstep, voffB);
        PG8_WAIT_V(6); PG8_BAR;
    }
    for (;;) {
        const bool has_next = S.next(ui + 1, nxt);
        const char* nA = has_next ? a_base<MODE>(g, nxt) : cA; const char* nB = has_next ? b_base<MODE>(g, nxt) : cB;
        for (int t = 0; t < nt; t += 2) {
            const bool last = (t == nt - 2);
            const char* a1 = cA + (size_t)(t + 1) * kstep + ((MODE == 2 && t + 1 >= 8) ? g.ajump : (size_t)0);
            const char* a2 = last ? nA : cA + (size_t)(t + 2) * kstep + ((MODE == 2 && t + 2 >= 8) ? g.ajump : (size_t)0); const char* b2 = last ? nB : cB + (size_t)(t + 2) * kstep;
            const char* a3 = (MODE == 2 && !last) ? cA + (size_t)(t + 3) * kstep + ((t + 3 >= 8) ? g.ajump : (size_t)0) : a2 + kstep; const char* b3 = b2 + kstep;
            if (last && has_next) S.a_ready(nxt);
            if constexpr (SP2) {
            PG8_LDB(B0, 0, 0); PG8_LDB(B1, 0, 1); PG8_SCHED; PG8_LDA(At, 0, 0); PG8_STAGE(PG8_SA(1, 1), a1 + hstepA, voffA);
            PG8_WAIT_V(8); PG8_WAIT_L(0); PG8_BAR; PG8_MMA(0, 0, At, B0); PG8_MMA(0, 1, At, B1); PG8_BAR; PG8_SCHED;
            PG8_LDA(At, 0, 1); PG8_STAGE(PG8_SB(0, 0), b2, voffB); PG8_STAGE(PG8_SB(0, 1), b2 + hstepB, voffB); PG8_STAGE(PG8_SA(0, 0), a2, voffA);
            PG8_WAIT_V(8); PG8_WAIT_L(0); PG8_BAR; PG8_MMA(1, 0, At, B0); PG8_MMA(1, 1, At, B1); PG8_BAR; PG8_SCHED;
            PG8_LDB(B0, 1, 0); PG8_LDB(B1, 1, 1); PG8_SCHED; PG8_LDA(At, 1, 0); PG8_STAGE(PG8_SA(0, 1), a2 + hstepA, voffA);
            PG8_WAIT_V(8); PG8_WAIT_L(0); PG8_BAR; PG8_MMA(0, 0, At, B0); PG8_MMA(0, 1, At, B1); PG8_BAR; PG8_SCHED;
            PG8_LDA(At, 1, 1); PG8_STAGE(PG8_SB(1, 0), b3, voffB); PG8_STAGE(PG8_SB(1, 1), b3 + hstepB, voffB); PG8_STAGE(PG8_SA(1, 0), a3, voffA);
            PG8_WAIT_V(8); PG8_WAIT_L(0); PG8_BAR; PG8_MMA(1, 0, At, B0); PG8_MMA(1, 1, At, B1); PG8_BAR; PG8_SCHED;
            } else {
            PG8_LDB(B0, 0, 0); PG8_SCHED; PG8_LDA(At, 0, 0); PG8_STAGE(PG8_SA(1, 1), a1 + hstepA, voffA);
            PG8_WAIT_L(8); PG8_BAR; PG8_WAIT_L(0); PG8_MMA(0, 0, At, B0); PG8_BAR; PG8_SCHED;
            PG8_LDB(B1, 0, 1); PG8_STAGE(PG8_SB(0, 0), b2, voffB);
            PG8_BAR; PG8_WAIT_L(0); PG8_MMA(0, 1, At, B1); PG8_BAR;
            PG8_LDA(At, 0, 1); PG8_STAGE(PG8_SA(0, 0), a2, voffA);
            PG8_BAR; PG8_WAIT_L(0); PG8_MMA(1, 0, At, B0); PG8_BAR; PG8_SCHED;
            PG8_STAGE(PG8_SB(0, 1), b2 + hstepB, voffB);
            PG8_WAIT_V(6); PG8_BAR; PG8_MMA(1, 1, At, B1); PG8_BAR;
            PG8_LDB(B0, 1, 0); PG8_SCHED; PG8_LDA(At, 1, 0); PG8_STAGE(PG8_SA(0, 1), a2 + hstepA, voffA);
            PG8_WAIT_L(8); PG8_BAR; PG8_WAIT_L(0); PG8_MMA(0, 0, At, B0); PG8_BAR; PG8_SCHED;
            PG8_LDB(B1, 1, 1); PG8_STAGE(PG8_SB(1, 0), b3, voffB);
            PG8_BAR; PG8_WAIT_L(0); PG8_MMA(0, 1, At, B1); PG8_BAR;
            PG8_LDA(At, 1, 1); PG8_STAGE(PG8_SA(1, 0), a3, voffA);
            PG8_BAR; PG8_WAIT_L(0); PG8_MMA(1, 0, At, B0); PG8_BAR; PG8_SCHED;
            PG8_STAGE(PG8_SB(1, 1), b3 + hstepB, voffB);
            PG8_WAIT_V(6); PG8_BAR; PG8_MMA(1, 1, At, B1); PG8_BAR;
            }
        }
        if constexpr (ALIGN_EPI) { if (wr == 0) PG8_BAR; }
        if constexpr (!Epi::AFTER_DRAIN) { int l2; asm volatile("v_mbcnt_lo_u32_b32 %0, -1, 0\n\tv_mbcnt_hi_u32_b32 %0, -1, %0" : "=v"(l2));
            E(acc, cur, wr, wc, l2 & 15, l2 >> 4); S.done(cur); }
        if (!has_next) break;
#pragma unroll
        for (int a = 0; a < 2; ++a)
#pragma unroll
            for (int b = 0; b < 2; ++b)
#pragma unroll
                for (int m = 0; m < 4; ++m)
#pragma unroll
                    for (int n = 0; n < 2; ++n) acc[a][b][m][n] = (f32x4){0.f, 0.f, 0.f, 0.f};
        cur = nxt; cA = nA; cB = nB; ++ui;
        if constexpr (ALIGN_EPI) { if (wr == 1) PG8_BAR; }
    }
    PG8_WAIT_V(0);
    if constexpr (!ALIGN_EPI) { if (wr == 0) PG8_BAR; }
    PG8_BAR;
    if constexpr (Epi::AFTER_DRAIN) { int l2; asm volatile("v_mbcnt_lo_u32_b32 %0, -1, 0\n\tv_mbcnt_hi_u32_b32 %0, -1, %0" : "=v"(l2)); E.fused(acc, cur, wr, wc, l2 & 15, l2 >> 4, lds, wid, l2); S.done(cur); }
#undef PG8_SA
#undef PG8_SB
#undef PG8_STAGE
#undef PG8_LDA
#undef PG8_LDB
#undef PG8_MMA
#undef PG8_WAIT_V
#undef PG8_WAIT_L
#undef PG8_BAR
#undef PG8_SCHED
}
}

constexpr int NWAVES = 8, NTHREADS = 512;
constexpr int DM = 1024, NB = 8, SEQ = 2048, DEPTH = 4, MEMLEN = 256, DIN = 4624, DINP = 4864, DFF = 4096;
constexpr int M = NB * SEQ;
constexpr int MMEM = NB * MEMLEN;

constexpr size_t MiB = 1u << 20;
constexpr size_t WS_CTL = 0, CTL_ZERO_BYTES = 1 * MiB;
constexpr size_t WS_SS = 2 * MiB;
constexpr size_t WS_LB = 3 * MiB;
constexpr size_t WS_W = 4 * MiB;
constexpr size_t WO_IN = 0, WO_OUT = 10 * MiB, WO_XQ = 12 * MiB, WO_XO = 14 * MiB, WO_UP = 16 * MiB, WO_DOWN = 24 * MiB;
constexpr size_t WS_KX = 36 * MiB, WS_VT = 52 * MiB;
constexpr size_t WS_XB = 68 * MiB;
constexpr size_t WS_R = 100 * MiB;
constexpr size_t SLAB = pg8::SLAB;
constexpr size_t S_QH = 0, S_VH = 2 * MiB, S_GG = 4 * MiB, S_MQ = 6 * MiB, S_MK = 8 * MiB, S_MV = 10 * MiB, S_MO = 12 * MiB,
                 S_GT = pg8::SL_GT, S_LF = pg8::SL_LF, S_OF = pg8::SL_OF, S_OB = pg8::SL_OB;
constexpr size_t S_P = 0, S_MT = S_MQ, S_NT = S_MK;
constexpr size_t S_H = 0;
constexpr size_t R_END = 8 * SLAB;
constexpr size_t OT_MEMB = 32 * MiB, OT_WKT = 36 * MiB, OT_WVT = 44 * MiB;
constexpr size_t WS_W2 = WS_R + R_END;
constexpr size_t WS_END = WS_W2 + 32 * MiB;
constexpr int CW_BAR = 4096;
constexpr int RING_BYTES = 131072, LDSCTL_OFF = 161792, MISC_OFF = LDSCTL_OFF + 320, LDS_BYTES = 163840;

#define GAS __attribute__((address_space(1)))
#define LAS __attribute__((address_space(3)))
typedef unsigned short bf16;
typedef unsigned v4u __attribute__((ext_vector_type(4)));
typedef float f32x4 __attribute__((ext_vector_type(4)));
#define LDS_WAIT() asm volatile("s_waitcnt lgkmcnt(0)" ::: "memory")
#define VM_WAIT() asm volatile("s_waitcnt vmcnt(0)" ::: "memory")
__device__ __forceinline__ unsigned f2bf(float f) { unsigned u = __builtin_bit_cast(unsigned, f); return (u + 0x7fffu + ((u >> 16) & 1u)) >> 16; }
__device__ __forceinline__ unsigned pk2(float lo, float hi) { return f2bf(lo) | (f2bf(hi) << 16); }
__device__ __forceinline__ float bf2f(unsigned short b) { return __builtin_bit_cast(float, (unsigned)b << 16); }
__device__ __forceinline__ float bflo(unsigned w) { return __builtin_bit_cast(float, w << 16); }
__device__ __forceinline__ float bfhi(unsigned w) { return __builtin_bit_cast(float, w & 0xffff0000u); }

#define XB_TMO      128
#define XB_XCNT(j)  (256  + 64 * (j))
#define XB_XSUB(j)  (1280 + 64 * (j))
#define XB_XGEN(j)  (2304 + 64 * (j))
#define XB_TOP      3328
#define XB_TOPGEN   3392
#define XCD_BAR_WORDS 3456
#define XB_LFLAG(j) (3456 + 64 * (j))
#define XB_SPIN_CAP (1u << 18)

__device__ __forceinline__ unsigned xb_ld(unsigned* p)              { return __hip_atomic_load(p, __ATOMIC_RELAXED, __HIP_MEMORY_SCOPE_AGENT); }
__device__ __forceinline__ unsigned xb_add(unsigned* p, unsigned v) { return __hip_atomic_fetch_add(p, v, __ATOMIC_RELAXED, __HIP_MEMORY_SCOPE_AGENT); }
__device__ __forceinline__ unsigned xb_xcc_id() { return (unsigned)__builtin_amdgcn_s_getreg((3 << 11) | 20) & 0xFu; }
#define XB_SPIN(cond, bar) do { unsigned _sp = 0; while (cond) { __builtin_amdgcn_s_sleep(1); \
    if ((++_sp & 255u) == 0u) { if (xb_ld(&(bar)[XB_TMO])) break; if (_sp > XB_SPIN_CAP) { atomicAdd(&(bar)[XB_TMO], 1u); break; } } } } while (0)

struct XcdBarrier {
    unsigned* bar; unsigned x;
    volatile LAS unsigned* st;
};

__device__ __forceinline__ XcdBarrier xcd_barrier_post(unsigned* bar, volatile LAS unsigned* st, int tid) {
    XcdBarrier b; b.bar = bar; b.x = xb_xcc_id(); b.st = st;
    if (tid == 0) st[3] = xb_add(&bar[XB_XCNT(b.x)], 1u);
    return b;
}
__device__ __forceinline__ void xcd_barrier_complete(unsigned* bar, unsigned x, unsigned& nloc, unsigned& nx, unsigned& uni) {
    const unsigned G = gridDim.x * gridDim.y * gridDim.z;
    unsigned sum, cnt, mine, sp = 0u;
    for (;;) {
        sum = 0u; cnt = 0u; mine = 0u; uni = 1u;
#pragma unroll
        for (unsigned j = 0; j < 16; ++j) { const unsigned c = xb_ld(&bar[XB_XCNT(j)]); sum += c; cnt += (c > 0u) ? 1u : 0u; mine = (j == x) ? c : mine; uni &= (c == (j < 8u ? 32u : 0u)) ? 1u : 0u; }
        if (sum == G) break;
        __builtin_amdgcn_s_sleep(1);
        if ((++sp & 255u) == 0u) { if (xb_ld(&bar[XB_TMO])) break; if (sp > XB_SPIN_CAP) { atomicAdd(&bar[XB_TMO], 1u); break; } }
    }
    nloc = mine > 0u ? mine : 1u; nx = cnt > 0u ? cnt : 1u; if (sum != G || G != 256u) uni = 0u;
}

template <bool LOCAL> __device__ __forceinline__ void xcd_barrier(const XcdBarrier& b, int tid) {
    if (LOCAL) {
        asm volatile("s_waitcnt vmcnt(0)" ::: "memory");
        __syncthreads();
        if (tid < 64) {
            unsigned* fl = b.bar + XB_LFLAG(b.x);
            const unsigned n = __builtin_amdgcn_readfirstlane(b.st[4]) + 1u;
            if (tid == 0) { b.st[4] = n; __hip_atomic_store(fl + b.st[3], n, __ATOMIC_RELAXED, __HIP_MEMORY_SCOPE_WORKGROUP); }
            unsigned sp = 0u;
            for (;;) { const unsigned v = tid < 32 ? xb_ld(fl + tid) : n;
                if (__builtin_amdgcn_ballot_w64(v < n) == 0ull) break;
                __builtin_amdgcn_s_sleep(1);
                if ((++sp & 255u) == 0u) { if (xb_ld(&b.bar[XB_TMO])) break; if (sp > XB_SPIN_CAP) { if (tid == 0) atomicAdd(&b.bar[XB_TMO], 1u); break; } } }
            __builtin_amdgcn_fence(__ATOMIC_ACQUIRE, "agent");
            asm volatile("s_waitcnt vmcnt(0)" ::: "memory");
        }
        __syncthreads();
        return;
    }
    asm volatile("s_waitcnt vmcnt(0)" ::: "memory");
    __syncthreads();
    if (tid == 0) {
        unsigned* bar = b.bar;
        __builtin_amdgcn_s_waitcnt(0);
        unsigned nloc = b.st[0], nx = b.st[1];
        if (nloc == 0u) { unsigned uni_; xcd_barrier_complete(bar, b.x, nloc, nx, uni_); b.st[0] = nloc; b.st[1] = nx; b.st[2] = uni_; }
        const unsigned old = xb_add(&bar[XB_XSUB(b.x)], 1u);
        const unsigned gen = old / nloc;
        if (old + 1u == (gen + 1u) * nloc) {
            __builtin_amdgcn_fence(__ATOMIC_RELEASE, "agent");
            asm volatile("s_waitcnt vmcnt(0)" ::: "memory");
            const unsigned og = xb_add(&bar[XB_TOP], 1u);
            const unsigned tg = og / nx;
            if (og + 1u == (tg + 1u) * nx) xb_add(&bar[XB_TOPGEN], 1u);
            else XB_SPIN(xb_ld(&bar[XB_TOPGEN]) == tg, bar);
            __builtin_amdgcn_fence(__ATOMIC_ACQUIRE, "agent");
            xb_add(&bar[XB_XGEN(b.x)], 1u);
            asm volatile("s_waitcnt vmcnt(0)" ::: "memory");
        } else {
            XB_SPIN(xb_ld(&bar[XB_XGEN(b.x)]) == gen, bar);
            __builtin_amdgcn_fence(__ATOMIC_ACQUIRE, "agent");
            asm volatile("s_waitcnt vmcnt(0)" ::: "memory");
        }
    }
    __syncthreads();
}

struct Args { const float* in[20]; float* out; unsigned char* ws; };
typedef const __attribute__((address_space(4))) Args* KArgs;
__device__ __forceinline__ KArgs fresh_args() { KArgs p = (KArgs)__builtin_amdgcn_kernarg_segment_ptr(); asm volatile("" : "+s"(p)); return p; }
__device__ __forceinline__ int fresh_tid(int wave_s) { int t; asm volatile("v_mbcnt_lo_u32_b32 %0, -1, 0\n\tv_mbcnt_hi_u32_b32 %0, -1, %0" : "=v"(t)); return (wave_s << 6) | t; }
enum { I_X = 0, I_MEM, I_NMIX, I_NXATTN, I_NMEM, I_NMLP, I_NFINAL, I_WIN, I_BIN, I_LBLOG, I_HNORM, I_CONVW, I_CONVB, I_MNORM, I_WOUT, I_WXQ, I_WXKV, I_WXO, I_WUP, I_WDOWN };

__device__ __forceinline__ float wave_sum(float v, int lane) {
#pragma unroll
    for (int o = 1; o < 64; o <<= 1) v += pg8::sx(v, o, lane);
    return v;
}
__device__ __forceinline__ void transpose_item(const float* W, int ldw, int nvalid, bf16* WT, int ldt, const float* g, float scale, float* scr, int item, int nblk, int lane) {
    const int kb = item / nblk, nb = item % nblk, k0 = 64 * kb, n0 = 32 * nb; const int n = n0 + (lane & 31);
    float vv_[32];
    const bool ok_ = n < nvalid; const float* wp_ = W + (size_t)(k0 + (lane >> 5)) * ldw + (ok_ ? n : 0);
#pragma unroll
    for (int i = 0; i < 32; ++i) vv_[i] = wp_[(size_t)(2 * i) * ldw];
#pragma unroll
    for (int i = 0; i < 32; ++i) { const int kk = 2 * i + (lane >> 5); float v = ok_ ? vv_[i] * scale : 0.f; if (g) v *= g[k0 + kk];
        scr[kk * 33 + (lane & 31)] = v; }
    LDS_WAIT(); asm volatile("" ::: "memory");
    const int c = lane & 7;
#pragma unroll
    for (int j = 0; j < 4; ++j) { const int nn = (lane >> 3) + 8 * j; const float* s = scr + (8 * c) * 33 + nn;
        v4u o; o.x = pk2(s[0 * 33], s[1 * 33]); o.y = pk2(s[2 * 33], s[3 * 33]); o.z = pk2(s[4 * 33], s[5 * 33]); o.w = pk2(s[6 * 33], s[7 * 33]);
        *(v4u*)(WT + (size_t)(n0 + nn) * ldt + k0 + 8 * c) = o; }
    LDS_WAIT(); asm volatile("" ::: "memory");
}
__device__ __forceinline__ void convert_layer(KArgs a, int l, unsigned char* lds, int gw, int ngw, int wave, int lane) {
    float* scr = (float*)(lds + wave * 16384);
    bf16* W = (bf16*)(a->ws + ((l & 1) ? WS_W2 : WS_W));
    constexpr int I_A = 16 * (DINP / 32), I_B = 16 * 32, I_U = 16 * (DFF / 32), I_D = 64 * 32;
    constexpr int NIT = I_A + 2 * I_B + I_U + I_D;
    for (int it = gw; it < NIT; it += ngw) {
        int r = it;
        if (r < I_A) { transpose_item(a->in[I_WIN] + (size_t)l * DM * DIN, DIN, DIN, W + WO_IN / 2, DM, a->in[I_NMIX] + l * DM, 1.f, scr, r, DINP / 32, lane); continue; } r -= I_A;
        if (r < I_B) { transpose_item(a->in[I_WOUT] + (size_t)l * DM * DM, DM, DM, W + WO_OUT / 2, DM, nullptr, 1.f, scr, r, 32, lane); continue; } r -= I_B;
        if (r < I_B) { transpose_item(a->in[I_WXO] + (size_t)l * DM * DM, DM, DM, W + WO_XO / 2, DM, nullptr, 1.f, scr, r, 32, lane); continue; } r -= I_B;
        if (r < I_U) { transpose_item(a->in[I_WUP] + (size_t)l * DM * DFF, DFF, DFF, W + WO_UP / 2, DM, a->in[I_NMLP] + l * DM, 1.f, scr, r, DFF / 32, lane); continue; } r -= I_U;
        transpose_item(a->in[I_WDOWN] + (size_t)l * DFF * DM, DM, DM, W + WO_DOWN / 2, DFF, nullptr, 1.f, scr, r, 32, lane);
    }
    { const float* Wq = a->in[I_WXQ] + (size_t)l * DM * DM; const float* gq = a->in[I_NXATTN] + l * DM; bf16* O = W + WO_XQ / 2;
      for (int k = gw; k < DM; k += ngw) { const f32x4* xr = (const f32x4*)(Wq + (size_t)k * DM) + lane; const float sc = gq[k] * 0.0625f; unsigned long long* o8 = (unsigned long long*)(O + (size_t)k * DM) + lane;
#pragma unroll
          for (int j = 0; j < 4; ++j) { const f32x4 v = xr[64 * j] * sc; o8[64 * j] = (unsigned long long)pk2(v[0], v[1]) | ((unsigned long long)pk2(v[2], v[3]) << 32); } } }
}
__device__ __forceinline__ void prologue(KArgs a, unsigned char* lds, int gw, int ngw, int wave, int lane, int tid) {
    if (blockIdx.x == 0) { float* LB = (float*)(a->ws + WS_LB);
        for (int i = tid; i < 2 * 512; i += NTHREADS) { const int dir = i >> 9, c = i & 511; const float* lg = a->in[I_LBLOG] + (size_t)dir * DEPTH * 512 + c;
            const float l0 = lg[0], l1 = lg[512], l2 = lg[1024], l3 = lg[1536]; const float mx = fmaxf(fmaxf(l0, l1), fmaxf(l2, l3));
            const float e0 = expf(l0 - mx), e1 = expf(l1 - mx), e2 = expf(l2 - mx), e3 = expf(l3 - mx); const float inv = 1.f / (e0 + e1 + e2 + e3);
            LB[(0 * 2 + dir) * 512 + c] = 0.f; LB[(1 * 2 + dir) * 512 + c] = e1 * inv; LB[(2 * 2 + dir) * 512 + c] = (e1 + e2) * inv; LB[(3 * 2 + dir) * 512 + c] = (e1 + e2 + e3) * inv; } }
    { bf16* XB = (bf16*)(a->ws + WS_XB); float* SS = (float*)(a->ws + WS_SS); const float* x = a->in[I_X];
      for (int m = gw; m < M; m += ngw) { const f32x4* xr = (const f32x4*)(x + (size_t)m * DM) + lane; f32x4 v[4]; float s = 0.f;
#pragma unroll
          for (int j = 0; j < 4; ++j) { v[j] = xr[64 * j]; s += (v[j][0] * v[j][0] + v[j][1] * v[j][1]) + (v[j][2] * v[j][2] + v[j][3] * v[j][3]); }
          s = wave_sum(s, lane);
          unsigned long long* o8 = (unsigned long long*)(XB + (size_t)m * DM) + lane;
#pragma unroll
          for (int j = 0; j < 4; ++j) o8[64 * j] = (unsigned long long)pk2(v[j][0], v[j][1]) | ((unsigned long long)pk2(v[j][2], v[j][3]) << 32);
          if (lane < 16) SS[(size_t)m * 16 + lane] = lane == 0 ? s : 0.f; } }
    { bf16* MB = (bf16*)((unsigned char*)a->out + OT_MEMB); const float* x = a->in[I_MEM];
      for (int m = gw; m < MMEM; m += ngw) { const f32x4* xr = (const f32x4*)(x + (size_t)m * DM) + lane; f32x4 v[4]; float s = 0.f;
#pragma unroll
          for (int j = 0; j < 4; ++j) { v[j] = xr[64 * j]; s += (v[j][0] * v[j][0] + v[j][1] * v[j][1]) + (v[j][2] * v[j][2] + v[j][3] * v[j][3]); }
          const float rs = 1.0f / sqrtf(wave_sum(s, lane) * (1.0f / DM) + 1e-6f);
          unsigned long long* o8 = (unsigned long long*)(MB + (size_t)m * DM) + lane;
#pragma unroll
          for (int j = 0; j < 4; ++j) o8[64 * j] = (unsigned long long)pk2(v[j][0] * rs, v[j][1] * rs) | ((unsigned long long)pk2(v[j][2] * rs, v[j][3] * rs) << 32); } }
    { float* scr = (float*)(lds + wave * 16384); bf16* WKT = (bf16*)((unsigned char*)a->out + OT_WKT); bf16* WVT = (bf16*)((unsigned char*)a->out + OT_WVT);
      for (int it = gw; it < DEPTH * 2 * 512; it += ngw) { const int l = it >> 10, part = (it >> 9) & 1, r = it & 511;
          transpose_item(a->in[I_WXKV] + (size_t)l * DM * 2048 + part * 1024, 2048, 1024, (part ? WVT : WKT) + (size_t)l * 1024 * DM, DM, a->in[I_NMEM] + l * DM, 1.f, scr, r, 32, lane); } }
    convert_layer(a, 0, lds, gw, ngw, wave, lane);
}
__device__ __forceinline__ void final_phase(KArgs a, int gw, int ngw, int lane) {
    const float* g = a->in[I_NFINAL] + lane * 16; const bf16* XB = (const bf16*)(a->ws + WS_XB);
    f32x4 gg[4];
#pragma unroll
    for (int j = 0; j < 4; ++j) gg[j] = *(const f32x4*)(g + 4 * j);
    for (int m = gw; m < M; m += ngw) { const v4u w0 = *(const v4u*)(XB + (size_t)m * DM + lane * 16), w1 = *(const v4u*)(XB + (size_t)m * DM + lane * 16 + 8);
        float x[16]; float s = 0.f;
#pragma unroll
        for (int j = 0; j < 4; ++j) { x[2 * j] = bflo(w0[j]); x[2 * j + 1] = bfhi(w0[j]); x[8 + 2 * j] = bflo(w1[j]); x[8 + 2 * j + 1] = bfhi(w1[j]); }
#pragma unroll
        for (int j = 0; j < 16; ++j) s += x[j] * x[j];
        const float rs = 1.0f / sqrtf(wave_sum(s, lane) * (1.0f / DM) + 1e-6f);
        f32x4* o = (f32x4*)(a->out + (size_t)m * DM + lane * 16);
#pragma unroll
        for (int j = 0; j < 4; ++j) o[j] = (f32x4){x[4 * j] * rs * gg[j][0], x[4 * j + 1] * rs * gg[j][1], x[4 * j + 2] * rs * gg[j][2], x[4 * j + 3] * rs * gg[j][3]}; }
}
namespace sc {
typedef short bf16x8 __attribute__((ext_vector_type(8)));
typedef float f32x4 __attribute__((ext_vector_type(4)));
typedef float f32x2 __attribute__((ext_vector_type(2)));
typedef unsigned u32x2 __attribute__((ext_vector_type(2)));
constexpr int LQ = 272, LS = 144;
constexpr int O_QS = 0, O_KS = O_QS + 64 * LQ, O_KDT = O_KS + 64 * LQ, O_VT = O_KDT + 128 * LS, O_KDT1 = O_VT + 64 * LS, O_VT1 = O_KDT1 + 128 * LS, O_P = O_VT1 + 64 * LS, O_ST = O_P + 64 * LS, O_SEG = O_ST + 80 * LQ,
              O_DEC = O_SEG + 4096, O_SCAL = O_DEC + 1024, O_NV = O_SCAL + 3072, O_PRE = O_NV + 1024, O_END = O_PRE + 3 * 32 * 64 * 4;
static_assert(O_END <= LDSCTL_OFF, "scan LDS map");
#define SC_BAR() do { __builtin_amdgcn_sched_barrier(0); asm volatile("s_waitcnt lgkmcnt(0)" ::: "memory"); __builtin_amdgcn_s_barrier(); asm volatile("" ::: "memory"); __builtin_amdgcn_sched_barrier(0); } while (0)
__device__ __forceinline__ bf16x8 frag(const unsigned char* base, int row, int pitch, int kbyte) { return *(const bf16x8*)(base + row * pitch + kbyte); }
__device__ __forceinline__ unsigned cvt2(float lo, float hi) { return pg8::cvt_pk_bf16(lo, hi); }
typedef _Float16 h2_t __attribute__((ext_vector_type(2)));
__device__ __forceinline__ f32x2 h2f(unsigned w) { return __builtin_convertvector(__builtin_bit_cast(h2_t, w), f32x2); }

constexpr int CW_CONV = 8192;
template <int NF> __device__ __forceinline__ void head_sync(unsigned* cnt, unsigned want, int slot, unsigned n, int mode, int tid, int uni);
__device__ __forceinline__ void mlstm_conv_part(KArgs a, int l, int b, int h, int part, int tid, int uni) {
    const int pair = tid & 127, which = pair >> 6, dp = pair & 63, rr = tid >> 7;
    unsigned char* R = a->ws + WS_R;
    const unsigned* src = (const unsigned*)((const bf16*)(R + (size_t)b * SLAB + (which ? S_MK : S_MQ)) + h * 128);
    unsigned* dst = (unsigned*)((bf16*)((unsigned char*)a->out + (which ? 16 * MiB : 0)) + h * 128) + (size_t)b * SEQ * 256;
    const float* cw = a->in[I_CONVW] + (size_t)l * 5 * 1024 + which * 512 + h * 128 + 2 * dp; const float* cb = a->in[I_CONVB] + (size_t)l * 1024 + which * 512 + h * 128 + 2 * dp;
    f32x2 w[5]; const f32x2 bias = *(const f32x2*)cb; const float sc = which ? 0.08838834764831845f : 1.0f;
#pragma unroll
    for (int j = 0; j < 5; ++j) w[j] = *(const f32x2*)(cw + j * 1024);
    const int t0 = 256 * part + 64 * rr;
    f32x2 x0, x1, x2, x3;
    { const unsigned z = 0u; const unsigned a0 = t0 >= 2 ? src[(size_t)(t0 - 2) * 256 + dp] : z, a1 = t0 >= 1 ? src[(size_t)(t0 - 1) * 256 + dp] : z, a2 = src[(size_t)t0 * 256 + dp], a3 = src[(size_t)(t0 + 1) * 256 + dp];
      x0 = (f32x2){bflo(a0), bfhi(a0)}; x1 = (f32x2){bflo(a1), bfhi(a1)}; x2 = (f32x2){bflo(a2), bfhi(a2)}; x3 = (f32x2){bflo(a3), bfhi(a3)}; }
#pragma unroll 1
    for (int tb = 0; tb < 64; tb += 8) { unsigned raw[8];
#pragma unroll
        for (int i = 0; i < 8; ++i) { const int tn = t0 + tb + i + 2; raw[i] = src[(size_t)(tn < SEQ ? tn : SEQ - 1) * 256 + dp]; }
#pragma unroll
        for (int i = 0; i < 8; ++i) { const int t = t0 + tb + i; const f32x2 x4 = (t + 2 < SEQ) ? (f32x2){bflo(raw[i]), bfhi(raw[i])} : (f32x2){0.f, 0.f};
            const f32x2 y = bias + w[0] * x0 + w[1] * x1 + w[2] * x2 + w[3] * x3 + w[4] * x4;
            dst[(size_t)t * 256 + dp] = cvt2(y.x * pg8::sigm(y.x) * sc, y.y * pg8::sigm(y.y) * sc);
            x0 = x1; x1 = x2; x2 = x3; x3 = x4; } }
    head_sync<8>((unsigned*)(a->ws + WS_CTL) + CW_CONV + 64 * (4 * b + h), 8u * (unsigned)(l + 1), part, (unsigned)(l + 1), 0, tid, uni);
}

constexpr int CW_MIX = 12288;
template <int NF> __device__ __forceinline__ void head_sync(unsigned* cnt, unsigned want, int slot, unsigned n, int mode, int tid, int uni) {
    const bool post = mode != 2, wait = mode != 0;
    if (post) { asm volatile("s_waitcnt vmcnt(0)" ::: "memory"); __syncthreads(); }
    if (uni) {
        if (tid < 64) { unsigned* fl = cnt + 8;
            if (tid == 0 && post) __hip_atomic_store(fl + slot, n, __ATOMIC_RELAXED, __HIP_MEMORY_SCOPE_WORKGROUP);
            unsigned spins = 0;
            if (wait) for (;;) { const unsigned v = tid < NF ? __hip_atomic_load(fl + tid, __ATOMIC_RELAXED, __HIP_MEMORY_SCOPE_AGENT) : n;
                if (__builtin_amdgcn_ballot_w64(v < n) == 0ull) break;
                __builtin_amdgcn_s_sleep(1); if (++spins > (1u << 22)) break; }
            if (wait) { __builtin_amdgcn_fence(__ATOMIC_ACQUIRE, "agent"); asm volatile("s_waitcnt vmcnt(0)" ::: "memory"); } }
    } else if (tid == 0) { if (post) { __builtin_amdgcn_fence(__ATOMIC_RELEASE, "agent"); asm volatile("s_waitcnt vmcnt(0)" ::: "memory");
        __hip_atomic_fetch_add(cnt, 1u, __ATOMIC_RELAXED, __HIP_MEMORY_SCOPE_AGENT); } unsigned spins = 0;
        if (wait) { while (__hip_atomic_load(cnt, __ATOMIC_RELAXED, __HIP_MEMORY_SCOPE_AGENT) < want) { __builtin_amdgcn_s_sleep(2); if (++spins > (1u << 22)) break; }
            __builtin_amdgcn_fence(__ATOMIC_ACQUIRE, "agent"); asm volatile("s_waitcnt vmcnt(0)" ::: "memory"); } }
    __syncthreads();
}
__device__ __forceinline__ void mix_quarter(KArgs a, int l, int type, int b, int h, int qi, int tid, int uni) {
    head_sync<4>((unsigned*)(a->ws + WS_CTL) + CW_MIX + 64 * (32 * type + 4 * b + h), 4u * (unsigned)(l + 1), qi, (unsigned)(l + 1), 1, tid, uni);
    const int lane = tid & 63, wave = tid >> 6, c16 = (lane & 7) * 16;
    unsigned char* R = a->ws + WS_R;
    unsigned char* SLB = R + (size_t)b * SLAB;
    const bf16* OF = (const bf16*)(SLB + S_OF) + type * 512 + h * 128 + c16; const bf16* OB = (const bf16*)(SLB + S_OB) + type * 512 + h * 128 + c16;
    bf16* GD = (bf16*)(SLB + (type ? S_MO : S_GG)) + h * 128 + c16;
    const float* gn = a->in[type ? I_MNORM : I_HNORM] + l * 512 + h * 128 + c16;
    float g[16];
#pragma unroll
    for (int j = 0; j < 16; ++j) g[j] = gn[j];
#pragma unroll 2
    for (int ps = 0; ps < 8; ++ps) { const size_t m = (size_t)(512 * qi + 64 * ps + 8 * wave + (lane >> 3));
        const v4u f0 = *(const v4u*)(OF + m * 1024), f1 = *(const v4u*)(OF + m * 1024 + 8), b0 = *(const v4u*)(OB + m * 1024), b1 = *(const v4u*)(OB + m * 1024 + 8);
        const v4u g0 = *(const v4u*)(GD + m * 512), g1 = *(const v4u*)(GD + m * 512 + 8);
        float o[16]; float s_ = 0.f;
#pragma unroll
        for (int j = 0; j < 16; ++j) { const unsigned fw = j < 8 ? f0[(j >> 1) & 3] : f1[(j >> 1) & 3], bw = j < 8 ? b0[(j >> 1) & 3] : b1[(j >> 1) & 3];
            o[j] = ((j & 1) ? bfhi(fw) : bflo(fw)) + ((j & 1) ? bfhi(bw) : bflo(bw)); s_ += o[j] * o[j]; }
        s_ += pg8::sx(s_, 1, lane); s_ += pg8::sx(s_, 2, lane); s_ += pg8::sx(s_, 4, lane);
        const float rs = __builtin_amdgcn_rsqf(s_ * (1.0f / 128.0f) + 1e-6f);
        v4u w0, w1;
#pragma unroll
        for (int j = 0; j < 16; j += 2) { const unsigned gw2 = j < 8 ? g0[(j >> 1) & 3] : g1[(j >> 1) & 3];
            const float z0 = bflo(gw2), z1 = bfhi(gw2), s0_ = pg8::sigm(z0), s1_ = pg8::sigm(z1);
            const unsigned pk = cvt2(o[j] * rs * g[j] * (type ? s0_ : z0 * s0_), o[j + 1] * rs * g[j + 1] * (type ? s1_ : z1 * s1_));
            if (j < 8) w0[(j >> 1) & 3] = pk; else w1[(j >> 1) & 3] = pk; }
        *(v4u*)(GD + m * 512) = w0; *(v4u*)(GD + m * 512 + 8) = w1; }
}

template <int TYPE> __device__ __forceinline__ void scan_s1b(unsigned char* lds, const int par, unsigned (&lfh)[8], unsigned (&qv)[8], unsigned (&kv)[8], unsigned (&vv)[4], const f32x2 cl7,
                                                        const int dp, const int rg, const int ep, const int sv, const f32x2* SEG, const float* SWKp) {
    const int okdt = par ? O_KDT1 : O_KDT, ovt = par ? O_VT1 : O_VT; float* DECp = (float*)(lds + O_DEC) + par * 128; (void)DECp; (void)SWKp; (void)cl7; (void)SEG;
    { asm volatile("" : "+v"(vv[0]), "+v"(vv[1]), "+v"(vv[2]), "+v"(vv[3]));
#pragma unroll
      for (int i = 0; i < 8; i += 4) { asm volatile("" : "+v"(qv[i]), "+v"(qv[i + 1]), "+v"(qv[i + 2]), "+v"(qv[i + 3])); if (TYPE == 1) asm volatile("" : "+v"(kv[i]), "+v"(kv[i + 1]), "+v"(kv[i + 2]), "+v"(kv[i + 3])); }
      unsigned kd0[4], kd1[4];
      if (TYPE == 0) { f32x2 pre = (f32x2){0.f, 0.f}, tot = pre;
#pragma unroll
          for (int j = 0; j < 8; ++j) { const f32x2 s_ = SEG[j * 64 + dp]; tot += s_; if (j < rg) pre += s_; }
          f32x2 f[8], kk[8];
#pragma unroll
          for (int i = 0; i < 8; ++i) { f[i] = h2f(lfh[i]); kk[i] = 1.0f - f[i]; }
          f32x2 E; E.x = __expf(pre.x); E.y = __expf(pre.y);
          f32x2 G; { const f32x2 ex = tot - (pre + cl7); G.x = __expf(ex.x); G.y = __expf(ex.y); }
          float kdx[8], kdy[8];
#pragma unroll
          for (int i = 7; i >= 0; --i) { const f32x2 kd = kk[i] * G; kdx[i] = kd.x; kdy[i] = kd.y; G = G * f[i]; }
#pragma unroll
          for (int i = 0; i < 8; ++i) { const int p = 8 * rg + i; E = E * f[i];
              const f32x2 qs = (f32x2){bflo(qv[i]), bfhi(qv[i])} * E;
              f32x2 ks; ks.x = kk[i].x * __builtin_amdgcn_rcpf(fmaxf(E.x, 1e-35f)); ks.y = kk[i].y * __builtin_amdgcn_rcpf(fmaxf(E.y, 1e-35f));
              *(unsigned*)(lds + O_QS + p * LQ + dp * 4) = cvt2(qs.x, qs.y);
              *(unsigned*)(lds + O_KS + p * LQ + dp * 4) = cvt2(ks.x, ks.y); }
#pragma unroll
          for (int i = 0; i < 4; ++i) { kd0[i] = cvt2(kdx[2 * i], kdx[2 * i + 1]); kd1[i] = cvt2(kdy[2 * i], kdy[2 * i + 1]); }
          if (rg == 0) { f32x2 dd; dd.x = __expf(tot.x); dd.y = __expf(tot.y); *(f32x2*)(DECp + 2 * dp) = dd; }
      } else {
          const f32x4 wk0 = *(const f32x4*)(SWKp + 8 * rg), wk1 = *(const f32x4*)(SWKp + 8 * rg + 4);
          float kdx[8], kdy[8];
#pragma unroll
          for (int i = 0; i < 8; ++i) { const int p = 8 * rg + i;
              *(unsigned*)(lds + O_QS + p * LQ + dp * 4) = qv[i];
              *(unsigned*)(lds + O_KS + p * LQ + dp * 4) = kv[i];
              const float w_ = i < 4 ? wk0[i & 3] : wk1[i & 3]; kdx[i] = bflo(kv[i]) * w_; kdy[i] = bfhi(kv[i]) * w_; }
#pragma unroll
          for (int i = 0; i < 4; ++i) { kd0[i] = cvt2(kdx[2 * i], kdx[2 * i + 1]); kd1[i] = cvt2(kdy[2 * i], kdy[2 * i + 1]); }
      }
      *(v4u*)(lds + okdt + (2 * dp) * LS + 16 * rg) = (v4u){kd0[0], kd0[1], kd0[2], kd0[3]};
      *(v4u*)(lds + okdt + (2 * dp + 1) * LS + 16 * rg) = (v4u){kd1[0], kd1[1], kd1[2], kd1[3]};
      u32x2 w0, w1; w0.x = (vv[0] & 0xffffu) | (vv[1] << 16); w0.y = (vv[2] & 0xffffu) | (vv[3] << 16); w1.x = (vv[0] >> 16) | (vv[1] & 0xffff0000u); w1.y = (vv[2] >> 16) | (vv[3] & 0xffff0000u);
      *(u32x2*)(lds + ovt + (2 * ep) * LS + 8 * sv) = w0; *(u32x2*)(lds + ovt + (2 * ep + 1) * LS + 8 * sv) = w1; }
}

template <int TYPE> __device__ __forceinline__ void scan_item(KArgs a, int l, int item, unsigned char* lds, int tid, int uni) {
    const int lane = tid & 63, wave = __builtin_amdgcn_readfirstlane(tid >> 6), fr = lane & 15, fq = lane >> 4;
    const int dir = (item >> 6) & 1, b = (item >> 3) & 7, h = (item >> 1) & 3, half = item & 1;
    unsigned char* R = a->ws + WS_R + (size_t)b * SLAB;
    bf16* OUT = (bf16*)(R + (dir ? S_OB : S_OF)) + TYPE * 512 + h * 128 + half * 64;
    const int dp = lane, rg = wave;
    const int ep = tid & 31, sv = tid >> 5;
    const int rstep = dir ? -1 : 1;
    const int row00 = dir ? SEQ - 1 : 0;
#define SC_RLO(c) (dir ? row00 - ((c) * 64 + 63) : row00 + (c) * 64)
#define SC_LR(p) (dir ? 63 - (p) : (p))
    unsigned lfh[2][8], qv[2][8], kv[2][8], vv[2][4];
    const unsigned* Qb = (const unsigned*)((const bf16*)(TYPE == 0 ? R + S_QH : (unsigned char*)a->out + (size_t)b * SEQ * 1024) + h * 128);
    const unsigned* Kb = (const unsigned*)((const bf16*)((unsigned char*)a->out + 16 * MiB + (size_t)b * SEQ * 1024) + h * 128);
    const unsigned* Vb = (const unsigned*)((const bf16*)(R + (TYPE == 0 ? S_VH : S_MV)) + h * 128 + half * 64);
    const unsigned* Lb = (const unsigned*)((const unsigned short*)(R + S_LF) + (size_t)dir * SEQ * 512 + h * 128);
    const float* GT = (const float*)(R + S_GT) + dir * 4 + h;
    const unsigned voffv = (unsigned)(SC_LR(4 * sv) * 256 + ep);
    const unsigned voffg = (unsigned)(SC_LR(lane) * 16);
#define SC_LOAD(c, u) do { long rlo_ = SC_RLO(c); asm volatile("" : "+s"(rlo_));     \
        if (TYPE == 0) { _Pragma("unroll") for (int i = 0; i < 8; ++i) { const long r = (rlo_ + SC_LR(8 * rg + i)) * 256; lfh[u][i] = Lb[r + dp]; qv[u][i] = Qb[r + dp]; } } \
        else { _Pragma("unroll") for (int i = 0; i < 8; ++i) { const long r = (rlo_ + SC_LR(8 * rg + i)) * 256; qv[u][i] = Qb[r + dp]; kv[u][i] = Kb[r + dp]; } \
        } \
        _Pragma("unroll") for (int i = 0; i < 4; ++i) { const unsigned vo_ = voffv + (unsigned)(rstep * i * 256); vv[u][i] = Vb[rlo_ * 256 + vo_]; } } while (0)
    f32x4 Sacc[4], Sx = (f32x4){0.f, 0.f, 0.f, 0.f};
#pragma unroll
    for (int et = 0; et < 4; ++et) Sacc[et] = (f32x4){0.f, 0.f, 0.f, 0.f};
    bf16x8 ONES; { const short o_ = (fr & 3) == 0 ? (short)0x3F80 : (short)0; ONES = (bf16x8){o_, o_, o_, o_, o_, o_, o_, o_}; }
    float m_prev = 0.f;
    for (int i = tid; i < 80 * LQ / 4; i += NTHREADS) ((unsigned*)(lds + O_ST))[i] = 0u;
    f32x2* SEG = (f32x2*)(lds + O_SEG); float* DEC = (float*)(lds + O_DEC); float* SCL = (float*)(lds + O_SCAL);
    float* PRE = (float*)(lds + O_PRE);
    if (TYPE == 1) {
        for (int cc = wave; cc < SEQ / 64; cc += NWAVES) { const long rl = SC_RLO(cc); const float gi_ = GT[rl * 16 + voffg], gf_ = GT[rl * 16 + voffg + 8];
            float cum = gf_;
#pragma unroll
            for (int o = 1; o < 64; o <<= 1) { const float t_ = pg8::sx_up(cum, o, lane); if (lane >= o) cum += t_; }
            const float bb = gi_ - cum; float pm = bb;
#pragma unroll
            for (int o = 1; o < 64; o <<= 1) { const float t_ = pg8::sx_up(pm, o, lane); if (lane >= o) pm = fmaxf(pm, t_); }
            PRE[cc * 64 + lane] = cum; PRE[2048 + cc * 64 + lane] = bb; PRE[4096 + cc * 64 + lane] = pm; } }
    if (TYPE == 1) head_sync<8>((unsigned*)(a->ws + WS_CTL) + CW_CONV + 64 * (4 * b + h), 8u * (unsigned)(l + 1), 0, (unsigned)(l + 1), 2, tid, uni);
    SC_LOAD(0, 0); SC_LOAD(1, 1);
    SC_BAR();
    f32x2 cl7 = (f32x2){0.f, 0.f};
#define SC_S1A(cn, u) do { if (TYPE == 0) { f32x2 p_ = (f32x2){1.f, 1.f}; _Pragma("unroll") for (int i = 0; i < 8; ++i) p_ = p_ * h2f(lfh[u][i]); f32x2 c_; c_.x = __logf(fmaxf(p_.x, 1e-37f)); c_.y = __logf(fmaxf(p_.y, 1e-37f)); cl7 = c_; SEG[rg * 64 + dp] = c_; } \
        else if (wave == 0) { const float cum = PRE[(cn) * 64 + lane], bb = PRE[2048 + (cn) * 64 + lane], pm = PRE[4096 + (cn) * 64 + lane], cum_last = PRE[(cn) * 64 + 63], pm_last = PRE[4096 + (cn) * 64 + 63]; \
            const float li = cum + m_prev, mt = fmaxf(cum + pm, li); \
            const float m_new = fmaxf(cum_last + m_prev, cum_last + pm_last); \
            float* W_ = SCL + ((cn) & 1) * 384; W_[lane] = cum - mt; W_[64 + lane] = bb; W_[128 + lane] = __expf(li - mt); W_[192 + lane] = __expf(-mt); W_[256 + lane] = __expf(cum_last + bb - m_new); if (lane == 0) W_[320] = __expf(cum_last + m_prev - m_new); \
            m_prev = m_new; } } while (0)
    SC_S1A(0, 0);
    SC_BAR();
    scan_s1b<TYPE>(lds, 0, lfh[0], qv[0], kv[0], vv[0], cl7, dp, rg, ep, sv, SEG, SCL + 256);
    SC_LOAD(2, 0);
    SC_BAR();
#pragma unroll 1
    for (int c0 = 0; c0 < SEQ / 64; c0 += 2)
#pragma unroll
    for (int u = 0; u < 2; ++u) { const int c = c0 + u;
        const float* SA = SCL + (c & 1) * 384; const float* SB = SA + 64; const float* SWI = SA + 128; const float* SEM = SA + 192; const float* SWK = SA + 256; const float* SCAR = SA + 320;
        (void)SB; (void)SWI; (void)SEM; (void)SWK; (void)SCAR;
        const int tt = wave >> 1, c2 = (wave & 1) * 2;
        f32x4 oacc[2]; float dqv = 0.f;
        { f32x4 sacc[2]; sacc[0] = sacc[1] = oacc[0] = oacc[1] = (f32x4){0.f, 0.f, 0.f, 0.f};
          bf16x8 Bq[4], Ak[2][4], As[2][4], Ax[4];
#pragma unroll
          for (int ks = 0; ks < 4; ++ks) { const int kb = (32 * ks + 8 * fq) * 2; Bq[ks] = frag(lds + O_QS, 16 * tt + fr, LQ, kb);
#pragma unroll
              for (int j = 0; j < 2; ++j) { Ak[j][ks] = frag(lds + O_KS, 16 * (c2 + j) + fr, LQ, kb); As[j][ks] = frag(lds + O_ST, 16 * (c2 + j) + fr, LQ, kb); }
              if (TYPE == 1) Ax[ks] = frag(lds + O_ST, 64 + fr, LQ, kb); }
#pragma unroll
          for (int ks = 0; ks < 4; ++ks)
#pragma unroll
              for (int j = 0; j < 2; ++j) { sacc[j] = __builtin_amdgcn_mfma_f32_16x16x32_bf16(Ak[j][ks], Bq[ks], sacc[j], 0, 0, 0);
                                            oacc[j] = __builtin_amdgcn_mfma_f32_16x16x32_bf16(As[j][ks], Bq[ks], oacc[j], 0, 0, 0); }
          if (TYPE == 1) { f32x4 ox = (f32x4){0.f, 0.f, 0.f, 0.f};
#pragma unroll
              for (int ks = 0; ks < 4; ++ks) ox = __builtin_amdgcn_mfma_f32_16x16x32_bf16(Ax[ks], Bq[ks], ox, 0, 0, 0);
              dqv = ox[0]; }
          const int t_ = 16 * tt + fr; const float sa = TYPE == 1 ? SA[t_] : 0.f;
#pragma unroll
          for (int j = 0; j < 2; ++j) { const int s0 = 16 * (c2 + j) + 4 * fq; f32x4 pv = sacc[j];
              if (TYPE == 1) { const f32x4 sb = *(const f32x4*)(SB + s0);
#pragma unroll
                  for (int r = 0; r < 4; ++r) pv[r] *= __expf(fminf(sa + sb[r], 0.f)); }
#pragma unroll
              for (int r = 0; r < 4; ++r) pv[r] = (s0 + r <= t_) ? pv[r] : 0.f;
              u32x2 w; w.x = cvt2(pv[0], pv[1]); w.y = cvt2(pv[2], pv[3]);
              *(u32x2*)(lds + O_P + t_ * LS + s0 * 2) = w; } }
        if (c + 1 < SEQ / 64) SC_S1A(c + 1, u ^ 1);
        SC_BAR();
        { const int t_ = 16 * tt + fr;
          bf16x8 Bp[2], Vf[2][2], Vs[4][2], Kd[2];
#pragma unroll
          for (int ks = 0; ks < 2; ++ks) { const int kb = (32 * ks + 8 * fq) * 2; Bp[ks] = frag(lds + O_P, t_, LS, kb);
#pragma unroll
              for (int j = 0; j < 2; ++j) Vf[j][ks] = frag(lds + (u ? O_VT1 : O_VT), 16 * (c2 + j) + fr, LS, kb); }
#pragma unroll
          for (int ks = 0; ks < 2; ++ks) { const int kb = (32 * ks + 8 * fq) * 2; Kd[ks] = frag(lds + (u ? O_KDT1 : O_KDT), 16 * wave + fr, LS, kb);
#pragma unroll
              for (int et = 0; et < 4; ++et) Vs[et][ks] = frag(lds + (u ? O_VT1 : O_VT), 16 * et + fr, LS, kb); }
          float wi = 1.f, sem = 0.f; f32x4 dv;
          if (TYPE == 0) dv = *(const f32x4*)(DEC + u * 128 + 16 * wave + 4 * fq); else { wi = SWI[t_]; sem = SEM[t_]; const float cr = SCAR[0]; dv = (f32x4){cr, cr, cr, cr}; }
          if (c + 1 < SEQ / 64) { scan_s1b<TYPE>(lds, u ^ 1, lfh[u ^ 1], qv[u ^ 1], kv[u ^ 1], vv[u ^ 1], cl7, dp, rg, ep, sv, SEG, SCL + (u ^ 1) * 384 + 256);
              if (c + 3 < SEQ / 64) SC_LOAD(c + 3, u ^ 1); }
          f32x4 pacc[2], px; pacc[0] = pacc[1] = px = (f32x4){0.f, 0.f, 0.f, 0.f};
#pragma unroll
          for (int ks = 0; ks < 2; ++ks) {
              pacc[0] = __builtin_amdgcn_mfma_f32_16x16x32_bf16(Vf[0][ks], Bp[ks], pacc[0], 0, 0, 0);
              pacc[1] = __builtin_amdgcn_mfma_f32_16x16x32_bf16(Vf[1][ks], Bp[ks], pacc[1], 0, 0, 0);
              if (TYPE == 1) px = __builtin_amdgcn_mfma_f32_16x16x32_bf16(ONES, Bp[ks], px, 0, 0, 0); }
#pragma unroll
          for (int et = 0; et < 4; ++et) Sacc[et] = Sacc[et] * dv;
          if (TYPE == 1) Sx = Sx * dv;
#pragma unroll
          for (int ks = 0; ks < 2; ++ks) {
#pragma unroll
              for (int et = 0; et < 4; ++et) Sacc[et] = __builtin_amdgcn_mfma_f32_16x16x32_bf16(Kd[ks], Vs[et][ks], Sacc[et], 0, 0, 0);
              if (TYPE == 1) Sx = __builtin_amdgcn_mfma_f32_16x16x32_bf16(Kd[ks], ONES, Sx, 0, 0, 0); }
          float rden = 1.f;
          if (TYPE == 1) { const float dn = px[0] + wi * dqv;
              rden = __builtin_amdgcn_rcpf(fmaxf(fabsf(dn), sem)); }
          bf16* orow = OUT + (size_t)SC_RLO(c) * 1024 + (unsigned)(SC_LR(t_) * 1024 + 4 * fq);
#pragma unroll
          for (int j = 0; j < 2; ++j) { f32x4 o;
              if (TYPE == 0) o = pacc[j] + oacc[j]; else o = (pacc[j] + oacc[j] * wi) * rden;
              u32x2 w; w.x = cvt2(o[0], o[1]); w.y = cvt2(o[2], o[3]);
              *(u32x2*)(orow + 16 * (c2 + j)) = w; }
#pragma unroll
          for (int et = 0; et < 4; ++et) { u32x2 w; w.x = cvt2(Sacc[et][0], Sacc[et][1]); w.y = cvt2(Sacc[et][2], Sacc[et][3]);
              *(u32x2*)(lds + O_ST + (16 * et + fr) * LQ + (16 * wave + 4 * fq) * 2) = w; }
          if (TYPE == 1) { u32x2 w; w.x = cvt2(Sx[0], Sx[1]); w.y = cvt2(Sx[2], Sx[3]);
              *(u32x2*)(lds + O_ST + (64 + fr) * LQ + (16 * wave + 4 * fq) * 2) = w; } }
        SC_BAR();
    }
#undef SC_LOAD
#undef SC_RLO
#undef SC_LR
#undef SC_S1A
}
}
#define PH_BEGIN KArgs ap = fresh_args(); const int tid = fresh_tid(wave_s), lane = tid & 63, wave = __builtin_amdgcn_readfirstlane(tid >> 6); \
    const int gw = (int)blockIdx.x * NWAVES + wave, ngw = G * NWAVES; unsigned char* ws = ap->ws; unsigned char* R = ws + WS_R; \
    (void)lane; (void)gw; (void)ngw; (void)R;
__global__ void __launch_bounds__(NTHREADS, 2) fwd_kernel(Args args_unused) {
    extern __shared__ __attribute__((aligned(16))) unsigned char lds[];
    const int G = gridDim.x;
    const int wave_s = __builtin_amdgcn_readfirstlane(threadIdx.x >> 6);
    { PH_BEGIN
      for (int u = tid; u < (LDS_BYTES - LDSCTL_OFF) / 4; u += NTHREADS) ((unsigned*)(lds + LDSCTL_OFF))[u] = 0u;
      __syncthreads();
      (void)xcd_barrier_post((unsigned*)(ws + WS_CTL) + CW_BAR, (volatile LAS unsigned*)(lds + MISC_OFF) + 8, tid);
      prologue(ap, lds, gw, ngw, wave, lane, tid);
      }
#define BAR_OBJ() XcdBarrier b_; b_.bar = (unsigned*)(fresh_args()->ws + WS_CTL) + CW_BAR; b_.x = xb_xcc_id(); b_.st = (volatile LAS unsigned*)(lds + MISC_OFF) + 8
#define GRID_BAR() do { BAR_OBJ(); xcd_barrier<false>(b_, fresh_tid(wave_s)); } while (0)
#define BATCH_BAR() do { BAR_OBJ(); if (uni) xcd_barrier<true>(b_, fresh_tid(wave_s)); else xcd_barrier<false>(b_, fresh_tid(wave_s)); } while (0)
#define RING ((PG8_LAS unsigned char*)lds)
    typedef pg8::bf16_t bt;
    GRID_BAR();
    int vb, uni;
    { volatile LAS unsigned* st_ = (volatile LAS unsigned*)(lds + MISC_OFF) + 8;
      uni = __builtin_amdgcn_readfirstlane((int)st_[2]);
      vb = uni ? __builtin_amdgcn_readfirstlane((int)(st_[3] * 8u + xb_xcc_id())) : (int)blockIdx.x; }
#pragma unroll 1
    for (int l = 0; l < DEPTH; ++l) {
        const size_t WOFF = (l & 1) ? WS_W2 : WS_W;
        { PH_BEGIN
          pg8::Gemm g = pg8::plain_gemm((const bt*)(ws + WS_XB), (const bt*)(ws + WOFF + WO_IN), DM, DM, DM); pg8::StaticOrder S; S.init(M / 256, DINP / 256, G, vb);
          pg8::EpiInProj E{(const float*)(ws + WS_SS), ap->in[I_BIN] + (size_t)l * DIN, (const float*)(ws + WS_LB) + l * 1024,
                           R};
          pg8::gemm_phase<pg8::EpiInProj, pg8::StaticOrder, true, true, 0>(RING, g, S, E, tid); }
        if (l + 1 < DEPTH && G == 256 && vb >= 192) { PH_BEGIN convert_layer(ap, l + 1, lds, (vb - 192) * NWAVES + wave, 64 * NWAVES, wave, lane); }
        else if (l + 1 < DEPTH && G != 256) { PH_BEGIN convert_layer(ap, l + 1, lds, gw, ngw, wave, lane); }
        if (l == 0) {
            if (uni) { PH_BEGIN
              pg8::Gemm g = pg8::plain_gemm((const bt*)((unsigned char*)ap->out + OT_MEMB), (const bt*)((unsigned char*)ap->out + OT_WKT), DM, DM, DM);
              pg8::OneUnit S; S.has = true; S.u.pm = vb & 7; S.u.pn = vb >> 3;
              pg8::EpiKV E{(bt*)(ws + WS_KX), (bt*)(ws + WS_VT)};
              pg8::gemm_phase<pg8::EpiKV, pg8::OneUnit, true, true, 0>(RING, g, S, E, tid); }
            else { PH_BEGIN
              pg8::Gemm g = pg8::plain_gemm((const bt*)((unsigned char*)ap->out + OT_MEMB), (const bt*)((unsigned char*)ap->out + OT_WKT), DM, DM, DM); pg8::StaticOrder S; S.init(MMEM / 256, 2 * DEPTH * DM / 256, G, (int)blockIdx.x);
              pg8::EpiKV E{(bt*)(ws + WS_KX), (bt*)(ws + WS_VT)};
              pg8::gemm_phase<pg8::EpiKV, pg8::StaticOrder, true, true, 0>(RING, g, S, E, tid); }
        }
        BATCH_BAR();
        { const int y_ = vb & 127, r_ = y_ >> 3; const int it_ = (r_ >> 3) * 64 + (y_ & 7) * 8 + ((r_ >> 1) & 3) * 2 + (r_ & 1);
          const int bb_ = (it_ >> 3) & 7, hh_ = (it_ >> 1) & 3, qi_ = ((it_ >> 6) & 1) * 2 + (it_ & 1);
          if (vb < 128) { { PH_BEGIN sc::mlstm_conv_part(ap, l, bb_, hh_, qi_, tid, uni); }
                 { PH_BEGIN sc::scan_item<0>(ap, l, it_, lds, tid, uni); }
                 { PH_BEGIN sc::mix_quarter(ap, l, 0, bb_, hh_, qi_, tid, uni); } }
          else { { PH_BEGIN sc::mlstm_conv_part(ap, l, bb_, hh_, 4 + qi_, tid, uni); }
                 { PH_BEGIN sc::scan_item<1>(ap, l, it_, lds, tid, uni); }
                 { PH_BEGIN sc::mix_quarter(ap, l, 1, bb_, hh_, qi_, tid, uni); } } }
        BATCH_BAR();
        { PH_BEGIN
          pg8::Gemm g; g.A = (const bt*)(ws + WS_KX) + (size_t)l * 32 * 65536; g.Bt = (const bt*)(ws + WOFF + WO_XQ); g.lda = 256; g.ldb = DM; g.K = 256; g.ajump = 0;
          g.am = (size_t)65536 * 2; g.am8 = 0; g.an3 = 0; g.bn = (size_t)256 * DM * 2; g.bm3 = 512; g.bm8 = 0;
          pg8::OneUnit S; S.has = (vb >> 3) < 16; S.u.pm = (vb & 7) * 4 + ((vb >> 5) & 3); S.u.pn = (vb >> 3) & 3;
          pg8::EpiRowBf16<2> E{nullptr, (bt*)(R + S_MT), DM, 2, (SLAB - 2 * MiB) / 2};
          pg8::gemm_phase<pg8::EpiRowBf16<2>, pg8::OneUnit, true, true, 0>(RING, g, S, E, tid); }
        { PH_BEGIN
          pg8::Gemm g; g.A = (const bt*)(ws + WOFF + WO_XO); g.Bt = (const bt*)(ws + WS_VT) + (size_t)l * 32 * 65536; g.lda = DM; g.ldb = 256; g.K = 256; g.ajump = 0;
          g.am = (size_t)256 * DM * 2; g.am8 = 0; g.an3 = 512; g.bn = (size_t)65536 * 2; g.bm3 = 0; g.bm8 = 0;
          pg8::OneUnit S; S.has = (vb >> 3) >= 16; S.u.pm = ((vb >> 3) - 16) >> 2; S.u.pn = (vb & 7) * 4 + ((vb >> 3) & 3);
          pg8::EpiNt E{(bt*)(R + S_NT)};
          pg8::gemm_phase<pg8::EpiNt, pg8::OneUnit, true, true, 0>(RING, g, S, E, tid); }
        { PH_BEGIN
          pg8::Gemm g = pg8::plain_gemm((const bt*)(R + S_GG), (const bt*)(ws + WOFF + WO_OUT), 512, DM, DM); g.ajump = (size_t)(S_MO - S_GG) - 1024; g.am8 = SLAB - 2 * MiB; pg8::StaticOrder S; S.init(M / 256, DM / 256, G, vb);
          pg8::EpiResid E{(bt*)(ws + WS_XB), (float*)(ws + WS_SS)};
          pg8::gemm_phase<pg8::EpiResid, pg8::StaticOrder, true, true, 2>(RING, g, S, E, tid); }
        BATCH_BAR();
        { PH_BEGIN
          pg8::Gemm g = pg8::plain_gemm((const bt*)(ws + WS_XB), (const bt*)(R + S_MT), DM, DM, DM); g.bm8 = SLAB; pg8::StaticOrder S; S.init(M / 256, 4, G, vb);
          pg8::EpiSoftmax E{(const float*)(ws + WS_SS), (bt*)(R + S_P)};
          pg8::gemm_phase<pg8::EpiSoftmax, pg8::StaticOrder, false, true, 0>(RING, g, S, E, tid); }
        BATCH_BAR();
        { PH_BEGIN
          pg8::Gemm g = pg8::plain_gemm((const bt*)(R + S_P), (const bt*)(R + S_NT), DM, DM, DM); g.am8 = SLAB - 4 * MiB; g.bm8 = SLAB; pg8::StaticOrder S; S.init(M / 256, DM / 256, G, vb);
          pg8::EpiResid E{(bt*)(ws + WS_XB), (float*)(ws + WS_SS)};
          pg8::gemm_phase<pg8::EpiResid, pg8::StaticOrder, true, true, 0>(RING, g, S, E, tid); }
        BATCH_BAR();
        { PH_BEGIN
          pg8::Gemm g = pg8::plain_gemm((const bt*)(ws + WS_XB), (const bt*)(ws + WOFF + WO_UP), DM, DM, DM); pg8::StaticOrder S; S.init(M / 256, DFF / 256, G, vb);
          pg8::EpiRowBf16<1> E{(const float*)(ws + WS_SS), (bt*)(R + S_H), DFF, 3, (SLAB - 16 * MiB) / 2};
          pg8::gemm_phase<pg8::EpiRowBf16<1>, pg8::StaticOrder, true, true, 0>(RING, g, S, E, tid); }
        BATCH_BAR();
        { PH_BEGIN
          pg8::Gemm g = pg8::plain_gemm((const bt*)(R + S_H), (const bt*)(ws + WOFF + WO_DOWN), DFF, DFF, DFF); g.am8 = SLAB - 16 * MiB; pg8::StaticOrder S; S.init(M / 256, DM / 256, G, vb);
          pg8::EpiResid E{(bt*)(ws + WS_XB), (float*)(ws + WS_SS)};
          pg8::gemm_phase<pg8::EpiResid, pg8::StaticOrder, true, true, 0>(RING, g, S, E, tid); }
        GRID_BAR();
    }
    { PH_BEGIN final_phase(ap, gw, ngw, lane); }
}

extern "C" void kernel_launch(void* const* d_in, const int* in_sizes, int n_in, void* d_out, int out_size, void* d_ws, size_t ws_size, hipStream_t stream) {
    static int grid = 0;
    if (grid == 0) {
        if (n_in != 20 || out_size != M * DM || ws_size < WS_END) { fprintf(stderr, "kernel_launch: unexpected shapes (n_in %d, out %d, ws %zu < %zu); nothing launched\n", n_in, out_size, ws_size, (size_t)WS_END); grid = -1; return; }
        int dev = 0, cus = 0;
        if (hipGetDevice(&dev) != hipSuccess || hipDeviceGetAttribute(&cus, hipDeviceAttributeMultiprocessorCount, dev) != hipSuccess) { grid = -1; return; }
        if (hipFuncSetAttribute((const void*)fwd_kernel, hipFuncAttributeMaxDynamicSharedMemorySize, LDS_BYTES) != hipSuccess) { fprintf(stderr, "kernel_launch: hipFuncSetAttribute failed\n"); grid = -1; return; }
        int occ = 0;
        if (hipOccupancyMaxActiveBlocksPerMultiprocessor(&occ, (const void*)fwd_kernel, NTHREADS, LDS_BYTES) != hipSuccess || occ < 1) { fprintf(stderr, "kernel_launch: occupancy query failed or zero\n"); grid = -1; return; }
        (void)hipGetLastError();
        grid = cus;
        if (grid != 256) fprintf(stderr, "kernel_launch: %d CUs; this kernel is built for 256\n", grid);
    }
    if (grid < 0) return;
    if (hipMemsetAsync((char*)d_ws + WS_CTL, 0, CTL_ZERO_BYTES, stream) != hipSuccess) return;
    Args a{};
    for (int i = 0; i < 20; ++i) a.in[i] = (const float*)d_in[i];
    a.out = (float*)d_out; a.ws = (unsigned char*)d_ws;
    hipLaunchKernelGGL(fwd_kernel, dim3(grid), dim3(NTHREADS), LDS_BYTES, stream, a);
}
```

```cpp
#include <hip/hip_runtime.h>
#include <cstdio>
#include <cstdint>
namespace pg8 {
#define PG8_LAS __attribute__((address_space(3)))
typedef unsigned short bf16_t;
typedef short bf16x8 __attribute__((ext_vector_type(8)));
typedef float f32x4 __attribute__((ext_vector_type(4)));
typedef float f32x2 __attribute__((ext_vector_type(2)));
typedef unsigned u32x4 __attribute__((ext_vector_type(4)));
constexpr int WCS = 64, BJS = 32;
constexpr int BM = 256, BK = 64, HALF = 128, HTB = HALF * BK * 2  , STAGE_BYTES = 8 * HTB, NXCD = 8, WGM = 8;

__host__ __device__ __forceinline__ int lds_byte(int r, int c) { const int st = (r >> 4) * 2 + (c >> 5), rr = r & 15, cc = c & 31, ob = rr * 64 + cc * 2; return st * 1024 + (ob ^ (((ob >> 9) & 1) << 5)); }
__host__ __device__ __forceinline__ void stage_rc(int b, int& R, int& C) { const int st = b / 1024, sb = b % 1024, swz = sb ^ (((sb >> 9) & 1) << 5); R = (st >> 1) * 16 + swz / 64; C = (st & 1) * 32 + (swz % 64) / 2; }
__host__ __device__ __forceinline__ int perm32(int rho) { const int n = rho >> 4, i = rho & 15; return 8 * (i >> 2) + 4 * n + (i & 3); }

struct Unit { int pm, pn; };
struct Gemm { const bf16_t* A; const bf16_t* Bt; int lda, ldb, K; size_t ajump, am, am8, an3, bn, bm3, bm8; };
__device__ __forceinline__ Gemm plain_gemm(const bf16_t* A, const bf16_t* Bt, int lda, int ldb, int K) { Gemm g; g.A = A; g.Bt = Bt; g.lda = lda; g.ldb = ldb; g.K = K; g.ajump = 0; g.am = (size_t)512 * lda; g.am8 = 0; g.an3 = 0; g.bn = (size_t)512 * ldb; g.bm3 = 0; g.bm8 = 0; return g; }
template <int MODE> __device__ __forceinline__ const char* a_base(const Gemm& g, const Unit& u) { return (const char*)g.A + (size_t)u.pm * g.am + (size_t)(u.pm >> 3) * g.am8 + (size_t)(u.pn & 3) * g.an3; }
template <int MODE> __device__ __forceinline__ const char* b_base(const Gemm& g, const Unit& u) { return (const char*)g.Bt + (size_t)u.pn * g.bn + (size_t)(u.pm & 3) * g.bm3 + (size_t)(u.pm >> 3) * g.bm8; }

struct StaticOrder {
    int nM, nN, nwg, G, c;
    __host__ __device__ void init(int nM_, int nN_, int G_, int c_) { nM = nM_; nN = nN_; nwg = nM * nN; G = G_; c = c_; }
    __host__ __device__ bool next(int i, Unit& u) const {
        const long L = (long)i * G + c; if (L >= nwg) return false;
        int wgid = (int)L; { const int q = nwg / NXCD, r = nwg % NXCD, xcd = wgid % NXCD, off = wgid / NXCD; wgid = (xcd < r ? xcd * (q + 1) : r * (q + 1) + (xcd - r) * q) + off; }
        const int nig = WGM * nN, gid = wgid / nig, fm = gid * WGM, gsz = (nM - fm) < WGM ? (nM - fm) : WGM;
        u.pm = fm + ((wgid % nig) % gsz); u.pn = (wgid % nig) / gsz; return true;
    }
    __device__ __forceinline__ void a_ready(const Unit&) const {}
    __device__ __forceinline__ void done(const Unit&) const {}
};

struct OneUnit { Unit u; bool has;
    __device__ bool next(int i, Unit& o) const { if (i != 0 || !has) return false; o = u; return true; }
    __device__ __forceinline__ void a_ready(const Unit&) const {}
    __device__ __forceinline__ void done(const Unit&) const {}
};

typedef float f32x2_cv __attribute__((ext_vector_type(2)));
typedef __bf16 bf16x2_cv __attribute__((ext_vector_type(2)));
__device__ __forceinline__ unsigned cvt_pk_bf16(float lo, float hi) { const f32x2_cv v = {lo, hi}; const bf16x2_cv b = __builtin_convertvector(v, bf16x2_cv); return __builtin_bit_cast(unsigned, b); }
__device__ __forceinline__ u32x4 pack8(const f32x4 a, const f32x4 b) { u32x4 w; w.x = cvt_pk_bf16(a[0], a[1]); w.y = cvt_pk_bf16(a[2], a[3]); w.z = cvt_pk_bf16(b[0], b[1]); w.w = cvt_pk_bf16(b[2], b[3]); return w; }
constexpr float NORM_EPS = 1e-6f;
__device__ __forceinline__ float sx(float v, int k, int lane) { return __builtin_bit_cast(float, __builtin_amdgcn_ds_bpermute((lane ^ k) << 2, __builtin_bit_cast(int, v))); }
__device__ __forceinline__ float sx_up(float v, int o, int lane) { return __builtin_bit_cast(float, __builtin_amdgcn_ds_bpermute(((lane - o) & 63) << 2, __builtin_bit_cast(int, v))); }
__device__ __forceinline__ float sx_idx(float v, int src) { return __builtin_bit_cast(float, __builtin_amdgcn_ds_bpermute(src << 2, __builtin_bit_cast(int, v))); }
__device__ __forceinline__ float row_rstd(const float* SS, int row, int fq) {
    const f32x4 v = *(const f32x4*)(SS + (size_t)row * 16 + fq * 4);
    const int lane = fq * 16 + (row & 15);
    float s = (v[0] + v[1]) + (v[2] + v[3]); s += sx(s, 16, lane); s += sx(s, 32, lane);
    return __builtin_amdgcn_rsqf(s * (1.0f / 1024.0f) + NORM_EPS);
}
__device__ __forceinline__ void row_rstd8(const float* SS, int row0, int fr, int fq, float (&rs)[8]) {
    f32x4 v[8];
#pragma unroll
    for (int i = 0; i < 8; ++i) v[i] = *(const f32x4*)(SS + (size_t)(row0 + (i >> 2) * HALF + (i & 3) * 16) * 16 + fq * 4);
    const int lane = fq * 16 + fr; float s[8];
#pragma unroll
    for (int i = 0; i < 8; ++i) s[i] = (v[i][0] + v[i][1]) + (v[i][2] + v[i][3]);
#pragma unroll
    for (int i = 0; i < 8; ++i) s[i] += sx(s[i], 16, lane);
#pragma unroll
    for (int i = 0; i < 8; ++i) s[i] += sx(s[i], 32, lane);
#pragma unroll
    for (int i = 0; i < 8; ++i) rs[i] = __builtin_amdgcn_rsqf(s[i] * (1.0f / 1024.0f) + NORM_EPS);
    asm volatile("" : "+v"(rs[0]), "+v"(rs[1]), "+v"(rs[2]), "+v"(rs[3]), "+v"(rs[4]), "+v"(rs[5]), "+v"(rs[6]), "+v"(rs[7]));
    __builtin_amdgcn_sched_barrier(0);
}
__device__ __forceinline__ float logsig(float z) { return fminf(z, 0.f) - __logf(1.0f + __expf(-fabsf(z))); }
__device__ __forceinline__ float sigm(float z) { return __builtin_amdgcn_rcpf(1.0f + __expf(-z)); }

__device__ __forceinline__ f32x4 sel_acc(const f32x4 (&acc)[2][2][4][2], int ai, int bj, int m, int n) {
    f32x4 r = acc[0][bj][0][n];
#pragma unroll
    for (int a = 0; a < 2; ++a)
#pragma unroll
        for (int mm = 0; mm < 4; ++mm) if (a == ai && mm == m) r = acc[a][bj][mm][n];
    return r;
}
constexpr int MTOK = 16384;
constexpr size_t SL_MIB = 1u << 20, SLAB = 53 * (SL_MIB / 2);
constexpr size_t SL_GT = 14 * SL_MIB, SL_LF = SL_GT + SL_MIB / 4, SL_OF = SL_LF + 4 * SL_MIB, SL_OB = SL_OF + 4 * SL_MIB;
template <bool LT> struct TabPtr { typedef const float* type; };
template <> struct TabPtr<true> { typedef const PG8_LAS float* type; };
__device__ __forceinline__ f32x4 ld4(const float* p) { return *(const f32x4*)p; }
__device__ __forceinline__ f32x4 ld4(const PG8_LAS float* p) { return *(const PG8_LAS f32x4*)p; }
__device__ __forceinline__ void rstd8x(const float* SS, int pm, int row0, int fr, int fq, float (&rs)[8]) { (void)pm; row_rstd8(SS, row0, fr, fq, rs); }
__device__ __forceinline__ void rstd8x(const PG8_LAS float* RS, int pm, int row0, int fr, int fq, float (&rs)[8]) { (void)fr; (void)fq; const int lr0 = row0 - pm * BM;
#pragma unroll
    for (int i = 0; i < 8; ++i) rs[i] = RS[lr0 + (i >> 2) * HALF + (i & 3) * 16]; }
template <bool LT> struct EpiInProjT {
    static constexpr bool PERM = true, AFTER_DRAIN = false;
    static __device__ __forceinline__ bool stores16(const Unit& u) { return (u.pn >> 1) != 9; }
    typename TabPtr<LT>::type SS, bias, lb;
    unsigned char* RB;
    __device__ __forceinline__ void operator()(const f32x4 (&acc)[2][2][4][2], const Unit& u, int wr, int wc, int fr, int fq) const {
        const int seg = u.pn >> 1;
        const int row0 = u.pm * BM + wr * 64 + fr, lrow0 = (u.pm & 7) * BM + wr * 64 + fr;
        unsigned char* const SLB = RB + (size_t)(u.pm >> 3) * SLAB;
        const int cs0 = (u.pn & 1) * 256 + wc * WCS + 8 * fq;
        const int gc0 = u.pn * BM + wc * WCS + 8 * fq;
        if (seg == 9) {
            if (wc != 0) return;
            float rs8[8]; rstd8x(SS, u.pm, row0, fr, fq, rs8);
            f32x4 b0 = (f32x4){0.f, 0.f, 0.f, 0.f}, b1 = b0;
            if (fq < 2) { b0 = ld4(bias + gc0); b1 = ld4(bias + gc0 + 4); }
#pragma unroll
            for (int am = 0; am < 8; ++am) { const int ai = am >> 2, m = am & 3; const int lrow = lrow0 + ai * HALF + m * 16; const float rs = rs8[am]; float* const GATES = (float*)(SLB + SL_GT);
                f32x4 v0 = acc[ai][0][m][0] * rs + b0, v1 = acc[ai][0][m][1] * rs + b1;
                if (fq == 1) {
#pragma unroll
                    for (int j = 0; j < 4; ++j) { v0[j] = logsig(v0[j]); v1[j] = logsig(v1[j]); } }
                if (fq < 2) { *(f32x4*)(GATES + (size_t)lrow * 16 + 8 * fq) = v0; *(f32x4*)(GATES + (size_t)lrow * 16 + 8 * fq + 4) = v1; } }
            return;
        }
        f32x4 bv[2][2];
#pragma unroll
        for (int bj = 0; bj < 2; ++bj)
#pragma unroll
            for (int n = 0; n < 2; ++n) bv[bj][n] = ld4(bias + gc0 + bj * BJS + 4 * n);
        float rs8[8];
        if (seg == 1 || seg == 2) {
            f32x4 lv[2][2];
#pragma unroll
            for (int bj = 0; bj < 2; ++bj)
#pragma unroll
                for (int n = 0; n < 2; ++n) lv[bj][n] = ld4(lb + (seg - 1) * 512 + cs0 + bj * BJS + 4 * n);
            unsigned short* LFd = (unsigned short*)(SLB + SL_LF) + (size_t)(seg - 1) * 2048 * 512 + cs0;
            rstd8x(SS, u.pm, row0, fr, fq, rs8);
#pragma unroll
            for (int ai = 0; ai < 2; ++ai)
#pragma unroll
                for (int m = 0; m < 4; ++m) { const int row = row0 + ai * HALF + m * 16; const float rs = rs8[ai * 4 + m];
#pragma unroll
                    for (int bj = 0; bj < 2; ++bj) { f32x4 v0 = acc[ai][bj][m][0] * rs + bv[bj][0], v1 = acc[ai][bj][m][1] * rs + bv[bj][1];
#pragma unroll
                        for (int j = 0; j < 4; ++j) { const float a0 = lv[bj][0][j], a1 = lv[bj][1][j];
                            v0[j] = a0 + (1.f - a0) * sigm(fmaxf(v0[j], -80.f)); v1[j] = a1 + (1.f - a1) * sigm(fmaxf(v1[j], -80.f)); }
                        typedef _Float16 h2_t __attribute__((ext_vector_type(2))); u32x4 w;
                        w.x = __builtin_bit_cast(unsigned, (h2_t){(_Float16)v0[0], (_Float16)v0[1]}); w.y = __builtin_bit_cast(unsigned, (h2_t){(_Float16)v0[2], (_Float16)v0[3]});
                        w.z = __builtin_bit_cast(unsigned, (h2_t){(_Float16)v1[0], (_Float16)v1[1]}); w.w = __builtin_bit_cast(unsigned, (h2_t){(_Float16)v1[2], (_Float16)v1[3]});
                        *(u32x4*)(LFd + (size_t)(row - row0 + lrow0) * 512 + bj * BJS) = w; } }
            return;
        }
        const float ca = seg == 0 ? 0.f : 1.f, cb = 0.f, cc = seg == 0 ? 1.f : 0.f;
        bf16_t* dst = (bf16_t*)(SLB + ((size_t)(seg == 0 ? 0 : seg - 2) << 21)) + cs0;
        rstd8x(SS, u.pm, row0, fr, fq, rs8);
#pragma unroll
        for (int ai = 0; ai < 2; ++ai)
#pragma unroll
            for (int m = 0; m < 4; ++m) { const int row = row0 + ai * HALF + m * 16; const float rs = rs8[ai * 4 + m];
#pragma unroll
                for (int bj = 0; bj < 2; ++bj) { f32x4 v0 = acc[ai][bj][m][0] * rs + bv[bj][0], v1 = acc[ai][bj][m][1] * rs + bv[bj][1];
                    if (ca == 0.f) {
#pragma unroll
                        for (int j = 0; j < 4; ++j) { const float s0 = sigm(v0[j]), s1 = sigm(v1[j]); v0[j] = v0[j] * (cc * s0) + cb * s0; v1[j] = v1[j] * (cc * s1) + cb * s1; } }
                    *(u32x4*)(dst + (size_t)(row - row0 + lrow0) * 512 + bj * BJS) = pack8(v0, v1); } }
    }
};
typedef EpiInProjT<false> EpiInProj; typedef EpiInProjT<true> EpiInProjL;
struct EpiResid {
    static constexpr bool PERM = true, AFTER_DRAIN = false;
    static __device__ __forceinline__ bool stores16(const Unit&) { return false; }
    bf16_t* xb; float* SS;
    __device__ __forceinline__ void operator()(const f32x4 (&acc)[2][2][4][2], const Unit& u, int wr, int wc, int fr, int fq) const {
        const int row0 = u.pm * BM + wr * 64 + fr, col0 = u.pn * BM + wc * WCS + 8 * fq;
        u32x4 xo[2][4][2];
#pragma unroll
        for (int ai = 0; ai < 2; ++ai)
#pragma unroll
            for (int m = 0; m < 4; ++m)
#pragma unroll
                for (int bj = 0; bj < 2; ++bj) xo[ai][m][bj] = *(const u32x4*)(xb + (size_t)(row0 + ai * HALF + m * 16) * 1024 + col0 + bj * BJS);
        __builtin_amdgcn_sched_barrier(0);
        float sq8[8];
#pragma unroll
        for (int ai = 0; ai < 2; ++ai)
#pragma unroll
            for (int m = 0; m < 4; ++m) { const int row = row0 + ai * HALF + m * 16; float sq = 0.f;
#pragma unroll
                for (int bj = 0; bj < 2; ++bj) { const size_t o = (size_t)row * 1024 + col0 + bj * BJS;
                    const u32x4 xw = xo[ai][m][bj];
                    f32x4 a = (f32x4){__builtin_bit_cast(float, xw.x << 16), __builtin_bit_cast(float, xw.x & 0xffff0000u), __builtin_bit_cast(float, xw.y << 16), __builtin_bit_cast(float, xw.y & 0xffff0000u)};
                    f32x4 b = (f32x4){__builtin_bit_cast(float, xw.z << 16), __builtin_bit_cast(float, xw.z & 0xffff0000u), __builtin_bit_cast(float, xw.w << 16), __builtin_bit_cast(float, xw.w & 0xffff0000u)};
                    a = a + acc[ai][bj][m][0]; b = b + acc[ai][bj][m][1];
                    *(u32x4*)(xb + o) = pack8(a, b);
                    sq += (a[0] * a[0] + a[1] * a[1]) + (a[2] * a[2] + a[3] * a[3]) + (b[0] * b[0] + b[1] * b[1]) + (b[2] * b[2] + b[3] * b[3]); }
                sq8[ai * 4 + m] = sq; }
        const int lane = fq * 16 + fr;
#pragma unroll
        for (int i = 0; i < 8; ++i) sq8[i] += sx(sq8[i], 16, lane);
#pragma unroll
        for (int i = 0; i < 8; ++i) sq8[i] += sx(sq8[i], 32, lane);
#pragma unroll
        for (int i = 0; i < 8; ++i) if (fq == 0) SS[(size_t)(row0 + (i >> 2) * HALF + (i & 3) * 16) * 16 + u.pn * 4 + wc] = sq8[i];
    }
};
template <int ACT, bool LT = false> struct EpiRowBf16 {
    static constexpr bool PERM = true, AFTER_DRAIN = false;
    static __device__ __forceinline__ bool stores16(const Unit&) { return true; }
    typename TabPtr<LT>::type SS; bf16_t* O; int ldc; int bshift; size_t corr;
    __device__ __forceinline__ void operator()(const f32x4 (&acc)[2][2][4][2], const Unit& u, int wr, int wc, int fr, int fq) const {
        const int row0 = u.pm * BM + wr * 64 + fr, col0 = u.pn * BM + wc * WCS + 8 * fq;
        float rs8[8]; if (ACT != 2) rstd8x(SS, u.pm, row0, fr, fq, rs8);
#pragma unroll
        for (int ai = 0; ai < 2; ++ai)
#pragma unroll
            for (int m = 0; m < 4; ++m) { const int row = row0 + ai * HALF + m * 16; const float rs = ACT == 2 ? 1.f : rs8[ai * 4 + m];
#pragma unroll
                for (int bj = 0; bj < 2; ++bj) { f32x4 v0 = acc[ai][bj][m][0] * rs, v1 = acc[ai][bj][m][1] * rs;
                    if (ACT == 1) {
#pragma unroll
                        for (int j = 0; j < 4; ++j) { const float t0 = fmaxf(v0[j], 0.f), t1 = fmaxf(v1[j], 0.f); v0[j] = t0 * t0; v1[j] = t1 * t1; } }
                    *(u32x4*)(O + (size_t)row * ldc + (size_t)(u.pm >> bshift) * corr + col0 + bj * BJS) = pack8(v0, v1); } }
    }
};
struct EpiKV {
    static constexpr bool PERM = true, AFTER_DRAIN = false;
    static __device__ __forceinline__ bool stores16(const Unit&) { return false; }
    bf16_t* OK; bf16_t* OV;
    __device__ __forceinline__ void operator()(const f32x4 (&acc)[2][2][4][2], const Unit& u, int wr, int wc, int fr, int fq) const {
        const int pn = u.pn & 15; const int tile = ((pn >> 2) * 8 + u.pm) * 4 + (pn & 3);
        bf16_t* base = (u.pn >= 16 ? OV : OK) + (size_t)tile * 65536; const int r0 = wr * 64 + fr, c0 = wc * WCS + 8 * fq;
#pragma unroll
        for (int ai = 0; ai < 2; ++ai)
#pragma unroll
            for (int m = 0; m < 4; ++m)
#pragma unroll
                for (int bj = 0; bj < 2; ++bj) *(u32x4*)(base + (size_t)(r0 + ai * HALF + m * 16) * 256 + c0 + bj * BJS) = pack8(acc[ai][bj][m][0], acc[ai][bj][m][1]);
    }
};
struct EpiNt {
    static constexpr bool PERM = true, AFTER_DRAIN = false;
    static __device__ __forceinline__ bool stores16(const Unit&) { return false; }
    bf16_t* O;
    __device__ __forceinline__ void operator()(const f32x4 (&acc)[2][2][4][2], const Unit& u, int wr, int wc, int fr, int fq) const {
        bf16_t* base = O + (size_t)(u.pn >> 2) * (SLAB / 2) + (size_t)u.pm * 256 * 1024 + (u.pn & 3) * 256; const int r0 = wr * 64 + fr, c0 = wc * WCS + 8 * fq;
#pragma unroll
        for (int ai = 0; ai < 2; ++ai)
#pragma unroll
            for (int m = 0; m < 4; ++m)
#pragma unroll
                for (int bj = 0; bj < 2; ++bj) *(u32x4*)(base + (size_t)(r0 + ai * HALF + m * 16) * 1024 + c0 + bj * BJS) = pack8(acc[ai][bj][m][0], acc[ai][bj][m][1]);
    }
};
template <bool LT> struct EpiSoftmaxT {
    static constexpr bool PERM = true, AFTER_DRAIN = true;
    static __device__ __forceinline__ bool stores16(const Unit&) { return false; }
    typename TabPtr<LT>::type SS; bf16_t* P;
    __device__ __forceinline__ void fused(f32x4 (&acc)[2][2][4][2], const Unit& u, int wr, int wc, int fr, int fq, PG8_LAS unsigned char* lds, int wid, int lane) const {
        PG8_LAS f32x2* T = (PG8_LAS f32x2*)lds;
        float rs8[8]; rstd8x(SS, u.pm, u.pm * BM + wr * 64 + fr, fr, fq, rs8);
#pragma unroll
        for (int ai = 0; ai < 2; ++ai)
#pragma unroll
            for (int m = 0; m < 4; ++m) { const float rs = rs8[ai * 4 + m];
#pragma unroll
                for (int bj = 0; bj < 2; ++bj)
#pragma unroll
                    for (int n = 0; n < 2; ++n) acc[ai][bj][m][n] = acc[ai][bj][m][n] * rs;
                float mx = -3.0e38f;
#pragma unroll
                for (int bj = 0; bj < 2; ++bj)
#pragma unroll
                    for (int n = 0; n < 2; ++n) { const f32x4 x = acc[ai][bj][m][n]; mx = fmaxf(mx, fmaxf(fmaxf(x[0], x[1]), fmaxf(x[2], x[3]))); }
                mx = fmaxf(mx, sx(mx, 16, lane)); mx = fmaxf(mx, sx(mx, 32, lane));
                float s = 0.f;
#pragma unroll
                for (int bj = 0; bj < 2; ++bj)
#pragma unroll
                    for (int n = 0; n < 2; ++n) { const f32x4 x = acc[ai][bj][m][n]; s += (__expf(x[0] - mx) + __expf(x[1] - mx)) + (__expf(x[2] - mx) + __expf(x[3] - mx)); }
                s += sx(s, 16, lane); s += sx(s, 32, lane);
                if (fq == 0) T[(ai * HALF + wr * 64 + m * 16 + fr) * 4 + wc] = (f32x2){mx, s}; }
        asm volatile("s_waitcnt lgkmcnt(0)" ::: "memory"); __builtin_amdgcn_s_barrier(); asm volatile("" ::: "memory");
        const int row0 = u.pm * BM + wr * 64 + fr, col0 = u.pn * BM + wc * WCS + 8 * fq;
#pragma unroll
        for (int ai = 0; ai < 2; ++ai)
#pragma unroll
            for (int m = 0; m < 4; ++m) { const int r = ai * HALF + wr * 64 + m * 16 + fr;
                const f32x2 t0 = T[r * 4 + 0], t1 = T[r * 4 + 1], t2 = T[r * 4 + 2], t3 = T[r * 4 + 3];
                const float M = fmaxf(fmaxf(t0.x, t1.x), fmaxf(t2.x, t3.x));
                const float L = (t0.y * __expf(t0.x - M) + t1.y * __expf(t1.x - M)) + (t2.y * __expf(t2.x - M) + t3.y * __expf(t3.x - M));
                const float inv = __builtin_amdgcn_rcpf(L);
#pragma unroll
                for (int bj = 0; bj < 2; ++bj) { f32x4 v0 = acc[ai][bj][m][0], v1 = acc[ai][bj][m][1];
#pragma unroll
                    for (int j = 0; j < 4; ++j) { v0[j] = __expf(v0[j] - M) * inv; v1[j] = __expf(v1[j] - M) * inv; }
                    *(u32x4*)(P + (size_t)(u.pm >> 3) * ((SLAB - 4 * SL_MIB) / 2) + (size_t)(row0 + ai * HALF + m * 16) * 1024 + col0 + bj * BJS) = pack8(v0, v1); } }
    }
};
typedef EpiSoftmaxT<false> EpiSoftmax; typedef EpiSoftmaxT<true> EpiSoftmaxL;

template <class Epi, class Sched, bool ALIGN_EPI, bool SP2, int MODE>
__device__ __forceinline__ void gemm_phase(PG8_LAS unsigned char* lds, const Gemm g, const Sched& S, const Epi& E, const int tid) {
    const int wid = __builtin_amdgcn_readfirstlane(tid >> 6), lane = tid & 63, wr = wid >> 2, wc = wid & 3, fr = lane & 15, fq = lane >> 4;
    const int K = g.K, nt = K / BK;
    unsigned voffA[2], voffB[2];
#pragma unroll
    for (int i = 0; i < 2; ++i) { int R, C; stage_rc(tid * 16 + i * 8192, R, C); const int Rb = Epi::PERM ? ((R >> 5) * WCS + perm32(R & 31)) : R;
        voffA[i] = (unsigned)(R * g.lda + C) * 2u; voffB[i] = (unsigned)(Rb * g.ldb + C) * 2u; }
    const size_t kstep = (size_t)(BK * 2);
    const size_t hstepA = (size_t)HALF * g.lda * 2, hstepB = (size_t)(Epi::PERM ? BJS : HALF) * g.ldb * 2;
    const unsigned ldsw = (unsigned)wid * 1024u;
    const int aoff = lds_byte(wr * 64 + fr, fq * 8), boff = lds_byte(wc * 32 + fr, fq * 8);
#define PG8_SA(b, h) (((b) * 2 + (h)) * HTB)
#define PG8_SB(b, h) ((4 + (b) * 2 + (h)) * HTB)
#define PG8_STAGE(bufoff, gbase, voff) do { _Pragma("unroll") for (int _i = 0; _i < 2; ++_i) \
        __builtin_amdgcn_global_load_lds((const unsigned*)((const char*)(gbase) + (voff)[_i]), (PG8_LAS unsigned*)(lds + (bufoff) + ldsw + _i * 8192), 16, 0, 0); } while (0)
#define PG8_LDA(dst, b, h) do { _Pragma("unroll") for (int m = 0; m < 4; ++m) _Pragma("unroll") for (int k = 0; k < 2; ++k) dst[m][k] = *(const PG8_LAS bf16x8*)(lds + PG8_SA(b, h) + aoff + m * 2048 + k * 1024); } while (0)
#define PG8_LDB(dst, b, h) do { _Pragma("unroll") for (int n = 0; n < 2; ++n) _Pragma("unroll") for (int k = 0; k < 2; ++k) dst[n][k] = *(const PG8_LAS bf16x8*)(lds + PG8_SB(b, h) + boff + n * 2048 + k * 1024); } while (0)
#define PG8_MMA(ai, bj, At, Bt) do { __builtin_amdgcn_s_setprio(1); _Pragma("unroll") for (int m = 0; m < 4; ++m) _Pragma("unroll") for (int n = 0; n < 2; ++n) _Pragma("unroll") for (int k = 0; k < 2; ++k) \
        acc[ai][bj][m][n] = __builtin_amdgcn_mfma_f32_16x16x32_bf16(Bt[n][k], At[m][k], acc[ai][bj][m][n], 0, 0, 0); __builtin_amdgcn_s_setprio(0); } while (0)
#define PG8_WAIT_V(n) asm volatile("s_waitcnt vmcnt(" #n ")" ::: "memory")
#define PG8_WAIT_L(n) asm volatile("s_waitcnt lgkmcnt(" #n ")" ::: "memory")
#define PG8_WAIT_V8R(rx) asm volatile("s_cmp_eq_u32 %0, 0\n\ts_cbranch_scc1 .Lrxa%=\n\ts_waitcnt vmcnt(24)\n\ts_branch .Lrxb%=\n.Lrxa%=:\n\ts_waitcnt vmcnt(8)\n.Lrxb%=:" :: "s"(rx) : "memory", "scc")
#define PG8_BAR __builtin_amdgcn_s_barrier()
#define PG8_SCHED __builtin_amdgcn_sched_barrier(0)
    Unit cur, nxt; int ui = 0; bool relax = false;
    if (!S.next(0, cur)) return;
    f32x4 acc[2][2][4][2];
#pragma unroll
    for (int a = 0; a < 2; ++a)
#pragma unroll
        for (int b = 0; b < 2; ++b)
#pragma unroll
            for (int m = 0; m < 4; ++m)
#pragma unroll
                for (int n = 0; n < 2; ++n) acc[a][b][m][n] = (f32x4){0.f, 0.f, 0.f, 0.f};
    bf16x8 At[4][2], B0[2][2], B1[2][2];
    const char* cA = a_base<MODE>(g, cur); const char* cB = b_base<MODE>(g, cur);
    S.a_ready(cur);
    if constexpr (SP2) {
        PG8_STAGE(PG8_SB(0, 0), cB, voffB); PG8_STAGE(PG8_SB(0, 1), cB + hstepB, voffB); PG8_STAGE(PG8_SA(0, 0), cA, voffA); PG8_STAGE(PG8_SA(0, 1), cA + hstepA, voffA);
        if (wr == 1) PG8_BAR;
        PG8_WAIT_V(2); PG8_BAR;
        PG8_STAGE(PG8_SB(1, 0), cB + kstep, voffB); PG8_STAGE(PG8_SA(1, 0), cA + kstep, voffA); PG8_STAGE(PG8_SB(1, 1), cB + hstepB + kstep, voffB);
        PG8_WAIT_V(6); PG8_BAR;
    } else {
        PG8_STAGE(PG8_SB(0, 0), cB, voffB); PG8_STAGE(PG8_SA(0, 0), cA, voffA); PG8_STAGE(PG8_SB(0, 1), cB + hstepB, voffB); PG8_STAGE(PG8_SA(0, 1), cA + hstepA, voffA);
        if (wr == 1) PG8_BAR;
        PG8_WAIT_V(4); PG8_BAR;
        PG8_STAGE(PG8_SB(1, 0), cB + kstep, voffB); PG8_STAGE(PG8_SA(1, 0), cA + kstep, voffA); PG8_STAGE(PG8_SB(1, 1), cB + hstepB + kstep, voffB);
        PG8_WAIT_V(6); PG8_BAR;
    }
    for (;;) {
        const bool has_next = S.next(ui + 1, nxt);
        const char* nA = has_next ? a_base<MODE>(g, nxt) : cA; const char* nB = has_next ? b_base<MODE>(g, nxt) : cB;
        for (int t = 0; t < nt; t += 2) {
            const bool last = (t == nt - 2); const int rx = __builtin_amdgcn_readfirstlane((relax && t == 0) ? 1 : 0);
            const char* a1 = cA + (size_t)(t + 1) * kstep + ((MODE == 2 && t + 1 >= 8) ? g.ajump : (size_t)0);
            const char* a2 = last ? nA : cA + (size_t)(t + 2) * kstep + ((MODE == 2 && t + 2 >= 8) ? g.ajump : (size_t)0); const char* b2 = last ? nB : cB + (size_t)(t + 2) * kstep;
            const char* a3 = (MODE == 2 && !last) ? cA + (size_t)(t + 3) * kstep + ((t + 3 >= 8) ? g.ajump : (size_t)0) : a2 + kstep; const char* b3 = b2 + kstep;
            if (last && has_next) S.a_ready(nxt);
            if constexpr (SP2) {
            PG8_LDB(B0, 0, 0); PG8_LDB(B1, 0, 1); PG8_SCHED; PG8_LDA(At, 0, 0); PG8_STAGE(PG8_SA(1, 1), a1 + hstepA, voffA);
            PG8_WAIT_V8R(rx); PG8_WAIT_L(0); PG8_BAR; PG8_MMA(0, 0, At, B0); PG8_MMA(0, 1, At, B1); PG8_BAR; PG8_SCHED;
            PG8_LDA(At, 0, 1); PG8_STAGE(PG8_SB(0, 0), b2, voffB); PG8_STAGE(PG8_SB(0, 1), b2 + hstepB, voffB); PG8_STAGE(PG8_SA(0, 0), a2, voffA);
            PG8_WAIT_V8R(rx); PG8_WAIT_L(0); PG8_BAR; PG8_MMA(1, 0, At, B0); PG8_MMA(1, 1, At, B1); PG8_BAR; PG8_SCHED;
            PG8_LDB(B0, 1, 0); PG8_LDB(B1, 1, 1); PG8_SCHED; PG8_LDA(At, 1, 0); PG8_STAGE(PG8_SA(0, 1), a2 + hstepA, voffA);
            PG8_WAIT_V(8); PG8_WAIT_L(0); PG8_BAR; PG8_MMA(0, 0, At, B0); PG8_MMA(0, 1, At, B1); PG8_BAR; PG8_SCHED;
            PG8_LDA(At, 1, 1); PG8_STAGE(PG8_SB(1, 0), b3, voffB); PG8_STAGE(PG8_SB(1, 1), b3 + hstepB, voffB); PG8_STAGE(PG8_SA(1, 0), a3, voffA);
            PG8_WAIT_V(8); PG8_WAIT_L(0); PG8_BAR; PG8_MMA(1, 0, At, B0); PG8_MMA(1, 1, At, B1); PG8_BAR; PG8_SCHED;
            } else {
            PG8_LDB(B0, 0, 0); PG8_SCHED; PG8_LDA(At, 0, 0); PG8_STAGE(PG8_SA(1, 1), a1 + hstepA, voffA);
            PG8_WAIT_L(8); PG8_BAR; PG8_WAIT_L(0); PG8_MMA(0, 0, At, B0); PG8_BAR; PG8_SCHED;
            PG8_LDB(B1, 0, 1); PG8_STAGE(PG8_SB(0, 0), b2, voffB);
            PG8_BAR; PG8_WAIT_L(0); PG8_MMA(0, 1, At, B1); PG8_BAR;
            PG8_LDA(At, 0, 1); PG8_STAGE(PG8_SA(0, 0), a2, voffA);
            PG8_BAR; PG8_WAIT_L(0); PG8_MMA(1, 0, At, B0); PG8_BAR; PG8_SCHED;
            PG8_STAGE(PG8_SB(0, 1), b2 + hstepB, voffB);
            PG8_WAIT_V(6); PG8_BAR; PG8_MMA(1, 1, At, B1); PG8_BAR;
            PG8_LDB(B0, 1, 0); PG8_SCHED; PG8_LDA(At, 1, 0); PG8_STAGE(PG8_SA(0, 1), a2 + hstepA, voffA);
            PG8_WAIT_L(8); PG8_BAR; PG8_WAIT_L(0); PG8_MMA(0, 0, At, B0); PG8_BAR; PG8_SCHED;
            PG8_LDB(B1, 1, 1); PG8_STAGE(PG8_SB(1, 0), b3, voffB);
            PG8_BAR; PG8_WAIT_L(0); PG8_MMA(0, 1, At, B1); PG8_BAR;
            PG8_LDA(At, 1, 1); PG8_STAGE(PG8_SA(1, 0), a3, voffA);
            PG8_BAR; PG8_WAIT_L(0); PG8_MMA(1, 0, At, B0); PG8_BAR; PG8_SCHED;
            PG8_STAGE(PG8_SB(1, 1), b3 + hstepB, voffB);
            PG8_WAIT_V(6); PG8_BAR; PG8_MMA(1, 1, At, B1); PG8_BAR;
            }
        }
        if constexpr (ALIGN_EPI) { if (wr == 0) PG8_BAR; }
        if constexpr (!Epi::AFTER_DRAIN) { int l2; asm volatile("v_mbcnt_lo_u32_b32 %0, -1, 0\n\tv_mbcnt_hi_u32_b32 %0, -1, %0" : "=v"(l2));
            E(acc, cur, wr, wc, l2 & 15, l2 >> 4); S.done(cur); relax = SP2 && Epi::stores16(cur); }
        if (!has_next) break;
#pragma unroll
        for (int a = 0; a < 2; ++a)
#pragma unroll
            for (int b = 0; b < 2; ++b)
#pragma unroll
                for (int m = 0; m < 4; ++m)
#pragma unroll
                    for (int n = 0; n < 2; ++n) acc[a][b][m][n] = (f32x4){0.f, 0.f, 0.f, 0.f};
        cur = nxt; cA = nA; cB = nB; ++ui;
        if constexpr (ALIGN_EPI) { if (wr == 1) PG8_BAR; }
    }
    PG8_WAIT_V(0);
    if constexpr (!ALIGN_EPI) { if (wr == 0) PG8_BAR; }
    PG8_BAR;
    if constexpr (Epi::AFTER_DRAIN) { int l2; asm volatile("v_mbcnt_lo_u32_b32 %0, -1, 0\n\tv_mbcnt_hi_u32_b32 %0, -1, %0" : "=v"(l2)); E.fused(acc, cur, wr, wc, l2 & 15, l2 >> 4, lds, wid, l2); S.done(cur); }
#undef PG8_SA
#undef PG8_SB
#undef PG8_STAGE
#undef PG8_LDA
#undef PG8_LDB
#undef PG8_MMA
#undef PG8_WAIT_V
#undef PG8_WAIT_V8R
#undef PG8_WAIT_L
#undef PG8_BAR
#undef PG8_SCHED
}
}

constexpr int NWAVES = 8, NTHREADS = 512;
constexpr int DM = 1024, NB = 8, SEQ = 2048, DEPTH = 4, MEMLEN = 256, DIN = 4624, DINP = 4864, DFF = 4096;
constexpr int M = NB * SEQ;
constexpr int MMEM = NB * MEMLEN;

constexpr size_t MiB = 1u << 20;
constexpr size_t WS_CTL = 0, CTL_ZERO_BYTES = 1 * MiB;
constexpr size_t WS_SS = 2 * MiB;
constexpr size_t WS_LB = 3 * MiB;
constexpr size_t WS_W = 4 * MiB;
constexpr size_t WO_IN = 0, WO_OUT = 10 * MiB, WO_XQ = 12 * MiB, WO_XO = 14 * MiB, WO_UP = 16 * MiB, WO_DOWN = 24 * MiB;
constexpr size_t WS_KX = 36 * MiB, WS_VT = 52 * MiB;
constexpr size_t WS_XB = 68 * MiB;
constexpr size_t WS_R = 100 * MiB;
constexpr size_t SLAB = pg8::SLAB;
constexpr size_t S_QH = 0, S_VH = 2 * MiB, S_GG = 4 * MiB, S_MQ = 6 * MiB, S_MK = 8 * MiB, S_MV = 10 * MiB, S_MO = 12 * MiB,
                 S_GT = pg8::SL_GT, S_LF = pg8::SL_LF, S_OF = pg8::SL_OF, S_OB = pg8::SL_OB;
constexpr size_t S_P = 0, S_MT = S_MQ, S_NT = S_MK;
constexpr size_t S_H = 0;
constexpr size_t R_END = 8 * SLAB;
constexpr size_t OT_MEMB = 32 * MiB, OT_WKT = 36 * MiB, OT_WVT = 44 * MiB;
constexpr size_t WS_W2 = WS_R + R_END;
constexpr size_t WS_END = WS_W2 + 32 * MiB;
constexpr int CW_BAR = 4096;
constexpr int RING_BYTES = 131072, LDSCTL_OFF = 161792, MISC_OFF = LDSCTL_OFF + 320, LDS_BYTES = 163840;

#define GAS __attribute__((address_space(1)))
#define LAS __attribute__((address_space(3)))
typedef unsigned short bf16;
typedef unsigned v4u __attribute__((ext_vector_type(4)));
typedef float f32x4 __attribute__((ext_vector_type(4)));
#define LDS_WAIT() asm volatile("s_waitcnt lgkmcnt(0)" ::: "memory")
#define VM_WAIT() asm volatile("s_waitcnt vmcnt(0)" ::: "memory")
__device__ __forceinline__ unsigned f2bf(float f) { unsigned u = __builtin_bit_cast(unsigned, f); return (u + 0x7fffu + ((u >> 16) & 1u)) >> 16; }
__device__ __forceinline__ unsigned pk2(float lo, float hi) { return f2bf(lo) | (f2bf(hi) << 16); }
__device__ __forceinline__ float bf2f(unsigned short b) { return __builtin_bit_cast(float, (unsigned)b << 16); }
__device__ __forceinline__ float bflo(unsigned w) { return __builtin_bit_cast(float, w << 16); }
__device__ __forceinline__ float bfhi(unsigned w) { return __builtin_bit_cast(float, w & 0xffff0000u); }

#define XB_TMO      128
#define XB_XCNT(j)  (256  + 64 * (j))
#define XB_XSUB(j)  (1280 + 64 * (j))
#define XB_XGEN(j)  (2304 + 64 * (j))
#define XB_TOP      3328
#define XB_TOPGEN   3392
#define XCD_BAR_WORDS 3456
#define XB_LFLAG(j) (3456 + 64 * (j))
#define XB_SPIN_CAP (1u << 18)

__device__ __forceinline__ unsigned xb_ld(unsigned* p)              { return __hip_atomic_load(p, __ATOMIC_RELAXED, __HIP_MEMORY_SCOPE_AGENT); }
__device__ __forceinline__ unsigned xb_add(unsigned* p, unsigned v) { return __hip_atomic_fetch_add(p, v, __ATOMIC_RELAXED, __HIP_MEMORY_SCOPE_AGENT); }
__device__ __forceinline__ unsigned xb_xcc_id() { return (unsigned)__builtin_amdgcn_s_getreg((3 << 11) | 20) & 0xFu; }
#define XB_SPIN(cond, bar) do { unsigned _sp = 0; while (cond) { __builtin_amdgcn_s_sleep(1); \
    if ((++_sp & 255u) == 0u) { if (xb_ld(&(bar)[XB_TMO])) break; if (_sp > XB_SPIN_CAP) { atomicAdd(&(bar)[XB_TMO], 1u); break; } } } } while (0)

struct XcdBarrier {
    unsigned* bar; unsigned x;
    volatile LAS unsigned* st;
};

__device__ __forceinline__ XcdBarrier xcd_barrier_post(unsigned* bar, volatile LAS unsigned* st, int tid) {
    XcdBarrier b; b.bar = bar; b.x = xb_xcc_id(); b.st = st;
    if (tid == 0) st[3] = xb_add(&bar[XB_XCNT(b.x)], 1u);
    return b;
}
__device__ __forceinline__ void xcd_barrier_complete(unsigned* bar, unsigned x, unsigned& nloc, unsigned& nx, unsigned& uni) {
    const unsigned G = gridDim.x * gridDim.y * gridDim.z;
    unsigned sum, cnt, mine, sp = 0u;
    for (;;) {
        sum = 0u; cnt = 0u; mine = 0u; uni = 1u;
#pragma unroll
        for (unsigned j = 0; j < 16; ++j) { const unsigned c = xb_ld(&bar[XB_XCNT(j)]); sum += c; cnt += (c > 0u) ? 1u : 0u; mine = (j == x) ? c : mine; uni &= (c == (j < 8u ? 32u : 0u)) ? 1u : 0u; }
        if (sum == G) break;
        __builtin_amdgcn_s_sleep(1);
        if ((++sp & 255u) == 0u) { if (xb_ld(&bar[XB_TMO])) break; if (sp > XB_SPIN_CAP) { atomicAdd(&bar[XB_TMO], 1u); break; } }
    }
    nloc = mine > 0u ? mine : 1u; nx = cnt > 0u ? cnt : 1u; if (sum != G || G != 256u) uni = 0u;
}

template <bool LOCAL> __device__ __forceinline__ void xcd_barrier(const XcdBarrier& b, int tid) {
    if (LOCAL) {
        asm volatile("s_waitcnt vmcnt(0)" ::: "memory");
        __syncthreads();
        if (tid < 64) {
            unsigned* fl = b.bar + XB_LFLAG(b.x);
            const unsigned n = __builtin_amdgcn_readfirstlane(b.st[4]) + 1u;
            if (tid == 0) { b.st[4] = n; __hip_atomic_store(fl + b.st[3], n, __ATOMIC_RELAXED, __HIP_MEMORY_SCOPE_WORKGROUP); }
            unsigned sp = 0u;
            for (;;) { const unsigned v = tid < 32 ? xb_ld(fl + tid) : n;
                if (__builtin_amdgcn_ballot_w64(v < n) == 0ull) break;
                __builtin_amdgcn_s_sleep(1);
                if ((++sp & 255u) == 0u) { if (xb_ld(&b.bar[XB_TMO])) break; if (sp > XB_SPIN_CAP) { if (tid == 0) atomicAdd(&b.bar[XB_TMO], 1u); break; } } }
            __builtin_amdgcn_fence(__ATOMIC_ACQUIRE, "agent");
            asm volatile("s_waitcnt vmcnt(0)" ::: "memory");
        }
        __syncthreads();
        return;
    }
    asm volatile("s_waitcnt vmcnt(0)" ::: "memory");
    __syncthreads();
    if (tid == 0) {
        unsigned* bar = b.bar;
        __builtin_amdgcn_s_waitcnt(0);
        unsigned nloc = b.st[0], nx = b.st[1];
        if (nloc == 0u) { unsigned uni_; xcd_barrier_complete(bar, b.x, nloc, nx, uni_); b.st[0] = nloc; b.st[1] = nx; b.st[2] = uni_; }
        const unsigned old = xb_add(&bar[XB_XSUB(b.x)], 1u);
        const unsigned gen = old / nloc;
        if (old + 1u == (gen + 1u) * nloc) {
            __builtin_amdgcn_fence(__ATOMIC_RELEASE, "agent");
            asm volatile("s_waitcnt vmcnt(0)" ::: "memory");
            const unsigned og = xb_add(&bar[XB_TOP], 1u);
            const unsigned tg = og / nx;
            if (og + 1u == (tg + 1u) * nx) xb_add(&bar[XB_TOPGEN], 1u);
            else XB_SPIN(xb_ld(&bar[XB_TOPGEN]) == tg, bar);
            __builtin_amdgcn_fence(__ATOMIC_ACQUIRE, "agent");
            xb_add(&bar[XB_XGEN(b.x)], 1u);
            asm volatile("s_waitcnt vmcnt(0)" ::: "memory");
        } else {
            XB_SPIN(xb_ld(&bar[XB_XGEN(b.x)]) == gen, bar);
            __builtin_amdgcn_fence(__ATOMIC_ACQUIRE, "agent");
            asm volatile("s_waitcnt vmcnt(0)" ::: "memory");
        }
    }
    __syncthreads();
}

struct Args { const float* in[20]; float* out; unsigned char* ws; };
typedef const __attribute__((address_space(4))) Args* KArgs;
__device__ __forceinline__ KArgs fresh_args() { KArgs p = (KArgs)__builtin_amdgcn_kernarg_segment_ptr(); asm volatile("" : "+s"(p)); return p; }
__device__ __forceinline__ int fresh_tid(int wave_s) { int t; asm volatile("v_mbcnt_lo_u32_b32 %0, -1, 0\n\tv_mbcnt_hi_u32_b32 %0, -1, %0" : "=v"(t)); return (wave_s << 6) | t; }
enum { I_X = 0, I_MEM, I_NMIX, I_NXATTN, I_NMEM, I_NMLP, I_NFINAL, I_WIN, I_BIN, I_LBLOG, I_HNORM, I_CONVW, I_CONVB, I_MNORM, I_WOUT, I_WXQ, I_WXKV, I_WXO, I_WUP, I_WDOWN };

__device__ __forceinline__ float wave_sum(float v, int lane) {
#pragma unroll
    for (int o = 1; o < 64; o <<= 1) v += pg8::sx(v, o, lane);
    return v;
}
struct TDesc { const float* W; int ldw, nvalid; bf16* WT; int ldt; const float* g; float scale; int item, nblk; int useg; };
__device__ __forceinline__ void titem_load(const TDesc& d, int lane, float (&vv_)[32], f32x4 (&gv)[2]) {
    const int kb = d.item / d.nblk, nb = d.item % d.nblk, k0 = 64 * kb, n0 = 32 * nb; const int n = n0 + (lane & 31);
    const bool ok_ = n < d.nvalid; const float* wp_ = d.W + (size_t)(k0 + (lane >> 5)) * d.ldw + (ok_ ? n : 0);
#pragma unroll
    for (int i = 0; i < 32; ++i) vv_[i] = wp_[(size_t)(2 * i) * d.ldw];
    const float* gp = d.g + (k0 & 1023) + 8 * (lane & 7);
    gv[0] = *(const f32x4*)gp; gv[1] = *(const f32x4*)(gp + 4);
}
__device__ __forceinline__ void titem_store(const TDesc& d, float* scr, int lane, float (&vv_)[32], const f32x4 (&gv)[2]) {
    const int kb = d.item / d.nblk, nb = d.item % d.nblk, k0 = 64 * kb, n0 = 32 * nb; const int n = n0 + (lane & 31);
    const bool ok_ = n < d.nvalid;
#pragma unroll
    for (int i = 0; i < 32; ++i) { const int kk = 2 * i + (lane >> 5); const float v = ok_ ? vv_[i] * d.scale : 0.f;
        scr[kk * 33 + (lane & 31)] = v; }
    LDS_WAIT(); asm volatile("" ::: "memory");
    const int c = lane & 7; const f32x4 one4 = (f32x4){1.f, 1.f, 1.f, 1.f}; const f32x4 g0_ = d.useg ? gv[0] : one4, g1_ = d.useg ? gv[1] : one4;
#pragma unroll
    for (int j = 0; j < 4; ++j) { const int nn = (lane >> 3) + 8 * j; const float* s = scr + (8 * c) * 33 + nn;
        v4u o; o.x = pk2(s[0 * 33] * g0_[0], s[1 * 33] * g0_[1]); o.y = pk2(s[2 * 33] * g0_[2], s[3 * 33] * g0_[3]); o.z = pk2(s[4 * 33] * g1_[0], s[5 * 33] * g1_[1]); o.w = pk2(s[6 * 33] * g1_[2], s[7 * 33] * g1_[3]);
        *(v4u*)(d.WT + (size_t)(n0 + nn) * d.ldt + k0 + 8 * c) = o; }
    LDS_WAIT(); asm volatile("" ::: "memory");
}
template <class DF> __device__ __forceinline__ void titem_pipeline(DF df, int first, int step, int nit, float* scr, int lane) {
    float va[32], vb[32]; f32x4 ga[2], gb[2]; TDesc da, db; int it = first;
    if (it >= nit) return;
    da = df(it); titem_load(da, lane, va, ga);
    for (;;) {
        int nx = it + step; const bool hb = nx < nit;
        if (hb) { db = df(nx); titem_load(db, lane, vb, gb); }
        titem_store(da, scr, lane, va, ga);
        if (!hb) break;
        it = nx; nx = it + step; const bool ha = nx < nit;
        if (ha) { da = df(nx); titem_load(da, lane, va, ga); }
        titem_store(db, scr, lane, vb, gb);
        if (!ha) break;
        it = nx;
    }
}
__device__ __forceinline__ void convert_layer(KArgs a, int l, unsigned char* lds, int gw, int ngw, int wave, int lane) {
    float* scr = (float*)(lds + wave * 16384);
    bf16* W = (bf16*)(a->ws + ((l & 1) ? WS_W2 : WS_W));
    constexpr int I_A = 16 * (DINP / 32), I_B = 16 * 32, I_U = 16 * (DFF / 32), I_D = 64 * 32;
    constexpr int NIT = I_A + 2 * I_B + I_U + I_D;
    auto df = [=](int it) -> TDesc { int r = it; TDesc d;
        if (r < I_A) { d = TDesc{a->in[I_WIN] + (size_t)l * DM * DIN, DIN, DIN, W + WO_IN / 2, DM, a->in[I_NMIX] + l * DM, 1.f, r, DINP / 32, 1}; return d; } r -= I_A;
        if (r < I_B) { d = TDesc{a->in[I_WOUT] + (size_t)l * DM * DM, DM, DM, W + WO_OUT / 2, DM, a->in[I_NFINAL], 1.f, r, 32, 0}; return d; } r -= I_B;
        if (r < I_B) { d = TDesc{a->in[I_WXO] + (size_t)l * DM * DM, DM, DM, W + WO_XO / 2, DM, a->in[I_NFINAL], 1.f, r, 32, 0}; return d; } r -= I_B;
        if (r < I_U) { d = TDesc{a->in[I_WUP] + (size_t)l * DM * DFF, DFF, DFF, W + WO_UP / 2, DM, a->in[I_NMLP] + l * DM, 1.f, r, DFF / 32, 1}; return d; } r -= I_U;
        d = TDesc{a->in[I_WDOWN] + (size_t)l * DFF * DM, DM, DM, W + WO_DOWN / 2, DFF, a->in[I_NFINAL], 1.f, r, 32, 0}; return d; };
    titem_pipeline(df, gw, ngw, NIT, scr, lane);
    { const float* Wq = a->in[I_WXQ] + (size_t)l * DM * DM; const float* gq = a->in[I_NXATTN] + l * DM; bf16* O = W + WO_XQ / 2;
      for (int k = gw; k < DM; k += 2 * ngw) { const int k2 = k + ngw; const bool h2 = k2 < DM;
          f32x4 v0[4], v1[4];
#pragma unroll
          for (int j = 0; j < 4; ++j) { v0[j] = ((const f32x4*)(Wq + (size_t)k * DM) + lane)[64 * j]; v1[j] = h2 ? ((const f32x4*)(Wq + (size_t)k2 * DM) + lane)[64 * j] : (f32x4){0.f, 0.f, 0.f, 0.f}; }
          const float sc0 = gq[k] * 0.0625f, sc1 = h2 ? gq[k2] * 0.0625f : 0.f;
          unsigned long long* o0 = (unsigned long long*)(O + (size_t)k * DM) + lane; unsigned long long* o1 = (unsigned long long*)(O + (size_t)k2 * DM) + lane;
#pragma unroll
          for (int j = 0; j < 4; ++j) { const f32x4 v = v0[j] * sc0; o0[64 * j] = (unsigned long long)pk2(v[0], v[1]) | ((unsigned long long)pk2(v[2], v[3]) << 32); }
          if (h2) {
#pragma unroll
              for (int j = 0; j < 4; ++j) { const f32x4 v = v1[j] * sc1; o1[64 * j] = (unsigned long long)pk2(v[0], v[1]) | ((unsigned long long)pk2(v[2], v[3]) << 32); } } } }
}
__device__ __forceinline__ void prologue(KArgs a, unsigned char* lds, int gw, int ngw, int wave, int lane, int tid) {
    if (blockIdx.x == 0) { float* LB = (float*)(a->ws + WS_LB);
        for (int i = tid; i < 2 * 512; i += NTHREADS) { const int dir = i >> 9, c = i & 511; const float* lg = a->in[I_LBLOG] + (size_t)dir * DEPTH * 512 + c;
            const float l0 = lg[0], l1 = lg[512], l2 = lg[1024], l3 = lg[1536]; const float mx = fmaxf(fmaxf(l0, l1), fmaxf(l2, l3));
            const float e0 = expf(l0 - mx), e1 = expf(l1 - mx), e2 = expf(l2 - mx), e3 = expf(l3 - mx); const float inv = 1.f / (e0 + e1 + e2 + e3);
            LB[(0 * 2 + dir) * 512 + c] = 0.f; LB[(1 * 2 + dir) * 512 + c] = e1 * inv; LB[(2 * 2 + dir) * 512 + c] = (e1 + e2) * inv; LB[(3 * 2 + dir) * 512 + c] = (e1 + e2 + e3) * inv; } }
    { bf16* XB = (bf16*)(a->ws + WS_XB); float* SS = (float*)(a->ws + WS_SS); const float* x = a->in[I_X];
      for (int m0 = gw; m0 < M; m0 += 4 * ngw) { f32x4 v[4][4]; float s4[4];
#pragma unroll
          for (int r = 0; r < 4; ++r) { const int m = m0 + r * ngw; const int mm = m < M ? m : gw; const f32x4* xr = (const f32x4*)(x + (size_t)mm * DM) + lane;
#pragma unroll
              for (int j = 0; j < 4; ++j) v[r][j] = xr[64 * j]; }
#pragma unroll
          for (int r = 0; r < 4; ++r) { float s = 0.f;
#pragma unroll
              for (int j = 0; j < 4; ++j) s += (v[r][j][0] * v[r][j][0] + v[r][j][1] * v[r][j][1]) + (v[r][j][2] * v[r][j][2] + v[r][j][3] * v[r][j][3]);
              s4[r] = s; }
#pragma unroll
          for (int o_ = 1; o_ < 64; o_ <<= 1) {
#pragma unroll
              for (int r = 0; r < 4; ++r) s4[r] += pg8::sx(s4[r], o_, lane); }
          __builtin_amdgcn_sched_barrier(0);
#pragma unroll
          for (int r = 0; r < 4; ++r) { const int m = m0 + r * ngw; if (m >= M) break;
              unsigned long long* o8 = (unsigned long long*)(XB + (size_t)m * DM) + lane;
#pragma unroll
              for (int j = 0; j < 4; ++j) o8[64 * j] = (unsigned long long)pk2(v[r][j][0], v[r][j][1]) | ((unsigned long long)pk2(v[r][j][2], v[r][j][3]) << 32);
              if (lane < 16) SS[(size_t)m * 16 + lane] = lane == 0 ? s4[r] : 0.f; } } }
    { bf16* MB = (bf16*)((unsigned char*)a->out + OT_MEMB); const float* x = a->in[I_MEM];
      for (int m = gw; m < MMEM; m += ngw) { const f32x4* xr = (const f32x4*)(x + (size_t)m * DM) + lane; f32x4 v[4]; float s = 0.f;
#pragma unroll
          for (int j = 0; j < 4; ++j) { v[j] = xr[64 * j]; s += (v[j][0] * v[j][0] + v[j][1] * v[j][1]) + (v[j][2] * v[j][2] + v[j][3] * v[j][3]); }
          const float rs = 1.0f / sqrtf(wave_sum(s, lane) * (1.0f / DM) + 1e-6f);
          unsigned long long* o8 = (unsigned long long*)(MB + (size_t)m * DM) + lane;
#pragma unroll
          for (int j = 0; j < 4; ++j) o8[64 * j] = (unsigned long long)pk2(v[j][0] * rs, v[j][1] * rs) | ((unsigned long long)pk2(v[j][2] * rs, v[j][3] * rs) << 32); } }
    { float* scr = (float*)(lds + wave * 16384); bf16* WKT = (bf16*)((unsigned char*)a->out + OT_WKT); bf16* WVT = (bf16*)((unsigned char*)a->out + OT_WVT);
      auto df = [=](int it) -> TDesc { const int l = it >> 10, part = (it >> 9) & 1, r = it & 511;
          return TDesc{a->in[I_WXKV] + (size_t)l * DM * 2048 + part * 1024, 2048, 1024, (part ? WVT : WKT) + (size_t)l * 1024 * DM, DM, a->in[I_NMEM] + l * DM, 1.f, r, 32, 1}; };
      titem_pipeline(df, gw, ngw, DEPTH * 2 * 512, scr, lane); }
    convert_layer(a, 0, lds, gw, ngw, wave, lane);
}
__device__ __forceinline__ void final_phase(KArgs a, int gw, int ngw, int lane) {
    const float* g = a->in[I_NFINAL] + lane * 16; const bf16* XB = (const bf16*)(a->ws + WS_XB);
    f32x4 gg[4];
#pragma unroll
    for (int j = 0; j < 4; ++j) gg[j] = *(const f32x4*)(g + 4 * j);
    for (int m0 = gw; m0 < M; m0 += 8 * ngw) {
        v4u w0[8], w1[8]; float s8[8];
#pragma unroll
        for (int r = 0; r < 8; ++r) { const int m = m0 + r * ngw; const int mm = m < M ? m : gw;
            w0[r] = *(const v4u*)(XB + (size_t)mm * DM + lane * 16); w1[r] = *(const v4u*)(XB + (size_t)mm * DM + lane * 16 + 8); }
#pragma unroll
        for (int r = 0; r < 8; ++r) { float s = 0.f;
#pragma unroll
            for (int j = 0; j < 4; ++j) { const float a0 = bflo(w0[r][j]), a1 = bfhi(w0[r][j]), a2 = bflo(w1[r][j]), a3 = bfhi(w1[r][j]); s += (a0 * a0 + a1 * a1) + (a2 * a2 + a3 * a3); }
            s8[r] = s; }
#pragma unroll
        for (int o_ = 1; o_ < 64; o_ <<= 1) {
#pragma unroll
            for (int r = 0; r < 8; ++r) s8[r] += pg8::sx(s8[r], o_, lane); }
        __builtin_amdgcn_sched_barrier(0);
#pragma unroll
        for (int r = 0; r < 8; ++r) { const int m = m0 + r * ngw; if (m >= M) break;
            const float rs = 1.0f / sqrtf(s8[r] * (1.0f / DM) + 1e-6f);
            float x[16];
#pragma unroll
            for (int j = 0; j < 4; ++j) { x[2 * j] = bflo(w0[r][j]); x[2 * j + 1] = bfhi(w0[r][j]); x[8 + 2 * j] = bflo(w1[r][j]); x[8 + 2 * j + 1] = bfhi(w1[r][j]); }
            f32x4* o = (f32x4*)(a->out + (size_t)m * DM + lane * 16);
#pragma unroll
            for (int j = 0; j < 4; ++j) o[j] = (f32x4){x[4 * j] * rs * gg[j][0], x[4 * j + 1] * rs * gg[j][1], x[4 * j + 2] * rs * gg[j][2], x[4 * j + 3] * rs * gg[j][3]}; } }
}
namespace sc {
typedef short bf16x8 __attribute__((ext_vector_type(8)));
typedef float f32x4 __attribute__((ext_vector_type(4)));
typedef float f32x2 __attribute__((ext_vector_type(2)));
typedef unsigned u32x2 __attribute__((ext_vector_type(2)));
constexpr int LQ = 272, LS = 144;
constexpr int O_QS = 0, O_KS = O_QS + 64 * LQ, O_KDT = O_KS + 64 * LQ, O_VT = O_KDT + 128 * LS, O_KDT1 = O_VT + 64 * LS, O_VT1 = O_KDT1 + 128 * LS, O_P = O_VT1 + 64 * LS, O_ST = O_P + 64 * LS, O_SEG = O_ST + 80 * LQ,
              O_DEC = O_SEG + 4096, O_SCAL = O_DEC + 1024, O_NV = O_SCAL + 3072, O_PRE = O_NV + 1024, O_END = O_PRE + 3 * 32 * 64 * 4;
static_assert(O_END <= LDSCTL_OFF, "scan LDS map");
#define SC_BAR() do { __builtin_amdgcn_sched_barrier(0); asm volatile("s_waitcnt lgkmcnt(0)" ::: "memory"); __builtin_amdgcn_s_barrier(); asm volatile("" ::: "memory"); __builtin_amdgcn_sched_barrier(0); } while (0)
__device__ __forceinline__ bf16x8 frag(const unsigned char* base, int row, int pitch, int kbyte) { return *(const bf16x8*)(base + row * pitch + kbyte); }
__device__ __forceinline__ unsigned cvt2(float lo, float hi) { return pg8::cvt_pk_bf16(lo, hi); }
typedef _Float16 h2_t __attribute__((ext_vector_type(2)));
__device__ __forceinline__ f32x2 h2f(unsigned w) { return __builtin_convertvector(__builtin_bit_cast(h2_t, w), f32x2); }

constexpr int CW_CONV = 8192;
template <int NF> __device__ __forceinline__ void head_sync(unsigned* cnt, unsigned want, int slot, unsigned n, int mode, int tid, int uni);
__device__ __forceinline__ void mlstm_conv_part(KArgs a, int l, int b, int h, int part, int tid, int uni) {
    const int pair = tid & 127, which = pair >> 6, dp = pair & 63, rr = tid >> 7;
    unsigned char* R = a->ws + WS_R;
    const unsigned* src = (const unsigned*)((const bf16*)(R + (size_t)b * SLAB + (which ? S_MK : S_MQ)) + h * 128);
    unsigned* dst = (unsigned*)((bf16*)((unsigned char*)a->out + (which ? 16 * MiB : 0)) + h * 128) + (size_t)b * SEQ * 256;
    const float* cw = a->in[I_CONVW] + (size_t)l * 5 * 1024 + which * 512 + h * 128 + 2 * dp; const float* cb = a->in[I_CONVB] + (size_t)l * 1024 + which * 512 + h * 128 + 2 * dp;
    f32x2 w[5]; const f32x2 bias = *(const f32x2*)cb; const float sc = which ? 0.08838834764831845f : 1.0f;
#pragma unroll
    for (int j = 0; j < 5; ++j) w[j] = *(const f32x2*)(cw + j * 1024);
    const int t0 = 256 * part + 64 * rr;
    f32x2 x0, x1, x2, x3;
    { const unsigned z = 0u; const unsigned a0 = t0 >= 2 ? src[(size_t)(t0 - 2) * 256 + dp] : z, a1 = t0 >= 1 ? src[(size_t)(t0 - 1) * 256 + dp] : z, a2 = src[(size_t)t0 * 256 + dp], a3 = src[(size_t)(t0 + 1) * 256 + dp];
      x0 = (f32x2){bflo(a0), bfhi(a0)}; x1 = (f32x2){bflo(a1), bfhi(a1)}; x2 = (f32x2){bflo(a2), bfhi(a2)}; x3 = (f32x2){bflo(a3), bfhi(a3)}; }
    unsigned rawA[8], rawB[8];
#define CONV_LOAD(tb, raw) do { _Pragma("unroll") for (int i = 0; i < 8; ++i) { const int tn = t0 + (tb) + i + 2; raw[i] = src[(size_t)(tn < SEQ ? tn : SEQ - 1) * 256 + dp]; } } while (0)
#define CONV_FINISH(tb, raw) do { _Pragma("unroll") for (int i = 0; i < 8; ++i) { const int t = t0 + (tb) + i; const f32x2 x4 = (t + 2 < SEQ) ? (f32x2){bflo(raw[i]), bfhi(raw[i])} : (f32x2){0.f, 0.f}; \
            const f32x2 y = bias + w[0] * x0 + w[1] * x1 + w[2] * x2 + w[3] * x3 + w[4] * x4; \
            dst[(size_t)t * 256 + dp] = cvt2(y.x * pg8::sigm(y.x) * sc, y.y * pg8::sigm(y.y) * sc); \
            x0 = x1; x1 = x2; x2 = x3; x3 = x4; } } while (0)
    CONV_LOAD(0, rawA);
#pragma unroll
    for (int tb = 0; tb < 64; tb += 16) {
        CONV_LOAD(tb + 8, rawB); __builtin_amdgcn_sched_barrier(0);
        CONV_FINISH(tb, rawA); __builtin_amdgcn_sched_barrier(0);
        if (tb + 16 < 64) CONV_LOAD(tb + 16, rawA);
        __builtin_amdgcn_sched_barrier(0);
        CONV_FINISH(tb + 8, rawB); __builtin_amdgcn_sched_barrier(0);
    }
#undef CONV_LOAD
#undef CONV_FINISH
    head_sync<8>((unsigned*)(a->ws + WS_CTL) + CW_CONV + 64 * (4 * b + h), 8u * (unsigned)(l + 1), part, (unsigned)(l + 1), 0, tid, uni);
}

constexpr int CW_MIX = 12288;
template <int NF> __device__ __forceinline__ void head_sync(unsigned* cnt, unsigned want, int slot, unsigned n, int mode, int tid, int uni) {
    const bool post = mode != 2, wait = mode != 0;
    if (post) { asm volatile("s_waitcnt vmcnt(0)" ::: "memory"); __syncthreads(); }
    if (uni) {
        if (tid < 64) { unsigned* fl = cnt + 8;
            if (tid == 0 && post) __hip_atomic_store(fl + slot, n, __ATOMIC_RELAXED, __HIP_MEMORY_SCOPE_WORKGROUP);
            unsigned spins = 0;
            if (wait) for (;;) { const unsigned v = tid < NF ? __hip_atomic_load(fl + tid, __ATOMIC_RELAXED, __HIP_MEMORY_SCOPE_AGENT) : n;
                if (__builtin_amdgcn_ballot_w64(v < n) == 0ull) break;
                __builtin_amdgcn_s_sleep(1); if (++spins > (1u << 22)) break; }
            if (wait) { __builtin_amdgcn_fence(__ATOMIC_ACQUIRE, "agent"); asm volatile("s_waitcnt vmcnt(0)" ::: "memory"); } }
    } else if (tid == 0) { if (post) { __builtin_amdgcn_fence(__ATOMIC_RELEASE, "agent"); asm volatile("s_waitcnt vmcnt(0)" ::: "memory");
        __hip_atomic_fetch_add(cnt, 1u, __ATOMIC_RELAXED, __HIP_MEMORY_SCOPE_AGENT); } unsigned spins = 0;
        if (wait) { while (__hip_atomic_load(cnt, __ATOMIC_RELAXED, __HIP_MEMORY_SCOPE_AGENT) < want) { __builtin_amdgcn_s_sleep(2); if (++spins > (1u << 22)) break; }
            __builtin_amdgcn_fence(__ATOMIC_ACQUIRE, "agent"); asm volatile("s_waitcnt vmcnt(0)" ::: "memory"); } }
    __syncthreads();
}
__device__ __forceinline__ void mix_quarter(KArgs a, int l, int type, int b, int h, int qi, int tid, int uni) {
    head_sync<4>((unsigned*)(a->ws + WS_CTL) + CW_MIX + 64 * (32 * type + 4 * b + h), 4u * (unsigned)(l + 1), qi, (unsigned)(l + 1), 1, tid, uni);
    const int lane = tid & 63, wave = tid >> 6, c16 = (lane & 7) * 16;
    unsigned char* R = a->ws + WS_R;
    unsigned char* SLB = R + (size_t)b * SLAB;
    const bf16* OF = (const bf16*)(SLB + S_OF) + type * 512 + h * 128 + c16; const bf16* OB = (const bf16*)(SLB + S_OB) + type * 512 + h * 128 + c16;
    bf16* GD = (bf16*)(SLB + (type ? S_MO : S_GG)) + h * 128 + c16;
    const float* gn = a->in[type ? I_MNORM : I_HNORM] + l * 512 + h * 128 + c16;
    float g[16];
#pragma unroll
    for (int j = 0; j < 16; ++j) g[j] = gn[j];
    const size_t m0 = (size_t)(512 * qi + 8 * wave + (lane >> 3));
    v4u L[2][2][6];
#define MIX_LOAD(ps, d) do { const size_t m_ = m0 + 64 * (ps); d[0] = *(const v4u*)(OF + m_ * 1024); d[1] = *(const v4u*)(OF + m_ * 1024 + 8); d[2] = *(const v4u*)(OB + m_ * 1024); d[3] = *(const v4u*)(OB + m_ * 1024 + 8); \
        d[4] = *(const v4u*)(GD + m_ * 512); d[5] = *(const v4u*)(GD + m_ * 512 + 8); } while (0)
#define MIX_FINISH(ps, d) do { const size_t m_ = m0 + 64 * (ps); float o[16]; float s_ = 0.f; \
        _Pragma("unroll") for (int j = 0; j < 16; ++j) { const unsigned fw = j < 8 ? d[0][(j >> 1) & 3] : d[1][(j >> 1) & 3], bw = j < 8 ? d[2][(j >> 1) & 3] : d[3][(j >> 1) & 3]; \
            o[j] = ((j & 1) ? bfhi(fw) : bflo(fw)) + ((j & 1) ? bfhi(bw) : bflo(bw)); s_ += o[j] * o[j]; } \
        s_ += pg8::sx(s_, 1, lane); s_ += pg8::sx(s_, 2, lane); s_ += pg8::sx(s_, 4, lane); \
        const float rs = __builtin_amdgcn_rsqf(s_ * (1.0f / 128.0f) + 1e-6f); \
        v4u w0, w1; \
        _Pragma("unroll") for (int j = 0; j < 16; j += 2) { const unsigned gw2 = j < 8 ? d[4][(j >> 1) & 3] : d[5][(j >> 1) & 3]; \
            const float z0 = bflo(gw2), z1 = bfhi(gw2), s0_ = pg8::sigm(z0), s1_ = pg8::sigm(z1);                  \
            const unsigned pk = cvt2(o[j] * rs * g[j] * (type ? s0_ : z0 * s0_), o[j + 1] * rs * g[j + 1] * (type ? s1_ : z1 * s1_)); \
            if (j < 8) w0[(j >> 1) & 3] = pk; else w1[(j >> 1) & 3] = pk; } \
        *(v4u*)(GD + m_ * 512) = w0; *(v4u*)(GD + m_ * 512 + 8) = w1; } while (0)
    MIX_LOAD(0, L[0][0]); MIX_LOAD(1, L[0][1]);
#pragma unroll
    for (int p = 0; p < 4; ++p) {
        if (p + 1 < 4) { MIX_LOAD(2 * p + 2, L[(p + 1) & 1][0]); MIX_LOAD(2 * p + 3, L[(p + 1) & 1][1]); }
        __builtin_amdgcn_sched_barrier(0);
        MIX_FINISH(2 * p, L[p & 1][0]); MIX_FINISH(2 * p + 1, L[p & 1][1]);
        __builtin_amdgcn_sched_barrier(0);
    }
#undef MIX_LOAD
#undef MIX_FINISH
}

template <int TYPE> __device__ __forceinline__ void scan_s1b(unsigned char* lds, const int par, unsigned (&lfh)[8], unsigned (&qv)[8], unsigned (&kv)[8], unsigned (&vv)[4], const f32x2 cl7,
                                                        const int dp, const int rg, const int ep, const int sv, const f32x2* SEG, const float* SWKp) {
    const int okdt = par ? O_KDT1 : O_KDT, ovt = par ? O_VT1 : O_VT; float* DECp = (float*)(lds + O_DEC) + par * 128; (void)DECp; (void)SWKp; (void)cl7; (void)SEG;
    { asm volatile("" : "+v"(vv[0]), "+v"(vv[1]), "+v"(vv[2]), "+v"(vv[3]));
#pragma unroll
      for (int i = 0; i < 8; i += 4) { asm volatile("" : "+v"(qv[i]), "+v"(qv[i + 1]), "+v"(qv[i + 2]), "+v"(qv[i + 3])); if (TYPE == 1) asm volatile("" : "+v"(kv[i]), "+v"(kv[i + 1]), "+v"(kv[i + 2]), "+v"(kv[i + 3])); }
      unsigned kd0[4], kd1[4];
      if (TYPE == 0) { f32x2 pre = (f32x2){0.f, 0.f}, tot = pre;
#pragma unroll
          for (int j = 0; j < 8; ++j) { const f32x2 s_ = SEG[j * 64 + dp]; tot += s_; if (j < rg) pre += s_; }
          f32x2 f[8], kk[8];
#pragma unroll
          for (int i = 0; i < 8; ++i) { f[i] = h2f(lfh[i]); kk[i] = 1.0f - f[i]; }
          f32x2 E; E.x = __expf(pre.x); E.y = __expf(pre.y);
          f32x2 G; { const f32x2 ex = tot - (pre + cl7); G.x = __expf(ex.x); G.y = __expf(ex.y); }
          float kdx[8], kdy[8];
#pragma unroll
          for (int i = 7; i >= 0; --i) { const f32x2 kd = kk[i] * G; kdx[i] = kd.x; kdy[i] = kd.y; G = G * f[i]; }
#pragma unroll
          for (int i = 0; i < 8; ++i) { const int p = 8 * rg + i; E = E * f[i];
              const f32x2 qs = (f32x2){bflo(qv[i]), bfhi(qv[i])} * E;
              f32x2 ks; ks.x = kk[i].x * __builtin_amdgcn_rcpf(fmaxf(E.x, 1e-35f)); ks.y = kk[i].y * __builtin_amdgcn_rcpf(fmaxf(E.y, 1e-35f));
              *(unsigned*)(lds + O_QS + p * LQ + dp * 4) = cvt2(qs.x, qs.y);
              *(unsigned*)(lds + O_KS + p * LQ + dp * 4) = cvt2(ks.x, ks.y); }
#pragma unroll
          for (int i = 0; i < 4; ++i) { kd0[i] = cvt2(kdx[2 * i], kdx[2 * i + 1]); kd1[i] = cvt2(kdy[2 * i], kdy[2 * i + 1]); }
          if (rg == 0) { f32x2 dd; dd.x = __expf(tot.x); dd.y = __expf(tot.y); *(f32x2*)(DECp + 2 * dp) = dd; }
      } else {
          const f32x4 wk0 = *(const f32x4*)(SWKp + 8 * rg), wk1 = *(const f32x4*)(SWKp + 8 * rg + 4);
          float kdx[8], kdy[8];
#pragma unroll
          for (int i = 0; i < 8; ++i) { const int p = 8 * rg + i;
              *(unsigned*)(lds + O_QS + p * LQ + dp * 4) = qv[i];
              *(unsigned*)(lds + O_KS + p * LQ + dp * 4) = kv[i];
              const float w_ = i < 4 ? wk0[i & 3] : wk1[i & 3]; kdx[i] = bflo(kv[i]) * w_; kdy[i] = bfhi(kv[i]) * w_; }
#pragma unroll
          for (int i = 0; i < 4; ++i) { kd0[i] = cvt2(kdx[2 * i], kdx[2 * i + 1]); kd1[i] = cvt2(kdy[2 * i], kdy[2 * i + 1]); }
      }
      *(v4u*)(lds + okdt + (2 * dp) * LS + 16 * rg) = (v4u){kd0[0], kd0[1], kd0[2], kd0[3]};
      *(v4u*)(lds + okdt + (2 * dp + 1) * LS + 16 * rg) = (v4u){kd1[0], kd1[1], kd1[2], kd1[3]};
      u32x2 w0, w1; w0.x = (vv[0] & 0xffffu) | (vv[1] << 16); w0.y = (vv[2] & 0xffffu) | (vv[3] << 16); w1.x = (vv[0] >> 16) | (vv[1] & 0xffff0000u); w1.y = (vv[2] >> 16) | (vv[3] & 0xffff0000u);
      *(u32x2*)(lds + ovt + (2 * ep) * LS + 8 * sv) = w0; *(u32x2*)(lds + ovt + (2 * ep + 1) * LS + 8 * sv) = w1; }
}

template <int TYPE> __device__ __forceinline__ void scan_item(KArgs a, int l, int item, unsigned char* lds, int tid, int uni) {
    const int lane = tid & 63, wave = __builtin_amdgcn_readfirstlane(tid >> 6), fr = lane & 15, fq = lane >> 4;
    const int dir = (item >> 6) & 1, b = (item >> 3) & 7, h = (item >> 1) & 3, half = item & 1;
    unsigned char* R = a->ws + WS_R + (size_t)b * SLAB;
    bf16* OUT = (bf16*)(R + (dir ? S_OB : S_OF)) + TYPE * 512 + h * 128 + half * 64;
    const int dp = lane, rg = wave;
    const int ep = tid & 31, sv = tid >> 5;
    const int rstep = dir ? -1 : 1;
    const int row00 = dir ? SEQ - 1 : 0;
#define SC_RLO(c) (dir ? row00 - ((c) * 64 + 63) : row00 + (c) * 64)
#define SC_LR(p) (dir ? 63 - (p) : (p))
    unsigned lfh[2][8], qv[2][8], kv[2][8], vv[2][4];
    const unsigned* Qb = (const unsigned*)((const bf16*)(TYPE == 0 ? R + S_QH : (unsigned char*)a->out + (size_t)b * SEQ * 1024) + h * 128);
    const unsigned* Kb = (const unsigned*)((const bf16*)((unsigned char*)a->out + 16 * MiB + (size_t)b * SEQ * 1024) + h * 128);
    const unsigned* Vb = (const unsigned*)((const bf16*)(R + (TYPE == 0 ? S_VH : S_MV)) + h * 128 + half * 64);
    const unsigned* Lb = (const unsigned*)((const unsigned short*)(R + S_LF) + (size_t)dir * SEQ * 512 + h * 128);
    const float* GT = (const float*)(R + S_GT) + dir * 4 + h;
    const unsigned voffv = (unsigned)(SC_LR(4 * sv) * 256 + ep);
    const unsigned voffg = (unsigned)(SC_LR(lane) * 16);
#define SC_LOAD(c, u) do { long rlo_ = SC_RLO(c); asm volatile("" : "+s"(rlo_));     \
        if (TYPE == 0) { _Pragma("unroll") for (int i = 0; i < 8; ++i) { const long r = (rlo_ + SC_LR(8 * rg + i)) * 256; lfh[u][i] = Lb[r + dp]; qv[u][i] = Qb[r + dp]; } } \
        else { _Pragma("unroll") for (int i = 0; i < 8; ++i) { const long r = (rlo_ + SC_LR(8 * rg + i)) * 256; qv[u][i] = Qb[r + dp]; kv[u][i] = Kb[r + dp]; } \
        } \
        _Pragma("unroll") for (int i = 0; i < 4; ++i) { const unsigned vo_ = voffv + (unsigned)(rstep * i * 256); vv[u][i] = Vb[rlo_ * 256 + vo_]; } } while (0)
    f32x4 Sacc[4], Sx = (f32x4){0.f, 0.f, 0.f, 0.f};
#pragma unroll
    for (int et = 0; et < 4; ++et) Sacc[et] = (f32x4){0.f, 0.f, 0.f, 0.f};
    bf16x8 ONES; { const short o_ = (fr & 3) == 0 ? (short)0x3F80 : (short)0; ONES = (bf16x8){o_, o_, o_, o_, o_, o_, o_, o_}; }
    float m_prev = 0.f;
    for (int i = tid; i < 80 * LQ / 4; i += NTHREADS) ((unsigned*)(lds + O_ST))[i] = 0u;
    f32x2* SEG = (f32x2*)(lds + O_SEG); float* DEC = (float*)(lds + O_DEC); float* SCL = (float*)(lds + O_SCAL);
    float* PRE = (float*)(lds + O_PRE);
    if (TYPE == 1) {
        for (int cc = wave; cc < SEQ / 64; cc += NWAVES) { const long rl = SC_RLO(cc); const float gi_ = GT[rl * 16 + voffg], gf_ = GT[rl * 16 + voffg + 8];
            float cum = gf_;
#pragma unroll
            for (int o = 1; o < 64; o <<= 1) { const float t_ = pg8::sx_up(cum, o, lane); if (lane >= o) cum += t_; }
            const float bb = gi_ - cum; float pm = bb;
#pragma unroll
            for (int o = 1; o < 64; o <<= 1) { const float t_ = pg8::sx_up(pm, o, lane); if (lane >= o) pm = fmaxf(pm, t_); }
            PRE[cc * 64 + lane] = cum; PRE[2048 + cc * 64 + lane] = bb; PRE[4096 + cc * 64 + lane] = pm; } }
    if (TYPE == 1) head_sync<8>((unsigned*)(a->ws + WS_CTL) + CW_CONV + 64 * (4 * b + h), 8u * (unsigned)(l + 1), 0, (unsigned)(l + 1), 2, tid, uni);
    SC_LOAD(0, 0); SC_LOAD(1, 1);
    SC_BAR();
    f32x2 cl7 = (f32x2){0.f, 0.f};
#define SC_S1A(cn, u) do { if (TYPE == 0) { f32x2 p_ = (f32x2){1.f, 1.f}; _Pragma("unroll") for (int i = 0; i < 8; ++i) p_ = p_ * h2f(lfh[u][i]); f32x2 c_; c_.x = __logf(fmaxf(p_.x, 1e-37f)); c_.y = __logf(fmaxf(p_.y, 1e-37f)); cl7 = c_; SEG[rg * 64 + dp] = c_; } \
        else if (wave == 0) { const float cum = PRE[(cn) * 64 + lane], bb = PRE[2048 + (cn) * 64 + lane], pm = PRE[4096 + (cn) * 64 + lane], cum_last = PRE[(cn) * 64 + 63], pm_last = PRE[4096 + (cn) * 64 + 63]; \
            const float li = cum + m_prev, mt = fmaxf(cum + pm, li); \
            const float m_new = fmaxf(cum_last + m_prev, cum_last + pm_last); \
            float* W_ = SCL + ((cn) & 1) * 384; W_[lane] = cum - mt; W_[64 + lane] = bb; W_[128 + lane] = __expf(li - mt); W_[192 + lane] = __expf(-mt); W_[256 + lane] = __expf(cum_last + bb - m_new); if (lane == 0) W_[320] = __expf(cum_last + m_prev - m_new); \
            m_prev = m_new; } } while (0)
    SC_S1A(0, 0);
    SC_BAR();
    scan_s1b<TYPE>(lds, 0, lfh[0], qv[0], kv[0], vv[0], cl7, dp, rg, ep, sv, SEG, SCL + 256);
    SC_LOAD(2, 0);
    SC_BAR();
#pragma unroll 1
    for (int c0 = 0; c0 < SEQ / 64; c0 += 2)
#pragma unroll
    for (int u = 0; u < 2; ++u) { const int c = c0 + u;
        const float* SA = SCL + (c & 1) * 384; const float* SB = SA + 64; const float* SWI = SA + 128; const float* SEM = SA + 192; const float* SWK = SA + 256; const float* SCAR = SA + 320;
        (void)SB; (void)SWI; (void)SEM; (void)SWK; (void)SCAR;
        const int tt = wave >> 1, c2 = (wave & 1) * 2;
        f32x4 oacc[2]; float dqv = 0.f;
        { f32x4 sacc[2]; sacc[0] = sacc[1] = oacc[0] = oacc[1] = (f32x4){0.f, 0.f, 0.f, 0.f};
          bf16x8 Bq[4], Ak[2][4], As[2][4], Ax[4];
#pragma unroll
          for (int ks = 0; ks < 4; ++ks) { const int kb = (32 * ks + 8 * fq) * 2; Bq[ks] = frag(lds + O_QS, 16 * tt + fr, LQ, kb);
#pragma unroll
              for (int j = 0; j < 2; ++j) { Ak[j][ks] = frag(lds + O_KS, 16 * (c2 + j) + fr, LQ, kb); As[j][ks] = frag(lds + O_ST, 16 * (c2 + j) + fr, LQ, kb); }
              if (TYPE == 1) Ax[ks] = frag(lds + O_ST, 64 + fr, LQ, kb); }
#pragma unroll
          for (int ks = 0; ks < 4; ++ks)
#pragma unroll
              for (int j = 0; j < 2; ++j) { sacc[j] = __builtin_amdgcn_mfma_f32_16x16x32_bf16(Ak[j][ks], Bq[ks], sacc[j], 0, 0, 0);
                                            oacc[j] = __builtin_amdgcn_mfma_f32_16x16x32_bf16(As[j][ks], Bq[ks], oacc[j], 0, 0, 0); }
          if (TYPE == 1) { f32x4 ox = (f32x4){0.f, 0.f, 0.f, 0.f};
#pragma unroll
              for (int ks = 0; ks < 4; ++ks) ox = __builtin_amdgcn_mfma_f32_16x16x32_bf16(Ax[ks], Bq[ks], ox, 0, 0, 0);
              dqv = ox[0]; }
          const int t_ = 16 * tt + fr; const float sa = TYPE == 1 ? SA[t_] : 0.f;
#pragma unroll
          for (int j = 0; j < 2; ++j) { const int s0 = 16 * (c2 + j) + 4 * fq; f32x4 pv = sacc[j];
              if (TYPE == 1) { const f32x4 sb = *(const f32x4*)(SB + s0);
#pragma unroll
                  for (int r = 0; r < 4; ++r) pv[r] *= __expf(fminf(sa + sb[r], 0.f)); }
#pragma unroll
              for (int r = 0; r < 4; ++r) pv[r] = (s0 + r <= t_) ? pv[r] : 0.f;
              u32x2 w; w.x = cvt2(pv[0], pv[1]); w.y = cvt2(pv[2], pv[3]);
              *(u32x2*)(lds + O_P + t_ * LS + s0 * 2) = w; } }
        if (c + 1 < SEQ / 64) SC_S1A(c + 1, u ^ 1);
        SC_BAR();
        { const int t_ = 16 * tt + fr;
          bf16x8 Bp[2], Vf[2][2], Vs[4][2], Kd[2];
#pragma unroll
          for (int ks = 0; ks < 2; ++ks) { const int kb = (32 * ks + 8 * fq) * 2; Bp[ks] = frag(lds + O_P, t_, LS, kb);
#pragma unroll
              for (int j = 0; j < 2; ++j) Vf[j][ks] = frag(lds + (u ? O_VT1 : O_VT), 16 * (c2 + j) + fr, LS, kb); }
#pragma unroll
          for (int ks = 0; ks < 2; ++ks) { const int kb = (32 * ks + 8 * fq) * 2; Kd[ks] = frag(lds + (u ? O_KDT1 : O_KDT), 16 * wave + fr, LS, kb);
#pragma unroll
              for (int et = 0; et < 4; ++et) Vs[et][ks] = frag(lds + (u ? O_VT1 : O_VT), 16 * et + fr, LS, kb); }
          float wi = 1.f, sem = 0.f; f32x4 dv;
          if (TYPE == 0) dv = *(const f32x4*)(DEC + u * 128 + 16 * wave + 4 * fq); else { wi = SWI[t_]; sem = SEM[t_]; const float cr = SCAR[0]; dv = (f32x4){cr, cr, cr, cr}; }
          if (c + 1 < SEQ / 64) { scan_s1b<TYPE>(lds, u ^ 1, lfh[u ^ 1], qv[u ^ 1], kv[u ^ 1], vv[u ^ 1], cl7, dp, rg, ep, sv, SEG, SCL + (u ^ 1) * 384 + 256);
              if (c + 3 < SEQ / 64) SC_LOAD(c + 3, u ^ 1); }
          f32x4 pacc[2], px; pacc[0] = pacc[1] = px = (f32x4){0.f, 0.f, 0.f, 0.f};
#pragma unroll
          for (int ks = 0; ks < 2; ++ks) {
              pacc[0] = __builtin_amdgcn_mfma_f32_16x16x32_bf16(Vf[0][ks], Bp[ks], pacc[0], 0, 0, 0);
              pacc[1] = __builtin_amdgcn_mfma_f32_16x16x32_bf16(Vf[1][ks], Bp[ks], pacc[1], 0, 0, 0);
              if (TYPE == 1) px = __builtin_amdgcn_mfma_f32_16x16x32_bf16(ONES, Bp[ks], px, 0, 0, 0); }
#pragma unroll
          for (int et = 0; et < 4; ++et) Sacc[et] = Sacc[et] * dv;
          if (TYPE == 1) Sx = Sx * dv;
#pragma unroll
          for (int ks = 0; ks < 2; ++ks) {
#pragma unroll
              for (int et = 0; et < 4; ++et) Sacc[et] = __builtin_amdgcn_mfma_f32_16x16x32_bf16(Kd[ks], Vs[et][ks], Sacc[et], 0, 0, 0);
              if (TYPE == 1) Sx = __builtin_amdgcn_mfma_f32_16x16x32_bf16(Kd[ks], ONES, Sx, 0, 0, 0); }
          float rden = 1.f;
          if (TYPE == 1) { const float dn = px[0] + wi * dqv;
              rden = __builtin_amdgcn_rcpf(fmaxf(fabsf(dn), sem)); }
          bf16* orow = OUT + (size_t)SC_RLO(c) * 1024 + (unsigned)(SC_LR(t_) * 1024 + 4 * fq);
#pragma unroll
          for (int j = 0; j < 2; ++j) { f32x4 o;
              if (TYPE == 0) o = pacc[j] + oacc[j]; else o = (pacc[j] + oacc[j] * wi) * rden;
              u32x2 w; w.x = cvt2(o[0], o[1]); w.y = cvt2(o[2], o[3]);
              *(u32x2*)(orow + 16 * (c2 + j)) = w; }
#pragma unroll
          for (int et = 0; et < 4; ++et) { u32x2 w; w.x = cvt2(Sacc[et][0], Sacc[et][1]); w.y = cvt2(Sacc[et][2], Sacc[et][3]);
              *(u32x2*)(lds + O_ST + (16 * et + fr) * LQ + (16 * wave + 4 * fq) * 2) = w; }
          if (TYPE == 1) { u32x2 w; w.x = cvt2(Sx[0], Sx[1]); w.y = cvt2(Sx[2], Sx[3]);
              *(u32x2*)(lds + O_ST + (64 + fr) * LQ + (16 * wave + 4 * fq) * 2) = w; } }
        SC_BAR();
    }
#undef SC_LOAD
#undef SC_RLO
#undef SC_LR
#undef SC_S1A
}
}
constexpr int TAB_RS = 131072, TAB_LB = TAB_RS + 1024, TAB_BI = TAB_LB + 4096;
static_assert(TAB_BI + DIN * 4 <= LDSCTL_OFF, "epilogue tables");
__device__ __forceinline__ void stage_rstd(LAS unsigned char* lds, const float* SS, int pm, int tid) {
    if (tid < 256) { const float* p = SS + (size_t)(pm * 256 + tid) * 16;
        const f32x4 a0 = *(const f32x4*)p, a1 = *(const f32x4*)(p + 4), a2 = *(const f32x4*)(p + 8), a3 = *(const f32x4*)(p + 12);
        const f32x4 t = (a0 + a1) + (a2 + a3); const float sm = (t[0] + t[1]) + (t[2] + t[3]);
        ((LAS float*)(lds + TAB_RS))[tid] = __builtin_amdgcn_rsqf(sm * (1.0f / 1024.0f) + pg8::NORM_EPS); }
}
__device__ __forceinline__ void stage_bias_lb(LAS unsigned char* lds, const float* bias, const float* lb, int tid) {
    for (int i = tid; i < DIN / 4; i += NTHREADS) ((LAS f32x4*)(lds + TAB_BI))[i] = ((const f32x4*)bias)[i];
    if (tid < 256) ((LAS f32x4*)(lds + TAB_LB))[tid] = ((const f32x4*)lb)[tid];
}
#define PH_BEGIN KArgs ap = fresh_args(); const int tid = fresh_tid(wave_s), lane = tid & 63, wave = __builtin_amdgcn_readfirstlane(tid >> 6); \
    const int gw = (int)blockIdx.x * NWAVES + wave, ngw = G * NWAVES; unsigned char* ws = ap->ws; unsigned char* R = ws + WS_R; \
    (void)lane; (void)gw; (void)ngw; (void)R;
__global__ void __launch_bounds__(NTHREADS, 2) fwd_kernel(Args args_unused) {
    extern __shared__ __attribute__((aligned(16))) unsigned char lds[];
    const int G = gridDim.x;
    const int wave_s = __builtin_amdgcn_readfirstlane(threadIdx.x >> 6);
    { PH_BEGIN
      for (int u = tid; u < (LDS_BYTES - LDSCTL_OFF) / 4; u += NTHREADS) ((unsigned*)(lds + LDSCTL_OFF))[u] = 0u;
      __syncthreads();
      (void)xcd_barrier_post((unsigned*)(ws + WS_CTL) + CW_BAR, (volatile LAS unsigned*)(lds + MISC_OFF) + 8, tid);
      prologue(ap, lds, gw, ngw, wave, lane, tid);
      }
#define BAR_OBJ() XcdBarrier b_; b_.bar = (unsigned*)(fresh_args()->ws + WS_CTL) + CW_BAR; b_.x = xb_xcc_id(); b_.st = (volatile LAS unsigned*)(lds + MISC_OFF) + 8
#define GRID_BAR() do { BAR_OBJ(); xcd_barrier<false>(b_, fresh_tid(wave_s)); } while (0)
#define BATCH_BAR() do { BAR_OBJ(); if (uni) xcd_barrier<true>(b_, fresh_tid(wave_s)); else xcd_barrier<false>(b_, fresh_tid(wave_s)); } while (0)
#define RING ((PG8_LAS unsigned char*)lds)
constexpr int CW_GRP = 16384;
#define GROUP_SYNC(k) do { if (uni) { const int rk_ = vb >> 3; sc::head_sync<4>((unsigned*)(fresh_args()->ws + WS_CTL) + CW_GRP + 64 * ((((vb & 7) * 8 + (rk_ & 7)) * 2) + (k)), 0u, rk_ >> 3, (unsigned)(l + 1), 1, fresh_tid(wave_s), 1); } \
                           else BATCH_BAR(); } while (0)
    typedef pg8::bf16_t bt;
    GRID_BAR();
    int vb, uni;
    { volatile LAS unsigned* st_ = (volatile LAS unsigned*)(lds + MISC_OFF) + 8;
      uni = __builtin_amdgcn_readfirstlane((int)st_[2]);
      vb = uni ? __builtin_amdgcn_readfirstlane((int)(st_[3] * 8u + xb_xcc_id())) : (int)blockIdx.x; }
#pragma unroll 1
    for (int l = 0; l < DEPTH; ++l) {
        const size_t WOFF = (l & 1) ? WS_W2 : WS_W;
        { PH_BEGIN
          pg8::Gemm g = pg8::plain_gemm((const bt*)(ws + WS_XB), (const bt*)(ws + WOFF + WO_IN), DM, DM, DM); pg8::StaticOrder S; S.init(M / 256, DINP / 256, G, vb);
          {
              pg8::Unit u0; (void)S.next(0, u0);
              stage_rstd((LAS unsigned char*)lds, (const float*)(ws + WS_SS), u0.pm, tid); stage_bias_lb((LAS unsigned char*)lds, ap->in[I_BIN] + (size_t)l * DIN, (const float*)(ws + WS_LB) + l * 1024, tid);
              __syncthreads();
              pg8::EpiInProjL E{(const LAS float*)((LAS unsigned char*)lds + TAB_RS), (const LAS float*)((LAS unsigned char*)lds + TAB_BI), (const LAS float*)((LAS unsigned char*)lds + TAB_LB), R};
              pg8::gemm_phase<pg8::EpiInProjL, pg8::StaticOrder, true, true, 0>(RING, g, S, E, tid);
          } }
        if (l + 1 < DEPTH && G == 256 && vb >= 192) { PH_BEGIN convert_layer(ap, l + 1, lds, (vb - 192) * NWAVES + wave, 64 * NWAVES, wave, lane); }
        else if (l + 1 < DEPTH && G != 256) { PH_BEGIN convert_layer(ap, l + 1, lds, gw, ngw, wave, lane); }
        if (l == 0) {
            __syncthreads();
            if (uni) { PH_BEGIN
              pg8::Gemm g = pg8::plain_gemm((const bt*)((unsigned char*)ap->out + OT_MEMB), (const bt*)((unsigned char*)ap->out + OT_WKT), DM, DM, DM);
              pg8::OneUnit S; S.has = true; S.u.pm = vb & 7; S.u.pn = vb >> 3;
              pg8::EpiKV E{(bt*)(ws + WS_KX), (bt*)(ws + WS_VT)};
              pg8::gemm_phase<pg8::EpiKV, pg8::OneUnit, true, true, 0>(RING, g, S, E, tid); }
            else { PH_BEGIN
              pg8::Gemm g = pg8::plain_gemm((const bt*)((unsigned char*)ap->out + OT_MEMB), (const bt*)((unsigned char*)ap->out + OT_WKT), DM, DM, DM); pg8::StaticOrder S; S.init(MMEM / 256, 2 * DEPTH * DM / 256, G, (int)blockIdx.x);
              pg8::EpiKV E{(bt*)(ws + WS_KX), (bt*)(ws + WS_VT)};
              pg8::gemm_phase<pg8::EpiKV, pg8::StaticOrder, true, true, 0>(RING, g, S, E, tid); }
        }
        BATCH_BAR();
        { const int y_ = vb & 127, r_ = y_ >> 3; const int it_ = (r_ >> 3) * 64 + (y_ & 7) * 8 + ((r_ >> 1) & 3) * 2 + (r_ & 1);
          const int bb_ = (it_ >> 3) & 7, hh_ = (it_ >> 1) & 3, qi_ = ((it_ >> 6) & 1) * 2 + (it_ & 1);
          if (vb < 128) { { PH_BEGIN sc::mlstm_conv_part(ap, l, bb_, hh_, qi_, tid, uni); }
                 { PH_BEGIN sc::scan_item<0>(ap, l, it_, lds, tid, uni); }
                 { PH_BEGIN sc::mix_quarter(ap, l, 0, bb_, hh_, qi_, tid, uni); } }
          else { { PH_BEGIN sc::mlstm_conv_part(ap, l, bb_, hh_, 4 + qi_, tid, uni); }
                 { PH_BEGIN sc::scan_item<1>(ap, l, it_, lds, tid, uni); }
                 { PH_BEGIN sc::mix_quarter(ap, l, 1, bb_, hh_, qi_, tid, uni); } } }
        BATCH_BAR();
        { PH_BEGIN
          pg8::Gemm g; g.A = (const bt*)(ws + WS_KX) + (size_t)l * 32 * 65536; g.Bt = (const bt*)(ws + WOFF + WO_XQ); g.lda = 256; g.ldb = DM; g.K = 256; g.ajump = 0;
          g.am = (size_t)65536 * 2; g.am8 = 0; g.an3 = 0; g.bn = (size_t)256 * DM * 2; g.bm3 = 512; g.bm8 = 0;
          pg8::OneUnit S; S.has = (vb >> 3) < 16; S.u.pm = (vb & 7) * 4 + ((vb >> 5) & 3); S.u.pn = (vb >> 3) & 3;
          pg8::EpiRowBf16<2> E{nullptr, (bt*)(R + S_MT), DM, 2, (SLAB - 2 * MiB) / 2};
          pg8::gemm_phase<pg8::EpiRowBf16<2>, pg8::OneUnit, true, true, 0>(RING, g, S, E, tid); }
        { PH_BEGIN
          pg8::Gemm g; g.A = (const bt*)(ws + WOFF + WO_XO); g.Bt = (const bt*)(ws + WS_VT) + (size_t)l * 32 * 65536; g.lda = DM; g.ldb = 256; g.K = 256; g.ajump = 0;
          g.am = (size_t)256 * DM * 2; g.am8 = 0; g.an3 = 512; g.bn = (size_t)65536 * 2; g.bm3 = 0; g.bm8 = 0;
          pg8::OneUnit S; S.has = (vb >> 3) >= 16; S.u.pm = ((vb >> 3) - 16) >> 2; S.u.pn = (vb & 7) * 4 + ((vb >> 3) & 3);
          pg8::EpiNt E{(bt*)(R + S_NT)};
          pg8::gemm_phase<pg8::EpiNt, pg8::OneUnit, true, true, 0>(RING, g, S, E, tid); }
        { PH_BEGIN
          pg8::Gemm g = pg8::plain_gemm((const bt*)(R + S_GG), (const bt*)(ws + WOFF + WO_OUT), 512, DM, DM); g.ajump = (size_t)(S_MO - S_GG) - 1024; g.am8 = SLAB - 2 * MiB; pg8::StaticOrder S; S.init(M / 256, DM / 256, G, vb);
          pg8::EpiResid E{(bt*)(ws + WS_XB), (float*)(ws + WS_SS)};
          pg8::gemm_phase<pg8::EpiResid, pg8::StaticOrder, true, true, 2>(RING, g, S, E, tid); }
        BATCH_BAR();
        { PH_BEGIN
          pg8::Gemm g = pg8::plain_gemm((const bt*)(ws + WS_XB), (const bt*)(R + S_MT), DM, DM, DM); g.bm8 = SLAB; pg8::StaticOrder S; S.init(M / 256, 4, G, vb);
          { pg8::Unit u0; (void)S.next(0, u0);
              stage_rstd((LAS unsigned char*)lds, (const float*)(ws + WS_SS), u0.pm, tid); __syncthreads();
              pg8::EpiSoftmaxL E{(const LAS float*)((LAS unsigned char*)lds + TAB_RS), (bt*)(R + S_P)};
              pg8::gemm_phase<pg8::EpiSoftmaxL, pg8::StaticOrder, false, true, 0>(RING, g, S, E, tid);
          } }
        GROUP_SYNC(0);
        { PH_BEGIN
          pg8::Gemm g = pg8::plain_gemm((const bt*)(R + S_P), (const bt*)(R + S_NT), DM, DM, DM); g.am8 = SLAB - 4 * MiB; g.bm8 = SLAB; pg8::StaticOrder S; S.init(M / 256, DM / 256, G, vb);
          pg8::EpiResid E{(bt*)(ws + WS_XB), (float*)(ws + WS_SS)};
          pg8::gemm_phase<pg8::EpiResid, pg8::StaticOrder, true, true, 0>(RING, g, S, E, tid); }
        BATCH_BAR();
        { PH_BEGIN
          pg8::Gemm g = pg8::plain_gemm((const bt*)(ws + WS_XB), (const bt*)(ws + WOFF + WO_UP), DM, DM, DM); pg8::StaticOrder S; S.init(M / 256, DFF / 256, G, vb);
          { pg8::Unit u0; (void)S.next(0, u0);
              stage_rstd((LAS unsigned char*)lds, (const float*)(ws + WS_SS), u0.pm, tid); __syncthreads();
              pg8::EpiRowBf16<1, true> E{(const LAS float*)((LAS unsigned char*)lds + TAB_RS), (bt*)(R + S_H), DFF, 3, (SLAB - 16 * MiB) / 2};
              pg8::gemm_phase<pg8::EpiRowBf16<1, true>, pg8::StaticOrder, true, true, 0>(RING, g, S, E, tid);
          } }
        GROUP_SYNC(1);
        { PH_BEGIN
          pg8::Gemm g = pg8::plain_gemm((const bt*)(R + S_H), (const bt*)(ws + WOFF + WO_DOWN), DFF, DFF, DFF); g.am8 = SLAB - 16 * MiB; pg8::StaticOrder S; S.init(M / 256, DM / 256, G, vb);
          pg8::EpiResid E{(bt*)(ws + WS_XB), (float*)(ws + WS_SS)};
          pg8::gemm_phase<pg8::EpiResid, pg8::StaticOrder, true, true, 0>(RING, g, S, E, tid); }
        GRID_BAR();
    }
    { PH_BEGIN final_phase(ap, gw, ngw, lane); }
}

extern "C" void kernel_launch(void* const* d_in, const int* in_sizes, int n_in, void* d_out, int out_size, void* d_ws, size_t ws_size, hipStream_t stream) {
    static int grid = 0;
    if (grid == 0) {
        if (n_in != 20 || out_size != M * DM || ws_size < WS_END) { fprintf(stderr, "kernel_launch: unexpected shapes (n_in %d, out %d, ws %zu < %zu); nothing launched\n", n_in, out_size, ws_size, (size_t)WS_END); grid = -1; return; }
        int dev = 0, cus = 0;
        if (hipGetDevice(&dev) != hipSuccess || hipDeviceGetAttribute(&cus, hipDeviceAttributeMultiprocessorCount, dev) != hipSuccess) { grid = -1; return; }
        if (hipFuncSetAttribute((const void*)fwd_kernel, hipFuncAttributeMaxDynamicSharedMemorySize, LDS_BYTES) != hipSuccess) { fprintf(stderr, "kernel_launch: hipFuncSetAttribute failed\n"); grid = -1; return; }
        int occ = 0;
        if (hipOccupancyMaxActiveBlocksPerMultiprocessor(&occ, (const void*)fwd_kernel, NTHREADS, LDS_BYTES) != hipSuccess || occ < 1) { fprintf(stderr, "kernel_launch: occupancy query failed or zero\n"); grid = -1; return; }
        (void)hipGetLastError();
        grid = cus;
        if (grid != 256) { fprintf(stderr, "kernel_launch: %d CUs; this kernel is built for exactly 256 (one workgroup per CU); nothing launched\n", grid); grid = -1; return; }
    }
    if (grid < 0) return;
    if (hipMemsetAsync((char*)d_ws + WS_CTL, 0, CTL_ZERO_BYTES, stream) != hipSuccess) return;
    Args a{};
    for (int i = 0; i < 20; ++i) a.in[i] = (const float*)d_in[i];
    a.out = (float*)d_out; a.ws = (unsigned char*)d_ws;
    hipLaunchKernelGGL(fwd_kernel, dim3(grid), dim3(NTHREADS), LDS_BYTES, stream, a);
}
```

```cpp
#include <hip/hip_runtime.h>
#include <cstdio>
#include <cstdint>
namespace pg8 {
#define PG8_LAS __attribute__((address_space(3)))
typedef unsigned short bf16_t;
typedef short bf16x8 __attribute__((ext_vector_type(8)));
typedef float f32x4 __attribute__((ext_vector_type(4)));
typedef float f32x2 __attribute__((ext_vector_type(2)));
typedef unsigned u32x4 __attribute__((ext_vector_type(4)));
constexpr int WCS = 64, BJS = 32;
constexpr int BM = 256, BK = 64, HALF = 128, HTB = HALF * BK * 2  , STAGE_BYTES = 8 * HTB, NXCD = 8, WGM = 8;

__host__ __device__ __forceinline__ int lds_byte(int r, int c) { const int st = (r >> 4) * 2 + (c >> 5), rr = r & 15, cc = c & 31, ob = rr * 64 + cc * 2; return st * 1024 + (ob ^ (((ob >> 9) & 1) << 5)); }
__host__ __device__ __forceinline__ void stage_rc(int b, int& R, int& C) { const int st = b / 1024, sb = b % 1024, swz = sb ^ (((sb >> 9) & 1) << 5); R = (st >> 1) * 16 + swz / 64; C = (st & 1) * 32 + (swz % 64) / 2; }
__host__ __device__ __forceinline__ int perm32(int rho) { const int n = rho >> 4, i = rho & 15; return 8 * (i >> 2) + 4 * n + (i & 3); }

struct Unit { int pm, pn; };
struct Gemm { const bf16_t* A; const bf16_t* Bt; int lda, ldb, K; size_t ajump, am, am8, an3, bn, bm3, bm8; };
__device__ __forceinline__ Gemm plain_gemm(const bf16_t* A, const bf16_t* Bt, int lda, int ldb, int K) { Gemm g; g.A = A; g.Bt = Bt; g.lda = lda; g.ldb = ldb; g.K = K; g.ajump = 0; g.am = (size_t)512 * lda; g.am8 = 0; g.an3 = 0; g.bn = (size_t)512 * ldb; g.bm3 = 0; g.bm8 = 0; return g; }
template <int MODE> __device__ __forceinline__ const char* a_base(const Gemm& g, const Unit& u) { return (const char*)g.A + (size_t)u.pm * g.am + (size_t)(u.pm >> 3) * g.am8 + (size_t)(u.pn & 3) * g.an3; }
template <int MODE> __device__ __forceinline__ const char* b_base(const Gemm& g, const Unit& u) { return (const char*)g.Bt + (size_t)u.pn * g.bn + (size_t)(u.pm & 3) * g.bm3 + (size_t)(u.pm >> 3) * g.bm8; }

struct StaticOrder {
    int nM, nN, nwg, G, c;
    __host__ __device__ void init(int nM_, int nN_, int G_, int c_) { nM = nM_; nN = nN_; nwg = nM * nN; G = G_; c = c_; }
    __host__ __device__ bool next(int i, Unit& u) const {
        const long L = (long)i * G + c; if (L >= nwg) return false;
        int wgid = (int)L; { const int q = nwg / NXCD, r = nwg % NXCD, xcd = wgid % NXCD, off = wgid / NXCD; wgid = (xcd < r ? xcd * (q + 1) : r * (q + 1) + (xcd - r) * q) + off; }
        const int nig = WGM * nN, gid = wgid / nig, fm = gid * WGM, gsz = (nM - fm) < WGM ? (nM - fm) : WGM;
        u.pm = fm + ((wgid % nig) % gsz); u.pn = (wgid % nig) / gsz; return true;
    }
    __device__ __forceinline__ void a_ready(const Unit&) const {}
    __device__ __forceinline__ void done(const Unit&) const {}
};

struct OneUnit { Unit u; bool has;
    __device__ bool next(int i, Unit& o) const { if (i != 0 || !has) return false; o = u; return true; }
    __device__ __forceinline__ void a_ready(const Unit&) const {}
    __device__ __forceinline__ void done(const Unit&) const {}
};

typedef float f32x2_cv __attribute__((ext_vector_type(2)));
typedef __bf16 bf16x2_cv __attribute__((ext_vector_type(2)));
__device__ __forceinline__ unsigned cvt_pk_bf16(float lo, float hi) { const f32x2_cv v = {lo, hi}; const bf16x2_cv b = __builtin_convertvector(v, bf16x2_cv); return __builtin_bit_cast(unsigned, b); }
__device__ __forceinline__ u32x4 pack8(const f32x4 a, const f32x4 b) { u32x4 w; w.x = cvt_pk_bf16(a[0], a[1]); w.y = cvt_pk_bf16(a[2], a[3]); w.z = cvt_pk_bf16(b[0], b[1]); w.w = cvt_pk_bf16(b[2], b[3]); return w; }
constexpr float NORM_EPS = 1e-6f;
__device__ __forceinline__ float sx(float v, int k, int lane) { return __builtin_bit_cast(float, __builtin_amdgcn_ds_bpermute((lane ^ k) << 2, __builtin_bit_cast(int, v))); }
__device__ __forceinline__ float sx_up(float v, int o, int lane) { return __builtin_bit_cast(float, __builtin_amdgcn_ds_bpermute(((lane - o) & 63) << 2, __builtin_bit_cast(int, v))); }
__device__ __forceinline__ float sx_idx(float v, int src) { return __builtin_bit_cast(float, __builtin_amdgcn_ds_bpermute(src << 2, __builtin_bit_cast(int, v))); }
__device__ __forceinline__ float row_rstd(const float* SS, int row, int fq) {
    const f32x4 v = *(const f32x4*)(SS + (size_t)row * 16 + fq * 4);
    const int lane = fq * 16 + (row & 15);
    float s = (v[0] + v[1]) + (v[2] + v[3]); s += sx(s, 16, lane); s += sx(s, 32, lane);
    return __builtin_amdgcn_rsqf(s * (1.0f / 1024.0f) + NORM_EPS);
}
__device__ __forceinline__ void row_rstd8(const float* SS, int row0, int fr, int fq, float (&rs)[8]) {
    f32x4 v[8];
#pragma unroll
    for (int i = 0; i < 8; ++i) v[i] = *(const f32x4*)(SS + (size_t)(row0 + (i >> 2) * HALF + (i & 3) * 16) * 16 + fq * 4);
    const int lane = fq * 16 + fr; float s[8];
#pragma unroll
    for (int i = 0; i < 8; ++i) s[i] = (v[i][0] + v[i][1]) + (v[i][2] + v[i][3]);
#pragma unroll
    for (int i = 0; i < 8; ++i) s[i] += sx(s[i], 16, lane);
#pragma unroll
    for (int i = 0; i < 8; ++i) s[i] += sx(s[i], 32, lane);
#pragma unroll
    for (int i = 0; i < 8; ++i) rs[i] = __builtin_amdgcn_rsqf(s[i] * (1.0f / 1024.0f) + NORM_EPS);
    asm volatile("" : "+v"(rs[0]), "+v"(rs[1]), "+v"(rs[2]), "+v"(rs[3]), "+v"(rs[4]), "+v"(rs[5]), "+v"(rs[6]), "+v"(rs[7]));
    __builtin_amdgcn_sched_barrier(0);
}
__device__ __forceinline__ float logsig(float z) { return fminf(z, 0.f) - __logf(1.0f + __expf(-fabsf(z))); }
__device__ __forceinline__ float sigm(float z) { return __builtin_amdgcn_rcpf(1.0f + __expf(-z)); }

__device__ __forceinline__ f32x4 sel_acc(const f32x4 (&acc)[2][2][4][2], int ai, int bj, int m, int n) {
    f32x4 r = acc[0][bj][0][n];
#pragma unroll
    for (int a = 0; a < 2; ++a)
#pragma unroll
        for (int mm = 0; mm < 4; ++mm) if (a == ai && mm == m) r = acc[a][bj][mm][n];
    return r;
}
constexpr int MTOK = 16384;
constexpr size_t SL_MIB = 1u << 20, SLAB = 53 * (SL_MIB / 2);
constexpr size_t SL_GT = 14 * SL_MIB, SL_LF = SL_GT + SL_MIB / 4, SL_OF = SL_LF + 4 * SL_MIB, SL_OB = SL_OF + 4 * SL_MIB;
template <bool LT> struct TabPtr { typedef const float* type; };
template <> struct TabPtr<true> { typedef const PG8_LAS float* type; };
__device__ __forceinline__ f32x4 ld4(const float* p) { return *(const f32x4*)p; }
__device__ __forceinline__ f32x4 ld4(const PG8_LAS float* p) { return *(const PG8_LAS f32x4*)p; }
__device__ __forceinline__ void rstd8x(const float* SS, int pm, int row0, int fr, int fq, float (&rs)[8]) { (void)pm; row_rstd8(SS, row0, fr, fq, rs); }
__device__ __forceinline__ void rstd8x(const PG8_LAS float* RS, int pm, int row0, int fr, int fq, float (&rs)[8]) { (void)fr; (void)fq; const int lr0 = row0 - pm * BM;
#pragma unroll
    for (int i = 0; i < 8; ++i) rs[i] = RS[lr0 + (i >> 2) * HALF + (i & 3) * 16]; }
template <bool LT> struct EpiInProjT {
    static constexpr bool PERM = true, AFTER_DRAIN = false;
    static __device__ __forceinline__ bool stores16(const Unit& u) { return (u.pn >> 1) != 9; }
    typename TabPtr<LT>::type SS, bias, lb;
    unsigned char* RB;
    __device__ __forceinline__ void operator()(const f32x4 (&acc)[2][2][4][2], const Unit& u, int wr, int wc, int fr, int fq) const {
        const int seg = u.pn >> 1;
        const int row0 = u.pm * BM + wr * 64 + fr, lrow0 = (u.pm & 7) * BM + wr * 64 + fr;
        unsigned char* const SLB = RB + (size_t)(u.pm >> 3) * SLAB;
        const int cs0 = (u.pn & 1) * 256 + wc * WCS + 8 * fq;
        const int gc0 = u.pn * BM + wc * WCS + 8 * fq;
        if (seg == 9) {
            if (wc != 0) return;
            float rs8[8]; rstd8x(SS, u.pm, row0, fr, fq, rs8);
            f32x4 b0 = (f32x4){0.f, 0.f, 0.f, 0.f}, b1 = b0;
            if (fq < 2) { b0 = ld4(bias + gc0); b1 = ld4(bias + gc0 + 4); }
#pragma unroll
            for (int am = 0; am < 8; ++am) { const int ai = am >> 2, m = am & 3; const int lrow = lrow0 + ai * HALF + m * 16; const float rs = rs8[am]; float* const GATES = (float*)(SLB + SL_GT);
                f32x4 v0 = acc[ai][0][m][0] * rs + b0, v1 = acc[ai][0][m][1] * rs + b1;
                if (fq == 1) {
#pragma unroll
                    for (int j = 0; j < 4; ++j) { v0[j] = logsig(v0[j]); v1[j] = logsig(v1[j]); } }
                if (fq < 2) { *(f32x4*)(GATES + (size_t)lrow * 16 + 8 * fq) = v0; *(f32x4*)(GATES + (size_t)lrow * 16 + 8 * fq + 4) = v1; } }
            return;
        }
        f32x4 bv[2][2];
#pragma unroll
        for (int bj = 0; bj < 2; ++bj)
#pragma unroll
            for (int n = 0; n < 2; ++n) bv[bj][n] = ld4(bias + gc0 + bj * BJS + 4 * n);
        float rs8[8];
        if (seg == 1 || seg == 2) {
            f32x4 lv[2][2];
#pragma unroll
            for (int bj = 0; bj < 2; ++bj)
#pragma unroll
                for (int n = 0; n < 2; ++n) lv[bj][n] = ld4(lb + (seg - 1) * 512 + cs0 + bj * BJS + 4 * n);
            unsigned short* LFd = (unsigned short*)(SLB + SL_LF) + (size_t)(seg - 1) * 2048 * 512 + cs0;
            rstd8x(SS, u.pm, row0, fr, fq, rs8);
#pragma unroll
            for (int ai = 0; ai < 2; ++ai)
#pragma unroll
                for (int m = 0; m < 4; ++m) { const int row = row0 + ai * HALF + m * 16; const float rs = rs8[ai * 4 + m];
#pragma unroll
                    for (int bj = 0; bj < 2; ++bj) { f32x4 v0 = acc[ai][bj][m][0] * rs + bv[bj][0], v1 = acc[ai][bj][m][1] * rs + bv[bj][1];
#pragma unroll
                        for (int j = 0; j < 4; ++j) { const float a0 = lv[bj][0][j], a1 = lv[bj][1][j];
                            v0[j] = a0 + (1.f - a0) * sigm(fmaxf(v0[j], -80.f)); v1[j] = a1 + (1.f - a1) * sigm(fmaxf(v1[j], -80.f)); }
                        typedef _Float16 h2_t __attribute__((ext_vector_type(2))); u32x4 w;
                        w.x = __builtin_bit_cast(unsigned, (h2_t){(_Float16)v0[0], (_Float16)v0[1]}); w.y = __builtin_bit_cast(unsigned, (h2_t){(_Float16)v0[2], (_Float16)v0[3]});
                        w.z = __builtin_bit_cast(unsigned, (h2_t){(_Float16)v1[0], (_Float16)v1[1]}); w.w = __builtin_bit_cast(unsigned, (h2_t){(_Float16)v1[2], (_Float16)v1[3]});
                        *(u32x4*)(LFd + (size_t)(row - row0 + lrow0) * 512 + bj * BJS) = w; } }
            return;
        }
        const float ca = seg == 0 ? 0.f : 1.f, cb = 0.f, cc = seg == 0 ? 1.f : 0.f;
        bf16_t* dst = (bf16_t*)(SLB + ((size_t)(seg == 0 ? 0 : seg - 2) << 21)) + cs0;
        rstd8x(SS, u.pm, row0, fr, fq, rs8);
#pragma unroll
        for (int ai = 0; ai < 2; ++ai)
#pragma unroll
            for (int m = 0; m < 4; ++m) { const int row = row0 + ai * HALF + m * 16; const float rs = rs8[ai * 4 + m];
#pragma unroll
                for (int bj = 0; bj < 2; ++bj) { f32x4 v0 = acc[ai][bj][m][0] * rs + bv[bj][0], v1 = acc[ai][bj][m][1] * rs + bv[bj][1];
                    if (ca == 0.f) {
#pragma unroll
                        for (int j = 0; j < 4; ++j) { const float s0 = sigm(v0[j]), s1 = sigm(v1[j]); v0[j] = v0[j] * (cc * s0) + cb * s0; v1[j] = v1[j] * (cc * s1) + cb * s1; } }
                    *(u32x4*)(dst + (size_t)(row - row0 + lrow0) * 512 + bj * BJS) = pack8(v0, v1); } }
    }
};
typedef EpiInProjT<false> EpiInProj; typedef EpiInProjT<true> EpiInProjL;
struct EpiResid {
    static constexpr bool PERM = true, AFTER_DRAIN = false;
    static __device__ __forceinline__ bool stores16(const Unit&) { return false; }
    bf16_t* xb; float* SS;
    __device__ __forceinline__ void operator()(const f32x4 (&acc)[2][2][4][2], const Unit& u, int wr, int wc, int fr, int fq) const {
        const int row0 = u.pm * BM + wr * 64 + fr, col0 = u.pn * BM + wc * WCS + 8 * fq;
        u32x4 xo[2][4][2];
#pragma unroll
        for (int ai = 0; ai < 2; ++ai)
#pragma unroll
            for (int m = 0; m < 4; ++m)
#pragma unroll
                for (int bj = 0; bj < 2; ++bj) xo[ai][m][bj] = *(const u32x4*)(xb + (size_t)(row0 + ai * HALF + m * 16) * 1024 + col0 + bj * BJS);
        __builtin_amdgcn_sched_barrier(0);
        float sq8[8];
#pragma unroll
        for (int ai = 0; ai < 2; ++ai)
#pragma unroll
            for (int m = 0; m < 4; ++m) { const int row = row0 + ai * HALF + m * 16; float sq = 0.f;
#pragma unroll
                for (int bj = 0; bj < 2; ++bj) { const size_t o = (size_t)row * 1024 + col0 + bj * BJS;
                    const u32x4 xw = xo[ai][m][bj];
                    f32x4 a = (f32x4){__builtin_bit_cast(float, xw.x << 16), __builtin_bit_cast(float, xw.x & 0xffff0000u), __builtin_bit_cast(float, xw.y << 16), __builtin_bit_cast(float, xw.y & 0xffff0000u)};
                    f32x4 b = (f32x4){__builtin_bit_cast(float, xw.z << 16), __builtin_bit_cast(float, xw.z & 0xffff0000u), __builtin_bit_cast(float, xw.w << 16), __builtin_bit_cast(float, xw.w & 0xffff0000u)};
                    a = a + acc[ai][bj][m][0]; b = b + acc[ai][bj][m][1];
                    *(u32x4*)(xb + o) = pack8(a, b);
                    sq += (a[0] * a[0] + a[1] * a[1]) + (a[2] * a[2] + a[3] * a[3]) + (b[0] * b[0] + b[1] * b[1]) + (b[2] * b[2] + b[3] * b[3]); }
                sq8[ai * 4 + m] = sq; }
        const int lane = fq * 16 + fr;
#pragma unroll
        for (int i = 0; i < 8; ++i) sq8[i] += sx(sq8[i], 16, lane);
#pragma unroll
        for (int i = 0; i < 8; ++i) sq8[i] += sx(sq8[i], 32, lane);
#pragma unroll
        for (int i = 0; i < 8; ++i) if (fq == 0) SS[(size_t)(row0 + (i >> 2) * HALF + (i & 3) * 16) * 16 + u.pn * 4 + wc] = sq8[i];
    }
};
template <int ACT, bool LT = false> struct EpiRowBf16 {
    static constexpr bool PERM = true, AFTER_DRAIN = false;
    static __device__ __forceinline__ bool stores16(const Unit&) { return true; }
    typename TabPtr<LT>::type SS; bf16_t* O; int ldc; int bshift; size_t corr;
    __device__ __forceinline__ void operator()(const f32x4 (&acc)[2][2][4][2], const Unit& u, int wr, int wc, int fr, int fq) const {
        const int row0 = u.pm * BM + wr * 64 + fr, col0 = u.pn * BM + wc * WCS + 8 * fq;
        float rs8[8]; if (ACT != 2) rstd8x(SS, u.pm, row0, fr, fq, rs8);
#pragma unroll
        for (int ai = 0; ai < 2; ++ai)
#pragma unroll
            for (int m = 0; m < 4; ++m) { const int row = row0 + ai * HALF + m * 16; const float rs = ACT == 2 ? 1.f : rs8[ai * 4 + m];
#pragma unroll
                for (int bj = 0; bj < 2; ++bj) { f32x4 v0 = acc[ai][bj][m][0] * rs, v1 = acc[ai][bj][m][1] * rs;
                    if (ACT == 1) {
#pragma unroll
                        for (int j = 0; j < 4; ++j) { const float t0 = fmaxf(v0[j], 0.f), t1 = fmaxf(v1[j], 0.f); v0[j] = t0 * t0; v1[j] = t1 * t1; } }
                    *(u32x4*)(O + (size_t)row * ldc + (size_t)(u.pm >> bshift) * corr + col0 + bj * BJS) = pack8(v0, v1); } }
    }
};
struct EpiKV {
    static constexpr bool PERM = true, AFTER_DRAIN = false;
    static __device__ __forceinline__ bool stores16(const Unit&) { return false; }
    bf16_t* OK; bf16_t* OV;
    __device__ __forceinline__ void operator()(const f32x4 (&acc)[2][2][4][2], const Unit& u, int wr, int wc, int fr, int fq) const {
        const int pn = u.pn & 15; const int tile = ((pn >> 2) * 8 + u.pm) * 4 + (pn & 3);
        bf16_t* base = (u.pn >= 16 ? OV : OK) + (size_t)tile * 65536; const int r0 = wr * 64 + fr, c0 = wc * WCS + 8 * fq;
#pragma unroll
        for (int ai = 0; ai < 2; ++ai)
#pragma unroll
            for (int m = 0; m < 4; ++m)
#pragma unroll
                for (int bj = 0; bj < 2; ++bj) *(u32x4*)(base + (size_t)(r0 + ai * HALF + m * 16) * 256 + c0 + bj * BJS) = pack8(acc[ai][bj][m][0], acc[ai][bj][m][1]);
    }
};
struct EpiNt {
    static constexpr bool PERM = true, AFTER_DRAIN = false;
    static __device__ __forceinline__ bool stores16(const Unit&) { return false; }
    bf16_t* O;
    __device__ __forceinline__ void operator()(const f32x4 (&acc)[2][2][4][2], const Unit& u, int wr, int wc, int fr, int fq) const {
        bf16_t* base = O + (size_t)(u.pn >> 2) * (SLAB / 2) + (size_t)u.pm * 256 * 1024 + (u.pn & 3) * 256; const int r0 = wr * 64 + fr, c0 = wc * WCS + 8 * fq;
#pragma unroll
        for (int ai = 0; ai < 2; ++ai)
#pragma unroll
            for (int m = 0; m < 4; ++m)
#pragma unroll
                for (int bj = 0; bj < 2; ++bj) *(u32x4*)(base + (size_t)(r0 + ai * HALF + m * 16) * 1024 + c0 + bj * BJS) = pack8(acc[ai][bj][m][0], acc[ai][bj][m][1]);
    }
};
template <bool LT> struct EpiSoftmaxT {
    static constexpr bool PERM = true, AFTER_DRAIN = true;
    static __device__ __forceinline__ bool stores16(const Unit&) { return false; }
    typename TabPtr<LT>::type SS; bf16_t* P;
    __device__ __forceinline__ void fused(f32x4 (&acc)[2][2][4][2], const Unit& u, int wr, int wc, int fr, int fq, PG8_LAS unsigned char* lds, int wid, int lane) const {
        PG8_LAS f32x2* T = (PG8_LAS f32x2*)lds;
        float rs8[8]; rstd8x(SS, u.pm, u.pm * BM + wr * 64 + fr, fr, fq, rs8);
#pragma unroll
        for (int ai = 0; ai < 2; ++ai)
#pragma unroll
            for (int m = 0; m < 4; ++m) { const float rs = rs8[ai * 4 + m];
#pragma unroll
                for (int bj = 0; bj < 2; ++bj)
#pragma unroll
                    for (int n = 0; n < 2; ++n) acc[ai][bj][m][n] = acc[ai][bj][m][n] * rs;
                float mx = -3.0e38f;
#pragma unroll
                for (int bj = 0; bj < 2; ++bj)
#pragma unroll
                    for (int n = 0; n < 2; ++n) { const f32x4 x = acc[ai][bj][m][n]; mx = fmaxf(mx, fmaxf(fmaxf(x[0], x[1]), fmaxf(x[2], x[3]))); }
                mx = fmaxf(mx, sx(mx, 16, lane)); mx = fmaxf(mx, sx(mx, 32, lane));
                float s = 0.f;
#pragma unroll
                for (int bj = 0; bj < 2; ++bj)
#pragma unroll
                    for (int n = 0; n < 2; ++n) { const f32x4 x = acc[ai][bj][m][n]; s += (__expf(x[0] - mx) + __expf(x[1] - mx)) + (__expf(x[2] - mx) + __expf(x[3] - mx)); }
                s += sx(s, 16, lane); s += sx(s, 32, lane);
                if (fq == 0) T[(ai * HALF + wr * 64 + m * 16 + fr) * 4 + wc] = (f32x2){mx, s}; }
        asm volatile("s_waitcnt lgkmcnt(0)" ::: "memory"); __builtin_amdgcn_s_barrier(); asm volatile("" ::: "memory");
        const int row0 = u.pm * BM + wr * 64 + fr, col0 = u.pn * BM + wc * WCS + 8 * fq;
#pragma unroll
        for (int ai = 0; ai < 2; ++ai)
#pragma unroll
            for (int m = 0; m < 4; ++m) { const int r = ai * HALF + wr * 64 + m * 16 + fr;
                const f32x2 t0 = T[r * 4 + 0], t1 = T[r * 4 + 1], t2 = T[r * 4 + 2], t3 = T[r * 4 + 3];
                const float M = fmaxf(fmaxf(t0.x, t1.x), fmaxf(t2.x, t3.x));
                const float L = (t0.y * __expf(t0.x - M) + t1.y * __expf(t1.x - M)) + (t2.y * __expf(t2.x - M) + t3.y * __expf(t3.x - M));
                const float inv = __builtin_amdgcn_rcpf(L);
#pragma unroll
                for (int bj = 0; bj < 2; ++bj) { f32x4 v0 = acc[ai][bj][m][0], v1 = acc[ai][bj][m][1];
#pragma unroll
                    for (int j = 0; j < 4; ++j) { v0[j] = __expf(v0[j] - M) * inv; v1[j] = __expf(v1[j] - M) * inv; }
                    *(u32x4*)(P + (size_t)(u.pm >> 3) * ((SLAB - 4 * SL_MIB) / 2) + (size_t)(row0 + ai * HALF + m * 16) * 1024 + col0 + bj * BJS) = pack8(v0, v1); } }
    }
};
typedef EpiSoftmaxT<false> EpiSoftmax; typedef EpiSoftmaxT<true> EpiSoftmaxL;

template <class Epi, class Sched, bool ALIGN_EPI, bool SP2, int MODE>
__device__ __forceinline__ void gemm_phase(PG8_LAS unsigned char* lds, const Gemm g, const Sched& S, const Epi& E, const int tid) {
    const int wid = __builtin_amdgcn_readfirstlane(tid >> 6), lane = tid & 63, wr = wid >> 2, wc = wid & 3, fr = lane & 15, fq = lane >> 4;
    const int K = g.K, nt = K / BK;
    unsigned voffA[2], voffB[2];
#pragma unroll
    for (int i = 0; i < 2; ++i) { int R, C; stage_rc(tid * 16 + i * 8192, R, C); const int Rb = Epi::PERM ? ((R >> 5) * WCS + perm32(R & 31)) : R;
        voffA[i] = (unsigned)(R * g.lda + C) * 2u; voffB[i] = (unsigned)(Rb * g.ldb + C) * 2u; }
    const size_t kstep = (size_t)(BK * 2);
    const size_t hstepA = (size_t)HALF * g.lda * 2, hstepB = (size_t)(Epi::PERM ? BJS : HALF) * g.ldb * 2;
    const unsigned ldsw = (unsigned)wid * 1024u;
    const int aoff = lds_byte(wr * 64 + fr, fq * 8), boff = lds_byte(wc * 32 + fr, fq * 8);
#define PG8_SA(b, h) (((b) * 2 + (h)) * HTB)
#define PG8_SB(b, h) ((4 + (b) * 2 + (h)) * HTB)
#define PG8_STAGE(bufoff, gbase, voff) do { _Pragma("unroll") for (int _i = 0; _i < 2; ++_i) \
        __builtin_amdgcn_global_load_lds((const unsigned*)((const char*)(gbase) + (voff)[_i]), (PG8_LAS unsigned*)(lds + (bufoff) + ldsw + _i * 8192), 16, 0, 0); } while (0)
#define PG8_LDA(dst, b, h) do { _Pragma("unroll") for (int m = 0; m < 4; ++m) _Pragma("unroll") for (int k = 0; k < 2; ++k) dst[m][k] = *(const PG8_LAS bf16x8*)(lds + PG8_SA(b, h) + aoff + m * 2048 + k * 1024); } while (0)
#define PG8_LDB(dst, b, h) do { _Pragma("unroll") for (int n = 0; n < 2; ++n) _Pragma("unroll") for (int k = 0; k < 2; ++k) dst[n][k] = *(const PG8_LAS bf16x8*)(lds + PG8_SB(b, h) + boff + n * 2048 + k * 1024); } while (0)
#define PG8_MMA(ai, bj, At, Bt) do { __builtin_amdgcn_s_setprio(1); _Pragma("unroll") for (int m = 0; m < 4; ++m) _Pragma("unroll") for (int n = 0; n < 2; ++n) _Pragma("unroll") for (int k = 0; k < 2; ++k) \
        acc[ai][bj][m][n] = __builtin_amdgcn_mfma_f32_16x16x32_bf16(Bt[n][k], At[m][k], acc[ai][bj][m][n], 0, 0, 0); __builtin_amdgcn_s_setprio(0); } while (0)
#define PG8_WAIT_V(n) asm volatile("s_waitcnt vmcnt(" #n ")" ::: "memory")
#define PG8_WAIT_L(n) asm volatile("s_waitcnt lgkmcnt(" #n ")" ::: "memory")
#define PG8_WAIT_V8R(rx) asm volatile("s_cmp_eq_u32 %0, 0\n\ts_cbranch_scc1 .Lrxa%=\n\ts_waitcnt vmcnt(24)\n\ts_branch .Lrxb%=\n.Lrxa%=:\n\ts_waitcnt vmcnt(8)\n.Lrxb%=:" :: "s"(rx) : "memory", "scc")
#define PG8_BAR __builtin_amdgcn_s_barrier()
#define PG8_SCHED __builtin_amdgcn_sched_barrier(0)
    Unit cur, nxt; int ui = 0; bool relax = false;
    if (!S.next(0, cur)) return;
    f32x4 acc[2][2][4][2];
#pragma unroll
    for (int a = 0; a < 2; ++a)
#pragma unroll
        for (int b = 0; b < 2; ++b)
#pragma unroll
            for (int m = 0; m < 4; ++m)
#pragma unroll
                for (int n = 0; n < 2; ++n) acc[a][b][m][n] = (f32x4){0.f, 0.f, 0.f, 0.f};
    bf16x8 At[4][2], B0[2][2], B1[2][2];
    const char* cA = a_base<MODE>(g, cur); const char* cB = b_base<MODE>(g, cur);
    S.a_ready(cur);
    if constexpr (SP2) {
        PG8_STAGE(PG8_SB(0, 0), cB, voffB); PG8_STAGE(PG8_SB(0, 1), cB + hstepB, voffB); PG8_STAGE(PG8_SA(0, 0), cA, voffA); PG8_STAGE(PG8_SA(0, 1), cA + hstepA, voffA);
        if (wr == 1) PG8_BAR;
        PG8_WAIT_V(2); PG8_BAR;
        PG8_STAGE(PG8_SB(1, 0), cB + kstep, voffB); PG8_STAGE(PG8_SA(1, 0), cA + kstep, voffA); PG8_STAGE(PG8_SB(1, 1), cB + hstepB + kstep, voffB);
        PG8_WAIT_V(6); PG8_BAR;
    } else {
        PG8_STAGE(PG8_SB(0, 0), cB, voffB); PG8_STAGE(PG8_SA(0, 0), cA, voffA); PG8_STAGE(PG8_SB(0, 1), cB + hstepB, voffB); PG8_STAGE(PG8_SA(0, 1), cA + hstepA, voffA);
        if (wr == 1) PG8_BAR;
        PG8_WAIT_V(4); PG8_BAR;
        PG8_STAGE(PG8_SB(1, 0), cB + kstep, voffB); PG8_STAGE(PG8_SA(1, 0), cA + kstep, voffA); PG8_STAGE(PG8_SB(1, 1), cB + hstepB + kstep, voffB);
        PG8_WAIT_V(6); PG8_BAR;
    }
    for (;;) {
        const bool has_next = S.next(ui + 1, nxt);
        const char* nA = has_next ? a_base<MODE>(g, nxt) : cA; const char* nB = has_next ? b_base<MODE>(g, nxt) : cB;
        for (int t = 0; t < nt; t += 2) {
            const bool last = (t == nt - 2); const int rx = __builtin_amdgcn_readfirstlane((relax && t == 0) ? 1 : 0);
            const char* a1 = cA + (size_t)(t + 1) * kstep + ((MODE == 2 && t + 1 >= 8) ? g.ajump : (size_t)0);
            const char* a2 = last ? nA : cA + (size_t)(t + 2) * kstep + ((MODE == 2 && t + 2 >= 8) ? g.ajump : (size_t)0); const char* b2 = last ? nB : cB + (size_t)(t + 2) * kstep;
            const char* a3 = (MODE == 2 && !last) ? cA + (size_t)(t + 3) * kstep + ((t + 3 >= 8) ? g.ajump : (size_t)0) : a2 + kstep; const char* b3 = b2 + kstep;
            if (last && has_next) S.a_ready(nxt);
            if constexpr (SP2) {
            PG8_LDB(B0, 0, 0); PG8_LDB(B1, 0, 1); PG8_SCHED; PG8_LDA(At, 0, 0); PG8_STAGE(PG8_SA(1, 1), a1 + hstepA, voffA);
            PG8_WAIT_V8R(rx); PG8_WAIT_L(0); PG8_BAR; PG8_MMA(0, 0, At, B0); PG8_MMA(0, 1, At, B1); PG8_BAR; PG8_SCHED;
            PG8_LDA(At, 0, 1); PG8_STAGE(PG8_SB(0, 0), b2, voffB); PG8_STAGE(PG8_SB(0, 1), b2 + hstepB, voffB); PG8_STAGE(PG8_SA(0, 0), a2, voffA);
            PG8_WAIT_V8R(rx); PG8_WAIT_L(0); PG8_BAR; PG8_MMA(1, 0, At, B0); PG8_MMA(1, 1, At, B1); PG8_BAR; PG8_SCHED;
            PG8_LDB(B0, 1, 0); PG8_LDB(B1, 1, 1); PG8_SCHED; PG8_LDA(At, 1, 0); PG8_STAGE(PG8_SA(0, 1), a2 + hstepA, voffA);
            PG8_WAIT_V(8); PG8_WAIT_L(0); PG8_BAR; PG8_MMA(0, 0, At, B0); PG8_MMA(0, 1, At, B1); PG8_BAR; PG8_SCHED;
            PG8_LDA(At, 1, 1); PG8_STAGE(PG8_SB(1, 0), b3, voffB); PG8_STAGE(PG8_SB(1, 1), b3 + hstepB, voffB); PG8_STAGE(PG8_SA(1, 0), a3, voffA);
            PG8_WAIT_V(8); PG8_WAIT_L(0); PG8_BAR; PG8_MMA(1, 0, At, B0); PG8_MMA(1, 1, At, B1); PG8_BAR; PG8_SCHED;
            } else {
            PG8_LDB(B0, 0, 0); PG8_SCHED; PG8_LDA(At, 0, 0); PG8_STAGE(PG8_SA(1, 1), a1 + hstepA, voffA);
            PG8_WAIT_L(8); PG8_BAR; PG8_WAIT_L(0); PG8_MMA(0, 0, At, B0); PG8_BAR; PG8_SCHED;
            PG8_LDB(B1, 0, 1); PG8_STAGE(PG8_SB(0, 0), b2, voffB);
            PG8_BAR; PG8_WAIT_L(0); PG8_MMA(0, 1, At, B1); PG8_BAR;
            PG8_LDA(At, 0, 1); PG8_STAGE(PG8_SA(0, 0), a2, voffA);
            PG8_BAR; PG8_WAIT_L(0); PG8_MMA(1, 0, At, B0); PG8_BAR; PG8_SCHED;
            PG8_STAGE(PG8_SB(0, 1), b2 + hstepB, voffB);
            PG8_WAIT_V(6); PG8_BAR; PG8_MMA(1, 1, At, B1); PG8_BAR;
            PG8_LDB(B0, 1, 0); PG8_SCHED; PG8_LDA(At, 1, 0); PG8_STAGE(PG8_SA(0, 1), a2 + hstepA, voffA);
            PG8_WAIT_L(8); PG8_BAR; PG8_WAIT_L(0); PG8_MMA(0, 0, At, B0); PG8_BAR; PG8_SCHED;
            PG8_LDB(B1, 1, 1); PG8_STAGE(PG8_SB(1, 0), b3, voffB);
            PG8_BAR; PG8_WAIT_L(0); PG8_MMA(0, 1, At, B1); PG8_BAR;
            PG8_LDA(At, 1, 1); PG8_STAGE(PG8_SA(1, 0), a3, voffA);
            PG8_BAR; PG8_WAIT_L(0); PG8_MMA(1, 0, At, B0); PG8_BAR; PG8_SCHED;
            PG8_STAGE(PG8_SB(1, 1), b3 + hstepB, voffB);
            PG8_WAIT_V(6); PG8_BAR; PG8_MMA(1, 1, At, B1); PG8_BAR;
            }
        }
        if constexpr (ALIGN_EPI) { if (wr == 0) PG8_BAR; }
        if constexpr (!Epi::AFTER_DRAIN) { int l2; asm volatile("v_mbcnt_lo_u32_b32 %0, -1, 0\n\tv_mbcnt_hi_u32_b32 %0, -1, %0" : "=v"(l2));
            E(acc, cur, wr, wc, l2 & 15, l2 >> 4); S.done(cur); relax = SP2 && Epi::stores16(cur); }
        if (!has_next) break;
#pragma unroll
        for (int a = 0; a < 2; ++a)
#pragma unroll
            for (int b = 0; b < 2; ++b)
#pragma unroll
                for (int m = 0; m < 4; ++m)
#pragma unroll
                    for (int n = 0; n < 2; ++n) acc[a][b][m][n] = (f32x4){0.f, 0.f, 0.f, 0.f};
        cur = nxt; cA = nA; cB = nB; ++ui;
        if constexpr (ALIGN_EPI) { if (wr == 1) PG8_BAR; }
    }
    PG8_WAIT_V(0);
    if constexpr (!ALIGN_EPI) { if (wr == 0) PG8_BAR; }
    PG8_BAR;
    if constexpr (Epi::AFTER_DRAIN) { int l2; asm volatile("v_mbcnt_lo_u32_b32 %0, -1, 0\n\tv_mbcnt_hi_u32_b32 %0, -1, %0" : "=v"(l2)); E.fused(acc, cur, wr, wc, l2 & 15, l2 >> 4, lds, wid, l2); S.done(cur); }
#undef PG8_SA
#undef PG8_SB
#undef PG8_STAGE
#undef PG8_LDA
#undef PG8_LDB
#undef PG8_MMA
#undef PG8_WAIT_V
#undef PG8_WAIT_V8R
#undef PG8_WAIT_L
#undef PG8_BAR
#undef PG8_SCHED
}
}

constexpr int NWAVES = 8, NTHREADS = 512;
constexpr int DM = 1024, NB = 8, SEQ = 2048, DEPTH = 4, MEMLEN = 256, DIN = 4624, DINP = 4864, DFF = 4096;
constexpr int M = NB * SEQ;
constexpr int MMEM = NB * MEMLEN;

constexpr size_t MiB = 1u << 20;
constexpr size_t WS_CTL = 0, CTL_ZERO_BYTES = 1 * MiB;
constexpr size_t WS_SS = 2 * MiB;
constexpr size_t WS_LB = 3 * MiB;
constexpr size_t WS_W = 4 * MiB;
constexpr size_t WO_IN = 0, WO_OUT = 10 * MiB, WO_XQ = 12 * MiB, WO_XO = 14 * MiB, WO_UP = 16 * MiB, WO_DOWN = 24 * MiB;
constexpr size_t WS_KX = 36 * MiB, WS_VT = 52 * MiB;
constexpr size_t WS_XB = 68 * MiB;
constexpr size_t WS_R = 100 * MiB;
constexpr size_t SLAB = pg8::SLAB;
constexpr size_t S_QH = 0, S_VH = 2 * MiB, S_GG = 4 * MiB, S_MQ = 6 * MiB, S_MK = 8 * MiB, S_MV = 10 * MiB, S_MO = 12 * MiB,
                 S_GT = pg8::SL_GT, S_LF = pg8::SL_LF, S_OF = pg8::SL_OF, S_OB = pg8::SL_OB;
constexpr size_t S_P = 0, S_MT = S_MQ, S_NT = S_MK;
constexpr size_t S_H = 0;
constexpr size_t R_END = 8 * SLAB;
constexpr size_t OT_MEMB = 32 * MiB, OT_WKT = 36 * MiB, OT_WVT = 44 * MiB;
constexpr size_t WS_W2 = WS_R + R_END;
constexpr size_t WS_END = WS_W2 + 32 * MiB;
constexpr int CW_BAR = 4096;
constexpr int RING_BYTES = 131072, LDSCTL_OFF = 161792, MISC_OFF = LDSCTL_OFF + 320, LDS_BYTES = 163840;

#define GAS __attribute__((address_space(1)))
#define LAS __attribute__((address_space(3)))
typedef unsigned short bf16;
typedef unsigned v4u __attribute__((ext_vector_type(4)));
typedef float f32x4 __attribute__((ext_vector_type(4)));
#define LDS_WAIT() asm volatile("s_waitcnt lgkmcnt(0)" ::: "memory")
#define VM_WAIT() asm volatile("s_waitcnt vmcnt(0)" ::: "memory")
__device__ __forceinline__ unsigned f2bf(float f) { unsigned u = __builtin_bit_cast(unsigned, f); return (u + 0x7fffu + ((u >> 16) & 1u)) >> 16; }
__device__ __forceinline__ unsigned pk2(float lo, float hi) { return f2bf(lo) | (f2bf(hi) << 16); }
__device__ __forceinline__ float bf2f(unsigned short b) { return __builtin_bit_cast(float, (unsigned)b << 16); }
__device__ __forceinline__ float bflo(unsigned w) { return __builtin_bit_cast(float, w << 16); }
__device__ __forceinline__ float bfhi(unsigned w) { return __builtin_bit_cast(float, w & 0xffff0000u); }

#define XB_TMO      128
#define XB_XCNT(j)  (256  + 64 * (j))
#define XB_XSUB(j)  (1280 + 64 * (j))
#define XB_XGEN(j)  (2304 + 64 * (j))
#define XB_TOP      3328
#define XB_TOPGEN   3392
#define XCD_BAR_WORDS 3456
#define XB_LFLAG(j) (3456 + 64 * (j))
#define XB_SPIN_CAP (1u << 18)

__device__ __forceinline__ unsigned xb_ld(unsigned* p)              { return __hip_atomic_load(p, __ATOMIC_RELAXED, __HIP_MEMORY_SCOPE_AGENT); }
__device__ __forceinline__ unsigned xb_add(unsigned* p, unsigned v) { return __hip_atomic_fetch_add(p, v, __ATOMIC_RELAXED, __HIP_MEMORY_SCOPE_AGENT); }
__device__ __forceinline__ unsigned xb_xcc_id() { return (unsigned)__builtin_amdgcn_s_getreg((3 << 11) | 20) & 0xFu; }
#define XB_SPIN(cond, bar) do { unsigned _sp = 0; while (cond) { __builtin_amdgcn_s_sleep(1); \
    if ((++_sp & 255u) == 0u) { if (xb_ld(&(bar)[XB_TMO])) break; if (_sp > XB_SPIN_CAP) { atomicAdd(&(bar)[XB_TMO], 1u); break; } } } } while (0)

struct XcdBarrier {
    unsigned* bar; unsigned x;
    volatile LAS unsigned* st;
};

__device__ __forceinline__ XcdBarrier xcd_barrier_post(unsigned* bar, volatile LAS unsigned* st, int tid) {
    XcdBarrier b; b.bar = bar; b.x = xb_xcc_id(); b.st = st;
    if (tid == 0) st[3] = xb_add(&bar[XB_XCNT(b.x)], 1u);
    return b;
}
__device__ __forceinline__ void xcd_barrier_complete(unsigned* bar, unsigned x, unsigned& nloc, unsigned& nx, unsigned& uni) {
    const unsigned G = gridDim.x * gridDim.y * gridDim.z;
    unsigned sum, cnt, mine, sp = 0u;
    for (;;) {
        sum = 0u; cnt = 0u; mine = 0u; uni = 1u;
#pragma unroll
        for (unsigned j = 0; j < 16; ++j) { const unsigned c = xb_ld(&bar[XB_XCNT(j)]); sum += c; cnt += (c > 0u) ? 1u : 0u; mine = (j == x) ? c : mine; uni &= (c == (j < 8u ? 32u : 0u)) ? 1u : 0u; }
        if (sum == G) break;
        __builtin_amdgcn_s_sleep(1);
        if ((++sp & 255u) == 0u) { if (xb_ld(&bar[XB_TMO])) break; if (sp > XB_SPIN_CAP) { atomicAdd(&bar[XB_TMO], 1u); break; } }
    }
    nloc = mine > 0u ? mine : 1u; nx = cnt > 0u ? cnt : 1u; if (sum != G || G != 256u) uni = 0u;
}

template <bool LOCAL> __device__ __forceinline__ void xcd_barrier(const XcdBarrier& b, int tid) {
    if (LOCAL) {
        asm volatile("s_waitcnt vmcnt(0)" ::: "memory");
        __syncthreads();
        if (tid < 64) {
            unsigned* fl = b.bar + XB_LFLAG(b.x);
            const unsigned n = __builtin_amdgcn_readfirstlane(b.st[4]) + 1u;
            if (tid == 0) { b.st[4] = n; __hip_atomic_store(fl + b.st[3], n, __ATOMIC_RELAXED, __HIP_MEMORY_SCOPE_WORKGROUP); }
            unsigned sp = 0u;
            for (;;) { const unsigned v = tid < 32 ? xb_ld(fl + tid) : n;
                if (__builtin_amdgcn_ballot_w64(v < n) == 0ull) break;
                __builtin_amdgcn_s_sleep(1);
                if ((++sp & 255u) == 0u) { if (xb_ld(&b.bar[XB_TMO])) break; if (sp > XB_SPIN_CAP) { if (tid == 0) atomicAdd(&b.bar[XB_TMO], 1u); break; } } }
            __builtin_amdgcn_fence(__ATOMIC_ACQUIRE, "agent");
            asm volatile("s_waitcnt vmcnt(0)" ::: "memory");
        }
        __syncthreads();
        return;
    }
    asm volatile("s_waitcnt vmcnt(0)" ::: "memory");
    __syncthreads();
    if (tid == 0) {
        unsigned* bar = b.bar;
        __builtin_amdgcn_s_waitcnt(0);
        unsigned nloc = b.st[0], nx = b.st[1];
        if (nloc == 0u) { unsigned uni_; xcd_barrier_complete(bar, b.x, nloc, nx, uni_); b.st[0] = nloc; b.st[1] = nx; b.st[2] = uni_; }
        const unsigned old = xb_add(&bar[XB_XSUB(b.x)], 1u);
        const unsigned gen = old / nloc;
        if (old + 1u == (gen + 1u) * nloc) {
            __builtin_amdgcn_fence(__ATOMIC_RELEASE, "agent");
            asm volatile("s_waitcnt vmcnt(0)" ::: "memory");
            const unsigned og = xb_add(&bar[XB_TOP], 1u);
            const unsigned tg = og / nx;
            if (og + 1u == (tg + 1u) * nx) xb_add(&bar[XB_TOPGEN], 1u);
            else XB_SPIN(xb_ld(&bar[XB_TOPGEN]) == tg, bar);
            __builtin_amdgcn_fence(__ATOMIC_ACQUIRE, "agent");
            xb_add(&bar[XB_XGEN(b.x)], 1u);
            asm volatile("s_waitcnt vmcnt(0)" ::: "memory");
        } else {
            XB_SPIN(xb_ld(&bar[XB_XGEN(b.x)]) == gen, bar);
            __builtin_amdgcn_fence(__ATOMIC_ACQUIRE, "agent");
            asm volatile("s_waitcnt vmcnt(0)" ::: "memory");
        }
    }
    __syncthreads();
}

struct Args { const float* in[20]; float* out; unsigned char* ws; };
typedef const __attribute__((address_space(4))) Args* KArgs;
__device__ __forceinline__ KArgs fresh_args() { KArgs p = (KArgs)__builtin_amdgcn_kernarg_segment_ptr(); asm volatile("" : "+s"(p)); return p; }
__device__ __forceinline__ int fresh_tid(int wave_s) { int t; asm volatile("v_mbcnt_lo_u32_b32 %0, -1, 0\n\tv_mbcnt_hi_u32_b32 %0, -1, %0" : "=v"(t)); return (wave_s << 6) | t; }
enum { I_X = 0, I_MEM, I_NMIX, I_NXATTN, I_NMEM, I_NMLP, I_NFINAL, I_WIN, I_BIN, I_LBLOG, I_HNORM, I_CONVW, I_CONVB, I_MNORM, I_WOUT, I_WXQ, I_WXKV, I_WXO, I_WUP, I_WDOWN };

__device__ __forceinline__ float wave_sum(float v, int lane) {
#pragma unroll
    for (int o = 1; o < 64; o <<= 1) v += pg8::sx(v, o, lane);
    return v;
}
struct TDesc { const float* W; int ldw, nvalid; bf16* WT; int ldt; const float* g; float scale; int item, nblk; int useg; };
__device__ __forceinline__ void titem_load(const TDesc& d, int lane, float (&vv_)[32], f32x4 (&gv)[2]) {
    const int kb = d.item / d.nblk, nb = d.item % d.nblk, k0 = 64 * kb, n0 = 32 * nb; const int n = n0 + (lane & 31);
    const bool ok_ = n < d.nvalid; const float* wp_ = d.W + (size_t)(k0 + (lane >> 5)) * d.ldw + (ok_ ? n : 0);
#pragma unroll
    for (int i = 0; i < 32; ++i) vv_[i] = wp_[(size_t)(2 * i) * d.ldw];
    const float* gp = d.g + (k0 & 1023) + 8 * (lane & 7);
    gv[0] = *(const f32x4*)gp; gv[1] = *(const f32x4*)(gp + 4);
}
__device__ __forceinline__ void titem_store(const TDesc& d, float* scr, int lane, float (&vv_)[32], const f32x4 (&gv)[2]) {
    const int kb = d.item / d.nblk, nb = d.item % d.nblk, k0 = 64 * kb, n0 = 32 * nb; const int n = n0 + (lane & 31);
    const bool ok_ = n < d.nvalid;
#pragma unroll
    for (int i = 0; i < 32; ++i) { const int kk = 2 * i + (lane >> 5); const float v = ok_ ? vv_[i] * d.scale : 0.f;
        scr[kk * 33 + (lane & 31)] = v; }
    LDS_WAIT(); asm volatile("" ::: "memory");
    const int c = lane & 7; const f32x4 one4 = (f32x4){1.f, 1.f, 1.f, 1.f}; const f32x4 g0_ = d.useg ? gv[0] : one4, g1_ = d.useg ? gv[1] : one4;
#pragma unroll
    for (int j = 0; j < 4; ++j) { const int nn = (lane >> 3) + 8 * j; const float* s = scr + (8 * c) * 33 + nn;
        v4u o; o.x = pk2(s[0 * 33] * g0_[0], s[1 * 33] * g0_[1]); o.y = pk2(s[2 * 33] * g0_[2], s[3 * 33] * g0_[3]); o.z = pk2(s[4 * 33] * g1_[0], s[5 * 33] * g1_[1]); o.w = pk2(s[6 * 33] * g1_[2], s[7 * 33] * g1_[3]);
        *(v4u*)(d.WT + (size_t)(n0 + nn) * d.ldt + k0 + 8 * c) = o; }
    LDS_WAIT(); asm volatile("" ::: "memory");
}
template <class DF> __device__ __forceinline__ void titem_pipeline(DF df, int first, int step, int nit, float* scr, int lane) {
    float va[32], vb[32]; f32x4 ga[2], gb[2]; TDesc da, db; int it = first;
    if (it >= nit) return;
    da = df(it); titem_load(da, lane, va, ga);
    for (;;) {
        int nx = it + step; const bool hb = nx < nit;
        if (hb) { db = df(nx); titem_load(db, lane, vb, gb); }
        titem_store(da, scr, lane, va, ga);
        if (!hb) break;
        it = nx; nx = it + step; const bool ha = nx < nit;
        if (ha) { da = df(nx); titem_load(da, lane, va, ga); }
        titem_store(db, scr, lane, vb, gb);
        if (!ha) break;
        it = nx;
    }
}
__device__ __forceinline__ void convert_layer(KArgs a, int l, unsigned char* lds, int gw, int ngw, int wave, int lane) {
    float* scr = (float*)(lds + wave * 16384);
    bf16* W = (bf16*)(a->ws + ((l & 1) ? WS_W2 : WS_W));
    constexpr int I_A = 16 * (DINP / 32), I_B = 16 * 32, I_U = 16 * (DFF / 32), I_D = 64 * 32;
    constexpr int NIT = I_A + 2 * I_B + I_U + I_D;
    auto df = [=](int it) -> TDesc { int r = it; TDesc d;
        if (r < I_A) { d = TDesc{a->in[I_WIN] + (size_t)l * DM * DIN, DIN, DIN, W + WO_IN / 2, DM, a->in[I_NMIX] + l * DM, 1.f, r, DINP / 32, 1}; return d; } r -= I_A;
        if (r < I_B) { d = TDesc{a->in[I_WOUT] + (size_t)l * DM * DM, DM, DM, W + WO_OUT / 2, DM, a->in[I_NFINAL], 1.f, r, 32, 0}; return d; } r -= I_B;
        if (r < I_B) { d = TDesc{a->in[I_WXO] + (size_t)l * DM * DM, DM, DM, W + WO_XO / 2, DM, a->in[I_NFINAL], 1.f, r, 32, 0}; return d; } r -= I_B;
        if (r < I_U) { d = TDesc{a->in[I_WUP] + (size_t)l * DM * DFF, DFF, DFF, W + WO_UP / 2, DM, a->in[I_NMLP] + l * DM, 1.f, r, DFF / 32, 1}; return d; } r -= I_U;
        d = TDesc{a->in[I_WDOWN] + (size_t)l * DFF * DM, DM, DM, W + WO_DOWN / 2, DFF, a->in[I_NFINAL], 1.f, r, 32, 0}; return d; };
    titem_pipeline(df, gw, ngw, NIT, scr, lane);
    { const float* Wq = a->in[I_WXQ] + (size_t)l * DM * DM; const float* gq = a->in[I_NXATTN] + l * DM; bf16* O = W + WO_XQ / 2;
      for (int k = gw; k < DM; k += 2 * ngw) { const int k2 = k + ngw; const bool h2 = k2 < DM;
          f32x4 v0[4], v1[4];
#pragma unroll
          for (int j = 0; j < 4; ++j) { v0[j] = ((const f32x4*)(Wq + (size_t)k * DM) + lane)[64 * j]; v1[j] = h2 ? ((const f32x4*)(Wq + (size_t)k2 * DM) + lane)[64 * j] : (f32x4){0.f, 0.f, 0.f, 0.f}; }
          const float sc0 = gq[k] * 0.0625f, sc1 = h2 ? gq[k2] * 0.0625f : 0.f;
          unsigned long long* o0 = (unsigned long long*)(O + (size_t)k * DM) + lane; unsigned long long* o1 = (unsigned long long*)(O + (size_t)k2 * DM) + lane;
#pragma unroll
          for (int j = 0; j < 4; ++j) { const f32x4 v = v0[j] * sc0; o0[64 * j] = (unsigned long long)pk2(v[0], v[1]) | ((unsigned long long)pk2(v[2], v[3]) << 32); }
          if (h2) {
#pragma unroll
              for (int j = 0; j < 4; ++j) { const f32x4 v = v1[j] * sc1; o1[64 * j] = (unsigned long long)pk2(v[0], v[1]) | ((unsigned long long)pk2(v[2], v[3]) << 32); } } } }
}
__device__ __forceinline__ void prologue(KArgs a, unsigned char* lds, int gw, int ngw, int wave, int lane, int tid) {
    if (blockIdx.x == 0) { float* LB = (float*)(a->ws + WS_LB);
        for (int i = tid; i < 2 * 512; i += NTHREADS) { const int dir = i >> 9, c = i & 511; const float* lg = a->in[I_LBLOG] + (size_t)dir * DEPTH * 512 + c;
            const float l0 = lg[0], l1 = lg[512], l2 = lg[1024], l3 = lg[1536]; const float mx = fmaxf(fmaxf(l0, l1), fmaxf(l2, l3));
            const float e0 = expf(l0 - mx), e1 = expf(l1 - mx), e2 = expf(l2 - mx), e3 = expf(l3 - mx); const float inv = 1.f / (e0 + e1 + e2 + e3);
            LB[(0 * 2 + dir) * 512 + c] = 0.f; LB[(1 * 2 + dir) * 512 + c] = e1 * inv; LB[(2 * 2 + dir) * 512 + c] = (e1 + e2) * inv; LB[(3 * 2 + dir) * 512 + c] = (e1 + e2 + e3) * inv; } }
    { bf16* XB = (bf16*)(a->ws + WS_XB); float* SS = (float*)(a->ws + WS_SS); const float* x = a->in[I_X];
      for (int m0 = gw; m0 < M; m0 += 4 * ngw) { f32x4 v[4][4]; float s4[4];
#pragma unroll
          for (int r = 0; r < 4; ++r) { const int m = m0 + r * ngw; const int mm = m < M ? m : gw; const f32x4* xr = (const f32x4*)(x + (size_t)mm * DM) + lane;
#pragma unroll
              for (int j = 0; j < 4; ++j) v[r][j] = xr[64 * j]; }
#pragma unroll
          for (int r = 0; r < 4; ++r) { float s = 0.f;
#pragma unroll
              for (int j = 0; j < 4; ++j) s += (v[r][j][0] * v[r][j][0] + v[r][j][1] * v[r][j][1]) + (v[r][j][2] * v[r][j][2] + v[r][j][3] * v[r][j][3]);
              s4[r] = s; }
#pragma unroll
          for (int o_ = 1; o_ < 64; o_ <<= 1) {
#pragma unroll
              for (int r = 0; r < 4; ++r) s4[r] += pg8::sx(s4[r], o_, lane); }
          __builtin_amdgcn_sched_barrier(0);
#pragma unroll
          for (int r = 0; r < 4; ++r) { const int m = m0 + r * ngw; if (m >= M) break;
              unsigned long long* o8 = (unsigned long long*)(XB + (size_t)m * DM) + lane;
#pragma unroll
              for (int j = 0; j < 4; ++j) o8[64 * j] = (unsigned long long)pk2(v[r][j][0], v[r][j][1]) | ((unsigned long long)pk2(v[r][j][2], v[r][j][3]) << 32);
              if (lane < 16) SS[(size_t)m * 16 + lane] = lane == 0 ? s4[r] : 0.f; } } }
    { bf16* MB = (bf16*)((unsigned char*)a->out + OT_MEMB); const float* x = a->in[I_MEM];
      for (int m = gw; m < MMEM; m += ngw) { const f32x4* xr = (const f32x4*)(x + (size_t)m * DM) + lane; f32x4 v[4]; float s = 0.f;
#pragma unroll
          for (int j = 0; j < 4; ++j) { v[j] = xr[64 * j]; s += (v[j][0] * v[j][0] + v[j][1] * v[j][1]) + (v[j][2] * v[j][2] + v[j][3] * v[j][3]); }
          const float rs = 1.0f / sqrtf(wave_sum(s, lane) * (1.0f / DM) + 1e-6f);
          unsigned long long* o8 = (unsigned long long*)(MB + (size_t)m * DM) + lane;
#pragma unroll
          for (int j = 0; j < 4; ++j) o8[64 * j] = (unsigned long long)pk2(v[j][0] * rs, v[j][1] * rs) | ((unsigned long long)pk2(v[j][2] * rs, v[j][3] * rs) << 32); } }
    { float* scr = (float*)(lds + wave * 16384); bf16* WKT = (bf16*)((unsigned char*)a->out + OT_WKT); bf16* WVT = (bf16*)((unsigned char*)a->out + OT_WVT);
      auto df = [=](int it) -> TDesc { const int l = it >> 10, part = (it >> 9) & 1, r = it & 511;
          return TDesc{a->in[I_WXKV] + (size_t)l * DM * 2048 + part * 1024, 2048, 1024, (part ? WVT : WKT) + (size_t)l * 1024 * DM, DM, a->in[I_NMEM] + l * DM, 1.f, r, 32, 1}; };
      titem_pipeline(df, gw, ngw, DEPTH * 2 * 512, scr, lane); }
    convert_layer(a, 0, lds, gw, ngw, wave, lane);
}
__device__ __forceinline__ void final_phase(KArgs a, int gw, int ngw, int lane) {
    const float* g = a->in[I_NFINAL] + lane * 16; const bf16* XB = (const bf16*)(a->ws + WS_XB);
    f32x4 gg[4];
#pragma unroll
    for (int j = 0; j < 4; ++j) gg[j] = *(const f32x4*)(g + 4 * j);
    for (int m0 = gw; m0 < M; m0 += 8 * ngw) {
        v4u w0[8], w1[8]; float s8[8];
#pragma unroll
        for (int r = 0; r < 8; ++r) { const int m = m0 + r * ngw; const int mm = m < M ? m : gw;
            w0[r] = *(const v4u*)(XB + (size_t)mm * DM + lane * 16); w1[r] = *(const v4u*)(XB + (size_t)mm * DM + lane * 16 + 8); }
#pragma unroll
        for (int r = 0; r < 8; ++r) { float s = 0.f;
#pragma unroll
            for (int j = 0; j < 4; ++j) { const float a0 = bflo(w0[r][j]), a1 = bfhi(w0[r][j]), a2 = bflo(w1[r][j]), a3 = bfhi(w1[r][j]); s += (a0 * a0 + a1 * a1) + (a2 * a2 + a3 * a3); }
            s8[r] = s; }
#pragma unroll
        for (int o_ = 1; o_ < 64; o_ <<= 1) {
#pragma unroll
            for (int r = 0; r < 8; ++r) s8[r] += pg8::sx(s8[r], o_, lane); }
        __builtin_amdgcn_sched_barrier(0);
#pragma unroll
        for (int r = 0; r < 8; ++r) { const int m = m0 + r * ngw; if (m >= M) break;
            const float rs = 1.0f / sqrtf(s8[r] * (1.0f / DM) + 1e-6f);
            float x[16];
#pragma unroll
            for (int j = 0; j < 4; ++j) { x[2 * j] = bflo(w0[r][j]); x[2 * j + 1] = bfhi(w0[r][j]); x[8 + 2 * j] = bflo(w1[r][j]); x[8 + 2 * j + 1] = bfhi(w1[r][j]); }
            f32x4* o = (f32x4*)(a->out + (size_t)m * DM + lane * 16);
#pragma unroll
            for (int j = 0; j < 4; ++j) o[j] = (f32x4){x[4 * j] * rs * gg[j][0], x[4 * j + 1] * rs * gg[j][1], x[4 * j + 2] * rs * gg[j][2], x[4 * j + 3] * rs * gg[j][3]}; } }
}
namespace sc {
typedef short bf16x8 __attribute__((ext_vector_type(8)));
typedef float f32x4 __attribute__((ext_vector_type(4)));
typedef float f32x2 __attribute__((ext_vector_type(2)));
typedef unsigned u32x2 __attribute__((ext_vector_type(2)));
constexpr int LQ = 272, LS = 144;
constexpr int O_QS = 0, O_KS = O_QS + 64 * LQ, O_KDT = O_KS + 64 * LQ, O_VT = O_KDT + 128 * LS, O_KDT1 = O_VT + 64 * LS, O_VT1 = O_KDT1 + 128 * LS, O_P = O_VT1 + 64 * LS, O_ST = O_P + 64 * LS, O_SEG = O_ST + 80 * LQ,
              O_DEC = O_SEG + 4096, O_SCAL = O_DEC + 1024, O_NV = O_SCAL + 3072, O_PRE = O_NV + 1024, O_END = O_PRE + 3 * 32 * 64 * 4;
static_assert(O_END <= LDSCTL_OFF, "scan LDS map");
#define SC_BAR() do { __builtin_amdgcn_sched_barrier(0); asm volatile("s_waitcnt lgkmcnt(0)" ::: "memory"); __builtin_amdgcn_s_barrier(); asm volatile("" ::: "memory"); __builtin_amdgcn_sched_barrier(0); } while (0)
__device__ __forceinline__ bf16x8 frag(const unsigned char* base, int row, int pitch, int kbyte) { return *(const bf16x8*)(base + row * pitch + kbyte); }
__device__ __forceinline__ unsigned cvt2(float lo, float hi) { return pg8::cvt_pk_bf16(lo, hi); }
typedef _Float16 h2_t __attribute__((ext_vector_type(2)));
__device__ __forceinline__ f32x2 h2f(unsigned w) { return __builtin_convertvector(__builtin_bit_cast(h2_t, w), f32x2); }

constexpr int CW_CONV = 8192;
template <int NF> __device__ __forceinline__ void head_sync(unsigned* cnt, unsigned want, int slot, unsigned n, int mode, int tid, int uni);
__device__ __forceinline__ void mlstm_conv_part(KArgs a, int l, int b, int h, int part, int tid, int uni) {
    const int pair = tid & 127, which = pair >> 6, dp = pair & 63, rr = tid >> 7;
    unsigned char* R = a->ws + WS_R;
    const unsigned* src = (const unsigned*)((const bf16*)(R + (size_t)b * SLAB + (which ? S_MK : S_MQ)) + h * 128);
    unsigned* dst = (unsigned*)((bf16*)((unsigned char*)a->out + (which ? 16 * MiB : 0)) + h * 128) + (size_t)b * SEQ * 256;
    const float* cw = a->in[I_CONVW] + (size_t)l * 5 * 1024 + which * 512 + h * 128 + 2 * dp; const float* cb = a->in[I_CONVB] + (size_t)l * 1024 + which * 512 + h * 128 + 2 * dp;
    f32x2 w[5]; const f32x2 bias = *(const f32x2*)cb; const float sc = which ? 0.08838834764831845f : 1.0f;
#pragma unroll
    for (int j = 0; j < 5; ++j) w[j] = *(const f32x2*)(cw + j * 1024);
    const int t0 = 256 * part + 64 * rr;
    f32x2 x0, x1, x2, x3;
    { const unsigned z = 0u; const unsigned a0 = t0 >= 2 ? src[(size_t)(t0 - 2) * 256 + dp] : z, a1 = t0 >= 1 ? src[(size_t)(t0 - 1) * 256 + dp] : z, a2 = src[(size_t)t0 * 256 + dp], a3 = src[(size_t)(t0 + 1) * 256 + dp];
      x0 = (f32x2){bflo(a0), bfhi(a0)}; x1 = (f32x2){bflo(a1), bfhi(a1)}; x2 = (f32x2){bflo(a2), bfhi(a2)}; x3 = (f32x2){bflo(a3), bfhi(a3)}; }
    unsigned rawA[8], rawB[8];
#define CONV_LOAD(tb, raw) do { _Pragma("unroll") for (int i = 0; i < 8; ++i) { const int tn = t0 + (tb) + i + 2; raw[i] = src[(size_t)(tn < SEQ ? tn : SEQ - 1) * 256 + dp]; } } while (0)
#define CONV_FINISH(tb, raw) do { _Pragma("unroll") for (int i = 0; i < 8; ++i) { const int t = t0 + (tb) + i; const f32x2 x4 = (t + 2 < SEQ) ? (f32x2){bflo(raw[i]), bfhi(raw[i])} : (f32x2){0.f, 0.f}; \
            const f32x2 y = bias + w[0] * x0 + w[1] * x1 + w[2] * x2 + w[3] * x3 + w[4] * x4; \
            dst[(size_t)t * 256 + dp] = cvt2(y.x * pg8::sigm(y.x) * sc, y.y * pg8::sigm(y.y) * sc); \
            x0 = x1; x1 = x2; x2 = x3; x3 = x4; } } while (0)
    CONV_LOAD(0, rawA);
#pragma unroll
    for (int tb = 0; tb < 64; tb += 16) {
        CONV_LOAD(tb + 8, rawB); __builtin_amdgcn_sched_barrier(0);
        CONV_FINISH(tb, rawA); __builtin_amdgcn_sched_barrier(0);
        if (tb + 16 < 64) CONV_LOAD(tb + 16, rawA);
        __builtin_amdgcn_sched_barrier(0);
        CONV_FINISH(tb + 8, rawB); __builtin_amdgcn_sched_barrier(0);
    }
#undef CONV_LOAD
#undef CONV_FINISH
    head_sync<8>((unsigned*)(a->ws + WS_CTL) + CW_CONV + 64 * (4 * b + h), 8u * (unsigned)(l + 1), part, (unsigned)(l + 1), 0, tid, uni);
}

constexpr int CW_MIX = 12288;
template <int NF> __device__ __forceinline__ void head_sync(unsigned* cnt, unsigned want, int slot, unsigned n, int mode, int tid, int uni) {
    const bool post = mode != 2, wait = mode != 0;
    if (post) { asm volatile("s_waitcnt vmcnt(0)" ::: "memory"); __syncthreads(); }
    if (uni) {
        if (tid < 64) { unsigned* fl = cnt + 8;
            if (tid == 0 && post) __hip_atomic_store(fl + slot, n, __ATOMIC_RELAXED, __HIP_MEMORY_SCOPE_WORKGROUP);
            unsigned spins = 0;
            if (wait) for (;;) { const unsigned v = tid < NF ? __hip_atomic_load(fl + tid, __ATOMIC_RELAXED, __HIP_MEMORY_SCOPE_AGENT) : n;
                if (__builtin_amdgcn_ballot_w64(v < n) == 0ull) break;
                __builtin_amdgcn_s_sleep(1); if (++spins > (1u << 22)) break; }
            if (wait) { __builtin_amdgcn_fence(__ATOMIC_ACQUIRE, "agent"); asm volatile("s_waitcnt vmcnt(0)" ::: "memory"); } }
    } else if (tid == 0) { if (post) { __builtin_amdgcn_fence(__ATOMIC_RELEASE, "agent"); asm volatile("s_waitcnt vmcnt(0)" ::: "memory");
        __hip_atomic_fetch_add(cnt, 1u, __ATOMIC_RELAXED, __HIP_MEMORY_SCOPE_AGENT); } unsigned spins = 0;
        if (wait) { while (__hip_atomic_load(cnt, __ATOMIC_RELAXED, __HIP_MEMORY_SCOPE_AGENT) < want) { __builtin_amdgcn_s_sleep(2); if (++spins > (1u << 22)) break; }
            __builtin_amdgcn_fence(__ATOMIC_ACQUIRE, "agent"); asm volatile("s_waitcnt vmcnt(0)" ::: "memory"); } }
    __syncthreads();
}
__device__ __forceinline__ void mix_quarter(KArgs a, int l, int type, int b, int h, int qi, int tid, int uni) {
    head_sync<4>((unsigned*)(a->ws + WS_CTL) + CW_MIX + 64 * (32 * type + 4 * b + h), 4u * (unsigned)(l + 1), qi, (unsigned)(l + 1), 1, tid, uni);
    const int lane = tid & 63, wave = tid >> 6, c16 = (lane & 7) * 16;
    unsigned char* R = a->ws + WS_R;
    unsigned char* SLB = R + (size_t)b * SLAB;
    const bf16* OF = (const bf16*)(SLB + S_OF) + type * 512 + h * 128 + c16; const bf16* OB = (const bf16*)(SLB + S_OB) + type * 512 + h * 128 + c16;
    bf16* GD = (bf16*)(SLB + (type ? S_MO : S_GG)) + h * 128 + c16;
    const float* gn = a->in[type ? I_MNORM : I_HNORM] + l * 512 + h * 128 + c16;
    float g[16];
#pragma unroll
    for (int j = 0; j < 16; ++j) g[j] = gn[j];
    const size_t m0 = (size_t)(512 * qi + 8 * wave + (lane >> 3));
    v4u L[2][2][6];
#define MIX_LOAD(ps, d) do { const size_t m_ = m0 + 64 * (ps); d[0] = *(const v4u*)(OF + m_ * 1024); d[1] = *(const v4u*)(OF + m_ * 1024 + 8); d[2] = *(const v4u*)(OB + m_ * 1024); d[3] = *(const v4u*)(OB + m_ * 1024 + 8); \
        d[4] = *(const v4u*)(GD + m_ * 512); d[5] = *(const v4u*)(GD + m_ * 512 + 8); } while (0)
#define MIX_FINISH(ps, d) do { const size_t m_ = m0 + 64 * (ps); float o[16]; float s_ = 0.f; \
        _Pragma("unroll") for (int j = 0; j < 16; ++j) { const unsigned fw = j < 8 ? d[0][(j >> 1) & 3] : d[1][(j >> 1) & 3], bw = j < 8 ? d[2][(j >> 1) & 3] : d[3][(j >> 1) & 3]; \
            o[j] = ((j & 1) ? bfhi(fw) : bflo(fw)) + ((j & 1) ? bfhi(bw) : bflo(bw)); s_ += o[j] * o[j]; } \
        s_ += pg8::sx(s_, 1, lane); s_ += pg8::sx(s_, 2, lane); s_ += pg8::sx(s_, 4, lane); \
        const float rs = __builtin_amdgcn_rsqf(s_ * (1.0f / 128.0f) + 1e-6f); \
        v4u w0, w1; \
        _Pragma("unroll") for (int j = 0; j < 16; j += 2) { const unsigned gw2 = j < 8 ? d[4][(j >> 1) & 3] : d[5][(j >> 1) & 3]; \
            const float z0 = bflo(gw2), z1 = bfhi(gw2), s0_ = pg8::sigm(z0), s1_ = pg8::sigm(z1);                  \
            const unsigned pk = cvt2(o[j] * rs * g[j] * (type ? s0_ : z0 * s0_), o[j + 1] * rs * g[j + 1] * (type ? s1_ : z1 * s1_)); \
            if (j < 8) w0[(j >> 1) & 3] = pk; else w1[(j >> 1) & 3] = pk; } \
        *(v4u*)(GD + m_ * 512) = w0; *(v4u*)(GD + m_ * 512 + 8) = w1; } while (0)
    MIX_LOAD(0, L[0][0]); MIX_LOAD(1, L[0][1]);
#pragma unroll
    for (int p = 0; p < 4; ++p) {
        if (p + 1 < 4) { MIX_LOAD(2 * p + 2, L[(p + 1) & 1][0]); MIX_LOAD(2 * p + 3, L[(p + 1) & 1][1]); }
        __builtin_amdgcn_sched_barrier(0);
        MIX_FINISH(2 * p, L[p & 1][0]); MIX_FINISH(2 * p + 1, L[p & 1][1]);
        __builtin_amdgcn_sched_barrier(0);
    }
#undef MIX_LOAD
#undef MIX_FINISH
}

template <int TYPE> __device__ __forceinline__ void scan_s1b(unsigned char* lds, const int par, unsigned (&lfh)[8], unsigned (&qv)[8], unsigned (&kv)[8], unsigned (&vv)[4], const f32x2 cl7,
                                                        const int dp, const int rg, const int ep, const int sv, const f32x2* SEG, const float* SWKp) {
    const int okdt = par ? O_KDT1 : O_KDT, ovt = par ? O_VT1 : O_VT; float* DECp = (float*)(lds + O_DEC) + par * 128; (void)DECp; (void)SWKp; (void)cl7; (void)SEG;
    { asm volatile("" : "+v"(vv[0]), "+v"(vv[1]), "+v"(vv[2]), "+v"(vv[3]));
#pragma unroll
      for (int i = 0; i < 8; i += 4) { asm volatile("" : "+v"(qv[i]), "+v"(qv[i + 1]), "+v"(qv[i + 2]), "+v"(qv[i + 3])); if (TYPE == 1) asm volatile("" : "+v"(kv[i]), "+v"(kv[i + 1]), "+v"(kv[i + 2]), "+v"(kv[i + 3])); }
      unsigned kd0[4], kd1[4];
      if (TYPE == 0) { f32x2 pre = (f32x2){0.f, 0.f}, tot = pre;
#pragma unroll
          for (int j = 0; j < 8; ++j) { const f32x2 s_ = SEG[j * 64 + dp]; tot += s_; if (j < rg) pre += s_; }
          f32x2 f[8], kk[8];
#pragma unroll
          for (int i = 0; i < 8; ++i) { f[i] = h2f(lfh[i]); kk[i] = 1.0f - f[i]; }
          f32x2 E; E.x = __expf(pre.x); E.y = __expf(pre.y);
          f32x2 G; { const f32x2 ex = tot - (pre + cl7); G.x = __expf(ex.x); G.y = __expf(ex.y); }
          float kdx[8], kdy[8];
#pragma unroll
          for (int i = 7; i >= 0; --i) { const f32x2 kd = kk[i] * G; kdx[i] = kd.x; kdy[i] = kd.y; G = G * f[i]; }
#pragma unroll
          for (int i = 0; i < 8; ++i) { const int p = 8 * rg + i; E = E * f[i];
              const f32x2 qs = (f32x2){bflo(qv[i]), bfhi(qv[i])} * E;
              f32x2 ks; ks.x = kk[i].x * __builtin_amdgcn_rcpf(fmaxf(E.x, 1e-35f)); ks.y = kk[i].y * __builtin_amdgcn_rcpf(fmaxf(E.y, 1e-35f));
              *(unsigned*)(lds + O_QS + p * LQ + dp * 4) = cvt2(qs.x, qs.y);
              *(unsigned*)(lds + O_KS + p * LQ + dp * 4) = cvt2(ks.x, ks.y); }
#pragma unroll
          for (int i = 0; i < 4; ++i) { kd0[i] = cvt2(kdx[2 * i], kdx[2 * i + 1]); kd1[i] = cvt2(kdy[2 * i], kdy[2 * i + 1]); }
          if (rg == 0) { f32x2 dd; dd.x = __expf(tot.x); dd.y = __expf(tot.y); *(f32x2*)(DECp + 2 * dp) = dd; }
      } else {
          const f32x4 wk0 = *(const f32x4*)(SWKp + 8 * rg), wk1 = *(const f32x4*)(SWKp + 8 * rg + 4);
          float kdx[8], kdy[8];
#pragma unroll
          for (int i = 0; i < 8; ++i) { const int p = 8 * rg + i;
              *(unsigned*)(lds + O_QS + p * LQ + dp * 4) = qv[i];
              *(unsigned*)(lds + O_KS + p * LQ + dp * 4) = kv[i];
              const float w_ = i < 4 ? wk0[i & 3] : wk1[i & 3]; kdx[i] = bflo(kv[i]) * w_; kdy[i] = bfhi(kv[i]) * w_; }
#pragma unroll
          for (int i = 0; i < 4; ++i) { kd0[i] = cvt2(kdx[2 * i], kdx[2 * i + 1]); kd1[i] = cvt2(kdy[2 * i], kdy[2 * i + 1]); }
      }
      *(v4u*)(lds + okdt + (2 * dp) * LS + 16 * rg) = (v4u){kd0[0], kd0[1], kd0[2], kd0[3]};
      *(v4u*)(lds + okdt + (2 * dp + 1) * LS + 16 * rg) = (v4u){kd1[0], kd1[1], kd1[2], kd1[3]};
      u32x2 w0, w1; w0.x = (vv[0] & 0xffffu) | (vv[1] << 16); w0.y = (vv[2] & 0xffffu) | (vv[3] << 16); w1.x = (vv[0] >> 16) | (vv[1] & 0xffff0000u); w1.y = (vv[2] >> 16) | (vv[3] & 0xffff0000u);
      *(u32x2*)(lds + ovt + (2 * ep) * LS + 8 * sv) = w0; *(u32x2*)(lds + ovt + (2 * ep + 1) * LS + 8 * sv) = w1; }
}

template <int TYPE> __device__ __forceinline__ void scan_item(KArgs a, int l, int item, unsigned char* lds, int tid, int uni) {
    const int lane = tid & 63, wave = __builtin_amdgcn_readfirstlane(tid >> 6), fr = lane & 15, fq = lane >> 4;
    const int dir = (item >> 6) & 1, b = (item >> 3) & 7, h = (item >> 1) & 3, half = item & 1;
    unsigned char* R = a->ws + WS_R + (size_t)b * SLAB;
    bf16* OUT = (bf16*)(R + (dir ? S_OB : S_OF)) + TYPE * 512 + h * 128 + half * 64;
    const int dp = lane, rg = wave;
    const int ep = tid & 31, sv = tid >> 5;
    const int rstep = dir ? -1 : 1;
    const int row00 = dir ? SEQ - 1 : 0;
#define SC_RLO(c) (dir ? row00 - ((c) * 64 + 63) : row00 + (c) * 64)
#define SC_LR(p) (dir ? 63 - (p) : (p))
    unsigned lfh[2][8], qv[2][8], kv[2][8], vv[2][4];
    const unsigned* Qb = (const unsigned*)((const bf16*)(TYPE == 0 ? R + S_QH : (unsigned char*)a->out + (size_t)b * SEQ * 1024) + h * 128);
    const unsigned* Kb = (const unsigned*)((const bf16*)((unsigned char*)a->out + 16 * MiB + (size_t)b * SEQ * 1024) + h * 128);
    const unsigned* Vb = (const unsigned*)((const bf16*)(R + (TYPE == 0 ? S_VH : S_MV)) + h * 128 + half * 64);
    const unsigned* Lb = (const unsigned*)((const unsigned short*)(R + S_LF) + (size_t)dir * SEQ * 512 + h * 128);
    const float* GT = (const float*)(R + S_GT) + dir * 4 + h;
    const unsigned voffv = (unsigned)(SC_LR(4 * sv) * 256 + ep);
    const unsigned voffg = (unsigned)(SC_LR(lane) * 16);
#define SC_LOAD(c, u) do { long rlo_ = SC_RLO(c); asm volatile("" : "+s"(rlo_));     \
        if (TYPE == 0) { _Pragma("unroll") for (int i = 0; i < 8; ++i) { const long r = (rlo_ + SC_LR(8 * rg + i)) * 256; lfh[u][i] = Lb[r + dp]; qv[u][i] = Qb[r + dp]; } } \
        else { _Pragma("unroll") for (int i = 0; i < 8; ++i) { const long r = (rlo_ + SC_LR(8 * rg + i)) * 256; qv[u][i] = Qb[r + dp]; kv[u][i] = Kb[r + dp]; } \
        } \
        _Pragma("unroll") for (int i = 0; i < 4; ++i) { const unsigned vo_ = voffv + (unsigned)(rstep * i * 256); vv[u][i] = Vb[rlo_ * 256 + vo_]; } } while (0)
    f32x4 Sacc[4], Sx = (f32x4){0.f, 0.f, 0.f, 0.f};
#pragma unroll
    for (int et = 0; et < 4; ++et) Sacc[et] = (f32x4){0.f, 0.f, 0.f, 0.f};
    bf16x8 ONES; { const short o_ = (fr & 3) == 0 ? (short)0x3F80 : (short)0; ONES = (bf16x8){o_, o_, o_, o_, o_, o_, o_, o_}; }
    float m_prev = 0.f;
    for (int i = tid; i < 80 * LQ / 4; i += NTHREADS) ((unsigned*)(lds + O_ST))[i] = 0u;
    f32x2* SEG = (f32x2*)(lds + O_SEG); float* DEC = (float*)(lds + O_DEC); float* SCL = (float*)(lds + O_SCAL);
    float* PRE = (float*)(lds + O_PRE);
    if (TYPE == 1) {
        for (int cc = wave; cc < SEQ / 64; cc += NWAVES) { const long rl = SC_RLO(cc); const float gi_ = GT[rl * 16 + voffg], gf_ = GT[rl * 16 + voffg + 8];
            float cum = gf_;
#pragma unroll
            for (int o = 1; o < 64; o <<= 1) { const float t_ = pg8::sx_up(cum, o, lane); if (lane >= o) cum += t_; }
            const float bb = gi_ - cum; float pm = bb;
#pragma unroll
            for (int o = 1; o < 64; o <<= 1) { const float t_ = pg8::sx_up(pm, o, lane); if (lane >= o) pm = fmaxf(pm, t_); }
            PRE[cc * 64 + lane] = cum; PRE[2048 + cc * 64 + lane] = bb; PRE[4096 + cc * 64 + lane] = pm; } }
    if (TYPE == 1) head_sync<8>((unsigned*)(a->ws + WS_CTL) + CW_CONV + 64 * (4 * b + h), 8u * (unsigned)(l + 1), 0, (unsigned)(l + 1), 2, tid, uni);
    SC_LOAD(0, 0); SC_LOAD(1, 1);
    SC_BAR();
    f32x2 cl7 = (f32x2){0.f, 0.f};
#define SC_S1A(cn, u) do { if (TYPE == 0) { f32x2 p_ = (f32x2){1.f, 1.f}; _Pragma("unroll") for (int i = 0; i < 8; ++i) p_ = p_ * h2f(lfh[u][i]); f32x2 c_; c_.x = __logf(fmaxf(p_.x, 1e-37f)); c_.y = __logf(fmaxf(p_.y, 1e-37f)); cl7 = c_; SEG[rg * 64 + dp] = c_; } \
        else if (wave == 0) { const float cum = PRE[(cn) * 64 + lane], bb = PRE[2048 + (cn) * 64 + lane], pm = PRE[4096 + (cn) * 64 + lane], cum_last = PRE[(cn) * 64 + 63], pm_last = PRE[4096 + (cn) * 64 + 63]; \
            const float li = cum + m_prev, mt = fmaxf(cum + pm, li); \
            const float m_new = fmaxf(cum_last + m_prev, cum_last + pm_last); \
            float* W_ = SCL + ((cn) & 1) * 384; W_[lane] = cum - mt; W_[64 + lane] = bb; W_[128 + lane] = __expf(li - mt); W_[192 + lane] = __expf(-mt); W_[256 + lane] = __expf(cum_last + bb - m_new); if (lane == 0) W_[320] = __expf(cum_last + m_prev - m_new); \
            m_prev = m_new; } } while (0)
    SC_S1A(0, 0);
    SC_BAR();
    scan_s1b<TYPE>(lds, 0, lfh[0], qv[0], kv[0], vv[0], cl7, dp, rg, ep, sv, SEG, SCL + 256);
    SC_LOAD(2, 0);
    SC_BAR();
#pragma unroll 1
    for (int c0 = 0; c0 < SEQ / 64; c0 += 2)
#pragma unroll
    for (int u = 0; u < 2; ++u) { const int c = c0 + u;
        const float* SA = SCL + (c & 1) * 384; const float* SB = SA + 64; const float* SWI = SA + 128; const float* SEM = SA + 192; const float* SWK = SA + 256; const float* SCAR = SA + 320;
        (void)SB; (void)SWI; (void)SEM; (void)SWK; (void)SCAR;
        const int tt = wave >> 1, c2 = (wave & 1) * 2;
        f32x4 oacc[2]; float dqv = 0.f;
        const bool hi2 = tt >= 2;
        const int rk1 = (c2 + 1 <= tt) ? 16 * (c2 + 1) + fr : 16 * c2;
        { f32x4 sacc[2]; sacc[0] = sacc[1] = oacc[0] = oacc[1] = (f32x4){0.f, 0.f, 0.f, 0.f};
          bf16x8 Bq[4], Ak[2][4], As[2][4], Ax[4];
#pragma unroll
          for (int ks = 0; ks < 4; ++ks) { const int kb = (32 * ks + 8 * fq) * 2; Bq[ks] = frag(lds + O_QS, 16 * tt + fr, LQ, kb);
#pragma unroll
              for (int j = 0; j < 2; ++j) { Ak[j][ks] = frag(lds + O_KS, j == 0 ? 16 * c2 + fr : rk1, LQ, kb); As[j][ks] = frag(lds + O_ST, 16 * (c2 + j) + fr, LQ, kb); }
              if (TYPE == 1) Ax[ks] = frag(lds + O_ST, 64 + fr, LQ, kb); }
#pragma unroll
          for (int ks = 0; ks < 4; ++ks)
#pragma unroll
              for (int j = 0; j < 2; ++j) { sacc[j] = __builtin_amdgcn_mfma_f32_16x16x32_bf16(Ak[j][ks], Bq[ks], sacc[j], 0, 0, 0);
                                            oacc[j] = __builtin_amdgcn_mfma_f32_16x16x32_bf16(As[j][ks], Bq[ks], oacc[j], 0, 0, 0); }
          if (TYPE == 1) { f32x4 ox = (f32x4){0.f, 0.f, 0.f, 0.f};
#pragma unroll
              for (int ks = 0; ks < 4; ++ks) ox = __builtin_amdgcn_mfma_f32_16x16x32_bf16(Ax[ks], Bq[ks], ox, 0, 0, 0);
              dqv = ox[0]; }
          const int t_ = 16 * tt + fr; const float sa = TYPE == 1 ? SA[t_] : 0.f;
#pragma unroll
          for (int j = 0; j < 2; ++j) { const int s0 = 16 * (c2 + j) + 4 * fq; f32x4 pv = sacc[j];
              if (TYPE == 1) { const f32x4 sb = *(const f32x4*)(SB + s0);
#pragma unroll
                  for (int r = 0; r < 4; ++r) pv[r] *= __expf(fminf(sa + sb[r], 0.f)); }
#pragma unroll
              for (int r = 0; r < 4; ++r) pv[r] = (s0 + r <= t_) ? pv[r] : 0.f;
              u32x2 w; w.x = cvt2(pv[0], pv[1]); w.y = cvt2(pv[2], pv[3]);
              *(u32x2*)(lds + O_P + t_ * LS + s0 * 2) = w; } }
        if (c + 1 < SEQ / 64) SC_S1A(c + 1, u ^ 1);
        SC_BAR();
        { const int t_ = 16 * tt + fr;
          bf16x8 Bp[2], Vf[2][2], Vs[4][2], Kd[2];
#pragma unroll
          for (int ks = 0; ks < 2; ++ks) { const int kb = (32 * ks + 8 * fq) * 2; if (ks == 0 || hi2) { Bp[ks] = frag(lds + O_P, t_, LS, kb);
#pragma unroll
              for (int j = 0; j < 2; ++j) Vf[j][ks] = frag(lds + (u ? O_VT1 : O_VT), 16 * (c2 + j) + fr, LS, kb); } }
#pragma unroll
          for (int ks = 0; ks < 2; ++ks) { const int kb = (32 * ks + 8 * fq) * 2; Kd[ks] = frag(lds + (u ? O_KDT1 : O_KDT), 16 * wave + fr, LS, kb);
#pragma unroll
              for (int et = 0; et < 4; ++et) Vs[et][ks] = frag(lds + (u ? O_VT1 : O_VT), 16 * et + fr, LS, kb); }
          float wi = 1.f, sem = 0.f; f32x4 dv;
          if (TYPE == 0) dv = *(const f32x4*)(DEC + u * 128 + 16 * wave + 4 * fq); else { wi = SWI[t_]; sem = SEM[t_]; const float cr = SCAR[0]; dv = (f32x4){cr, cr, cr, cr}; }
          if (c + 1 < SEQ / 64) { scan_s1b<TYPE>(lds, u ^ 1, lfh[u ^ 1], qv[u ^ 1], kv[u ^ 1], vv[u ^ 1], cl7, dp, rg, ep, sv, SEG, SCL + (u ^ 1) * 384 + 256);
              if (c + 3 < SEQ / 64) SC_LOAD(c + 3, u ^ 1); }
          f32x4 pacc[2], px; pacc[0] = pacc[1] = px = (f32x4){0.f, 0.f, 0.f, 0.f};
#pragma unroll
          for (int ks = 0; ks < 2; ++ks) if (ks == 0 || hi2) {
              pacc[0] = __builtin_amdgcn_mfma_f32_16x16x32_bf16(Vf[0][ks], Bp[ks], pacc[0], 0, 0, 0);
              pacc[1] = __builtin_amdgcn_mfma_f32_16x16x32_bf16(Vf[1][ks], Bp[ks], pacc[1], 0, 0, 0);
              if (TYPE == 1) px = __builtin_amdgcn_mfma_f32_16x16x32_bf16(ONES, Bp[ks], px, 0, 0, 0); }
#pragma unroll
          for (int et = 0; et < 4; ++et) Sacc[et] = Sacc[et] * dv;
          if (TYPE == 1) Sx = Sx * dv;
#pragma unroll
          for (int ks = 0; ks < 2; ++ks) {
#pragma unroll
              for (int et = 0; et < 4; ++et) Sacc[et] = __builtin_amdgcn_mfma_f32_16x16x32_bf16(Kd[ks], Vs[et][ks], Sacc[et], 0, 0, 0);
              if (TYPE == 1) Sx = __builtin_amdgcn_mfma_f32_16x16x32_bf16(Kd[ks], ONES, Sx, 0, 0, 0); }
          float rden = 1.f;
          if (TYPE == 1) { const float dn = px[0] + wi * dqv;
              rden = __builtin_amdgcn_rcpf(fmaxf(fabsf(dn), sem)); }
          bf16* orow = OUT + (size_t)SC_RLO(c) * 1024 + (unsigned)(SC_LR(t_) * 1024 + 4 * fq);
#pragma unroll
          for (int j = 0; j < 2; ++j) { f32x4 o;
              if (TYPE == 0) o = pacc[j] + oacc[j]; else o = (pacc[j] + oacc[j] * wi) * rden;
              u32x2 w; w.x = cvt2(o[0], o[1]); w.y = cvt2(o[2], o[3]);
              *(u32x2*)(orow + 16 * (c2 + j)) = w; }
#pragma unroll
          for (int et = 0; et < 4; ++et) { u32x2 w; w.x = cvt2(Sacc[et][0], Sacc[et][1]); w.y = cvt2(Sacc[et][2], Sacc[et][3]);
              *(u32x2*)(lds + O_ST + (16 * et + fr) * LQ + (16 * wave + 4 * fq) * 2) = w; }
          if (TYPE == 1) { u32x2 w; w.x = cvt2(Sx[0], Sx[1]); w.y = cvt2(Sx[2], Sx[3]);
              *(u32x2*)(lds + O_ST + (64 + fr) * LQ + (16 * wave + 4 * fq) * 2) = w; } }
        SC_BAR();
    }
#undef SC_LOAD
#undef SC_RLO
#undef SC_LR
#undef SC_S1A
}
}
constexpr int TAB_RS = 131072, TAB_LB = TAB_RS + 1024, TAB_BI = TAB_LB + 4096;
static_assert(TAB_BI + DIN * 4 <= LDSCTL_OFF, "epilogue tables");
__device__ __forceinline__ void stage_rstd(LAS unsigned char* lds, const float* SS, int pm, int tid) {
    if (tid < 256) { const float* p = SS + (size_t)(pm * 256 + tid) * 16;
        const f32x4 a0 = *(const f32x4*)p, a1 = *(const f32x4*)(p + 4), a2 = *(const f32x4*)(p + 8), a3 = *(const f32x4*)(p + 12);
        const f32x4 t = (a0 + a1) + (a2 + a3); const float sm = (t[0] + t[1]) + (t[2] + t[3]);
        ((LAS float*)(lds + TAB_RS))[tid] = __builtin_amdgcn_rsqf(sm * (1.0f / 1024.0f) + pg8::NORM_EPS); }
}
__device__ __forceinline__ void stage_bias_lb(LAS unsigned char* lds, const float* bias, const float* lb, int tid) {
    for (int i = tid; i < DIN / 4; i += NTHREADS) ((LAS f32x4*)(lds + TAB_BI))[i] = ((const f32x4*)bias)[i];
    if (tid < 256) ((LAS f32x4*)(lds + TAB_LB))[tid] = ((const f32x4*)lb)[tid];
}
#define PH_BEGIN KArgs ap = fresh_args(); const int tid = fresh_tid(wave_s), lane = tid & 63, wave = __builtin_amdgcn_readfirstlane(tid >> 6); \
    const int gw = (int)blockIdx.x * NWAVES + wave, ngw = G * NWAVES; unsigned char* ws = ap->ws; unsigned char* R = ws + WS_R; \
    (void)lane; (void)gw; (void)ngw; (void)R;
__global__ void __launch_bounds__(NTHREADS, 2) fwd_kernel(Args args_unused) {
    extern __shared__ __attribute__((aligned(16))) unsigned char lds[];
    const int G = gridDim.x;
    const int wave_s = __builtin_amdgcn_readfirstlane(threadIdx.x >> 6);
    { PH_BEGIN
      for (int u = tid; u < (LDS_BYTES - LDSCTL_OFF) / 4; u += NTHREADS) ((unsigned*)(lds + LDSCTL_OFF))[u] = 0u;
      __syncthreads();
      (void)xcd_barrier_post((unsigned*)(ws + WS_CTL) + CW_BAR, (volatile LAS unsigned*)(lds + MISC_OFF) + 8, tid);
      prologue(ap, lds, gw, ngw, wave, lane, tid);
      }
#define BAR_OBJ() XcdBarrier b_; b_.bar = (unsigned*)(fresh_args()->ws + WS_CTL) + CW_BAR; b_.x = xb_xcc_id(); b_.st = (volatile LAS unsigned*)(lds + MISC_OFF) + 8
#define GRID_BAR() do { BAR_OBJ(); xcd_barrier<false>(b_, fresh_tid(wave_s)); } while (0)
#define BATCH_BAR() do { BAR_OBJ(); if (uni) xcd_barrier<true>(b_, fresh_tid(wave_s)); else xcd_barrier<false>(b_, fresh_tid(wave_s)); } while (0)
#define RING ((PG8_LAS unsigned char*)lds)
constexpr int CW_GRP = 16384;
#define GROUP_SYNC(k) do { if (uni) { const int rk_ = vb >> 3; sc::head_sync<4>((unsigned*)(fresh_args()->ws + WS_CTL) + CW_GRP + 64 * ((((vb & 7) * 8 + (rk_ & 7)) * 2) + (k)), 0u, rk_ >> 3, (unsigned)(l + 1), 1, fresh_tid(wave_s), 1); } \
                           else BATCH_BAR(); } while (0)
    typedef pg8::bf16_t bt;
    GRID_BAR();
    int vb, uni;
    { volatile LAS unsigned* st_ = (volatile LAS unsigned*)(lds + MISC_OFF) + 8;
      uni = __builtin_amdgcn_readfirstlane((int)st_[2]);
      vb = uni ? __builtin_amdgcn_readfirstlane((int)(st_[3] * 8u + xb_xcc_id())) : (int)blockIdx.x; }
#pragma unroll 1
    for (int l = 0; l < DEPTH; ++l) {
        const size_t WOFF = (l & 1) ? WS_W2 : WS_W;
        { PH_BEGIN
          pg8::Gemm g = pg8::plain_gemm((const bt*)(ws + WS_XB), (const bt*)(ws + WOFF + WO_IN), DM, DM, DM); pg8::StaticOrder S; S.init(M / 256, DINP / 256, G, vb);
          {
              pg8::Unit u0; (void)S.next(0, u0);
              stage_rstd((LAS unsigned char*)lds, (const float*)(ws + WS_SS), u0.pm, tid); stage_bias_lb((LAS unsigned char*)lds, ap->in[I_BIN] + (size_t)l * DIN, (const float*)(ws + WS_LB) + l * 1024, tid);
              __syncthreads();
              pg8::EpiInProjL E{(const LAS float*)((LAS unsigned char*)lds + TAB_RS), (const LAS float*)((LAS unsigned char*)lds + TAB_BI), (const LAS float*)((LAS unsigned char*)lds + TAB_LB), R};
              pg8::gemm_phase<pg8::EpiInProjL, pg8::StaticOrder, true, true, 0>(RING, g, S, E, tid);
          } }
        if (l + 1 < DEPTH && G == 256 && vb >= 192) { PH_BEGIN convert_layer(ap, l + 1, lds, (vb - 192) * NWAVES + wave, 64 * NWAVES, wave, lane); }
        else if (l + 1 < DEPTH && G != 256) { PH_BEGIN convert_layer(ap, l + 1, lds, gw, ngw, wave, lane); }
        if (l == 0) {
            __syncthreads();
            if (uni) { PH_BEGIN
              pg8::Gemm g = pg8::plain_gemm((const bt*)((unsigned char*)ap->out + OT_MEMB), (const bt*)((unsigned char*)ap->out + OT_WKT), DM, DM, DM);
              pg8::OneUnit S; S.has = true; S.u.pm = vb & 7; S.u.pn = vb >> 3;
              pg8::EpiKV E{(bt*)(ws + WS_KX), (bt*)(ws + WS_VT)};
              pg8::gemm_phase<pg8::EpiKV, pg8::OneUnit, true, true, 0>(RING, g, S, E, tid); }
            else { PH_BEGIN
              pg8::Gemm g = pg8::plain_gemm((const bt*)((unsigned char*)ap->out + OT_MEMB), (const bt*)((unsigned char*)ap->out + OT_WKT), DM, DM, DM); pg8::StaticOrder S; S.init(MMEM / 256, 2 * DEPTH * DM / 256, G, (int)blockIdx.x);
              pg8::EpiKV E{(bt*)(ws + WS_KX), (bt*)(ws + WS_VT)};
              pg8::gemm_phase<pg8::EpiKV, pg8::StaticOrder, true, true, 0>(RING, g, S, E, tid); }
        }
        BATCH_BAR();
        { const int y_ = vb & 127, r_ = y_ >> 3; const int it_ = (r_ >> 3) * 64 + (y_ & 7) * 8 + ((r_ >> 1) & 3) * 2 + (r_ & 1);
          const int bb_ = (it_ >> 3) & 7, hh_ = (it_ >> 1) & 3, qi_ = ((it_ >> 6) & 1) * 2 + (it_ & 1);
          if (vb < 128) { { PH_BEGIN sc::mlstm_conv_part(ap, l, bb_, hh_, qi_, tid, uni); }
                 { PH_BEGIN sc::scan_item<0>(ap, l, it_, lds, tid, uni); }
                 { PH_BEGIN sc::mix_quarter(ap, l, 0, bb_, hh_, qi_, tid, uni); } }
          else { { PH_BEGIN sc::mlstm_conv_part(ap, l, bb_, hh_, 4 + qi_, tid, uni); }
                 { PH_BEGIN sc::scan_item<1>(ap, l, it_, lds, tid, uni); }
                 { PH_BEGIN sc::mix_quarter(ap, l, 1, bb_, hh_, qi_, tid, uni); } } }
        BATCH_BAR();
        { PH_BEGIN
          pg8::Gemm g; g.A = (const bt*)(ws + WS_KX) + (size_t)l * 32 * 65536; g.Bt = (const bt*)(ws + WOFF + WO_XQ); g.lda = 256; g.ldb = DM; g.K = 256; g.ajump = 0;
          g.am = (size_t)65536 * 2; g.am8 = 0; g.an3 = 0; g.bn = (size_t)256 * DM * 2; g.bm3 = 512; g.bm8 = 0;
          pg8::OneUnit S; S.has = (vb >> 3) < 16; S.u.pm = (vb & 7) * 4 + ((vb >> 5) & 3); S.u.pn = (vb >> 3) & 3;
          pg8::EpiRowBf16<2> E{nullptr, (bt*)(R + S_MT), DM, 2, (SLAB - 2 * MiB) / 2};
          pg8::gemm_phase<pg8::EpiRowBf16<2>, pg8::OneUnit, true, true, 0>(RING, g, S, E, tid); }
        { PH_BEGIN
          pg8::Gemm g; g.A = (const bt*)(ws + WOFF + WO_XO); g.Bt = (const bt*)(ws + WS_VT) + (size_t)l * 32 * 65536; g.lda = DM; g.ldb = 256; g.K = 256; g.ajump = 0;
          g.am = (size_t)256 * DM * 2; g.am8 = 0; g.an3 = 512; g.bn = (size_t)65536 * 2; g.bm3 = 0; g.bm8 = 0;
          pg8::OneUnit S; S.has = (vb >> 3) >= 16; S.u.pm = ((vb >> 3) - 16) >> 2; S.u.pn = (vb & 7) * 4 + ((vb >> 3) & 3);
          pg8::EpiNt E{(bt*)(R + S_NT)};
          pg8::gemm_phase<pg8::EpiNt, pg8::OneUnit, true, true, 0>(RING, g, S, E, tid); }
        { PH_BEGIN
          pg8::Gemm g = pg8::plain_gemm((const bt*)(R + S_GG), (const bt*)(ws + WOFF + WO_OUT), 512, DM, DM); g.ajump = (size_t)(S_MO - S_GG) - 1024; g.am8 = SLAB - 2 * MiB; pg8::StaticOrder S; S.init(M / 256, DM / 256, G, vb);
          pg8::EpiResid E{(bt*)(ws + WS_XB), (float*)(ws + WS_SS)};
          pg8::gemm_phase<pg8::EpiResid, pg8::StaticOrder, true, true, 2>(RING, g, S, E, tid); }
        BATCH_BAR();
        { PH_BEGIN
          pg8::Gemm g = pg8::plain_gemm((const bt*)(ws + WS_XB), (const bt*)(R + S_MT), DM, DM, DM); g.bm8 = SLAB; pg8::StaticOrder S; S.init(M / 256, 4, G, vb);
          { pg8::Unit u0; (void)S.next(0, u0);
              stage_rstd((LAS unsigned char*)lds, (const float*)(ws + WS_SS), u0.pm, tid); __syncthreads();
              pg8::EpiSoftmaxL E{(const LAS float*)((LAS unsigned char*)lds + TAB_RS), (bt*)(R + S_P)};
              pg8::gemm_phase<pg8::EpiSoftmaxL, pg8::StaticOrder, false, true, 0>(RING, g, S, E, tid);
          } }
        GROUP_SYNC(0);
        { PH_BEGIN
          pg8::Gemm g = pg8::plain_gemm((const bt*)(R + S_P), (const bt*)(R + S_NT), DM, DM, DM); g.am8 = SLAB - 4 * MiB; g.bm8 = SLAB; pg8::StaticOrder S; S.init(M / 256, DM / 256, G, vb);
          pg8::EpiResid E{(bt*)(ws + WS_XB), (float*)(ws + WS_SS)};
          pg8::gemm_phase<pg8::EpiResid, pg8::StaticOrder, true, true, 0>(RING, g, S, E, tid); }
        BATCH_BAR();
        { PH_BEGIN
          pg8::Gemm g = pg8::plain_gemm((const bt*)(ws + WS_XB), (const bt*)(ws + WOFF + WO_UP), DM, DM, DM); pg8::StaticOrder S; S.init(M / 256, DFF / 256, G, vb);
          { pg8::Unit u0; (void)S.next(0, u0);
              stage_rstd((LAS unsigned char*)lds, (const float*)(ws + WS_SS), u0.pm, tid); __syncthreads();
              pg8::EpiRowBf16<1, true> E{(const LAS float*)((LAS unsigned char*)lds + TAB_RS), (bt*)(R + S_H), DFF, 3, (SLAB - 16 * MiB) / 2};
              pg8::gemm_phase<pg8::EpiRowBf16<1, true>, pg8::StaticOrder, true, true, 0>(RING, g, S, E, tid);
          } }
        GROUP_SYNC(1);
        { PH_BEGIN
          pg8::Gemm g = pg8::plain_gemm((const bt*)(R + S_H), (const bt*)(ws + WOFF + WO_DOWN), DFF, DFF, DFF); g.am8 = SLAB - 16 * MiB; pg8::StaticOrder S; S.init(M / 256, DM / 256, G, vb);
          pg8::EpiResid E{(bt*)(ws + WS_XB), (float*)(ws + WS_SS)};
          pg8::gemm_phase<pg8::EpiResid, pg8::StaticOrder, true, true, 0>(RING, g, S, E, tid); }
        GRID_BAR();
    }
    { PH_BEGIN final_phase(ap, gw, ngw, lane); }
}

extern "C" void kernel_launch(void* const* d_in, const int* in_sizes, int n_in, void* d_out, int out_size, void* d_ws, size_t ws_size, hipStream_t stream) {
    static int grid = 0;
    if (grid == 0) {
        if (n_in != 20 || out_size != M * DM || ws_size < WS_END) { fprintf(stderr, "kernel_launch: unexpected shapes (n_in %d, out %d, ws %zu < %zu); nothing launched\n", n_in, out_size, ws_size, (size_t)WS_END); grid = -1; return; }
        int dev = 0, cus = 0;
        if (hipGetDevice(&dev) != hipSuccess || hipDeviceGetAttribute(&cus, hipDeviceAttributeMultiprocessorCount, dev) != hipSuccess) { grid = -1; return; }
        if (hipFuncSetAttribute((const void*)fwd_kernel, hipFuncAttributeMaxDynamicSharedMemorySize, LDS_BYTES) != hipSuccess) { fprintf(stderr, "kernel_launch: hipFuncSetAttribute failed\n"); grid = -1; return; }
        int occ = 0;
        if (hipOccupancyMaxActiveBlocksPerMultiprocessor(&occ, (const void*)fwd_kernel, NTHREADS, LDS_BYTES) != hipSuccess || occ < 1) { fprintf(stderr, "kernel_launch: occupancy query failed or zero\n"); grid = -1; return; }
        (void)hipGetLastError();
        grid = cus;
        if (grid != 256) { fprintf(stderr, "kernel_launch: %d CUs; this kernel is built for exactly 256 (one workgroup per CU); nothing launched\n", grid); grid = -1; return; }
    }
    if (grid < 0) return;
    if (hipMemsetAsync((char*)d_ws + WS_CTL, 0, CTL_ZERO_BYTES, stream) != hipSuccess) return;
    Args a{};
    for (int i = 0; i < 20; ++i) a.in[i] = (const float*)d_in[i];
    a.out = (float*)d_out; a.ws = (unsigned char*)d_ws;
    hipLaunchKernelGGL(fwd_kernel, dim3(grid), dim3(NTHREADS), LDS_BYTES, stream, a);
}
```

```cpp
#include <hip/hip_runtime.h>
#include <cstdio>
#include <cstdint>
namespace pg8 {
#define PG8_LAS __attribute__((address_space(3)))
typedef unsigned short bf16_t;
typedef short bf16x8 __attribute__((ext_vector_type(8)));
typedef float f32x4 __attribute__((ext_vector_type(4)));
typedef float f32x2 __attribute__((ext_vector_type(2)));
typedef unsigned u32x4 __attribute__((ext_vector_type(4)));
constexpr int WCS = 64, BJS = 32;
constexpr int BM = 256, BK = 64, HALF = 128, HTB = HALF * BK * 2  , STAGE_BYTES = 8 * HTB, NXCD = 8, WGM = 8;

__host__ __device__ __forceinline__ int lds_byte(int r, int c) { const int st = (r >> 4) * 2 + (c >> 5), rr = r & 15, cc = c & 31, ob = rr * 64 + cc * 2; return st * 1024 + (ob ^ (((ob >> 9) & 1) << 5)); }
__host__ __device__ __forceinline__ void stage_rc(int b, int& R, int& C) { const int st = b / 1024, sb = b % 1024, swz = sb ^ (((sb >> 9) & 1) << 5); R = (st >> 1) * 16 + swz / 64; C = (st & 1) * 32 + (swz % 64) / 2; }
__host__ __device__ __forceinline__ int perm32(int rho) { const int n = rho >> 4, i = rho & 15; return 8 * (i >> 2) + 4 * n + (i & 3); }

struct Unit { int pm, pn; };
struct Gemm { const bf16_t* A; const bf16_t* Bt; int lda, ldb, K; size_t ajump, am, am8, an3, bn, bm3, bm8; };
__device__ __forceinline__ Gemm plain_gemm(const bf16_t* A, const bf16_t* Bt, int lda, int ldb, int K) { Gemm g; g.A = A; g.Bt = Bt; g.lda = lda; g.ldb = ldb; g.K = K; g.ajump = 0; g.am = (size_t)512 * lda; g.am8 = 0; g.an3 = 0; g.bn = (size_t)512 * ldb; g.bm3 = 0; g.bm8 = 0; return g; }
template <int MODE> __device__ __forceinline__ const char* a_base(const Gemm& g, const Unit& u) { return (const char*)g.A + (size_t)u.pm * g.am + (size_t)(u.pm >> 3) * g.am8 + (size_t)(u.pn & 3) * g.an3; }
template <int MODE> __device__ __forceinline__ const char* b_base(const Gemm& g, const Unit& u) { return (const char*)g.Bt + (size_t)u.pn * g.bn + (size_t)(u.pm & 3) * g.bm3 + (size_t)(u.pm >> 3) * g.bm8; }

struct StaticOrder {
    int nM, nN, nwg, G, c;
    __host__ __device__ void init(int nM_, int nN_, int G_, int c_) { nM = nM_; nN = nN_; nwg = nM * nN; G = G_; c = c_; }
    __host__ __device__ bool next(int i, Unit& u) const {
        const long L = (long)i * G + c; if (L >= nwg) return false;
        int wgid = (int)L; { const int q = nwg / NXCD, r = nwg % NXCD, xcd = wgid % NXCD, off = wgid / NXCD; wgid = (xcd < r ? xcd * (q + 1) : r * (q + 1) + (xcd - r) * q) + off; }
        const int nig = WGM * nN, gid = wgid / nig, fm = gid * WGM, gsz = (nM - fm) < WGM ? (nM - fm) : WGM;
        u.pm = fm + ((wgid % nig) % gsz); u.pn = (wgid % nig) / gsz; return true;
    }
    __device__ __forceinline__ void a_ready(const Unit&) const {}
    __device__ __forceinline__ void done(const Unit&) const {}
};

struct OneUnit { Unit u; bool has;
    __device__ bool next(int i, Unit& o) const { if (i != 0 || !has) return false; o = u; return true; }
    __device__ __forceinline__ void a_ready(const Unit&) const {}
    __device__ __forceinline__ void done(const Unit&) const {}
};

typedef float f32x2_cv __attribute__((ext_vector_type(2)));
typedef __bf16 bf16x2_cv __attribute__((ext_vector_type(2)));
__device__ __forceinline__ unsigned cvt_pk_bf16(float lo, float hi) { const f32x2_cv v = {lo, hi}; const bf16x2_cv b = __builtin_convertvector(v, bf16x2_cv); return __builtin_bit_cast(unsigned, b); }
__device__ __forceinline__ u32x4 pack8(const f32x4 a, const f32x4 b) { u32x4 w; w.x = cvt_pk_bf16(a[0], a[1]); w.y = cvt_pk_bf16(a[2], a[3]); w.z = cvt_pk_bf16(b[0], b[1]); w.w = cvt_pk_bf16(b[2], b[3]); return w; }
constexpr float NORM_EPS = 1e-6f;
__device__ __forceinline__ float sx(float v, int k, int lane) { return __builtin_bit_cast(float, __builtin_amdgcn_ds_bpermute((lane ^ k) << 2, __builtin_bit_cast(int, v))); }
__device__ __forceinline__ float sx_up(float v, int o, int lane) { return __builtin_bit_cast(float, __builtin_amdgcn_ds_bpermute(((lane - o) & 63) << 2, __builtin_bit_cast(int, v))); }
__device__ __forceinline__ float sx_idx(float v, int src) { return __builtin_bit_cast(float, __builtin_amdgcn_ds_bpermute(src << 2, __builtin_bit_cast(int, v))); }
__device__ __forceinline__ float row_rstd(const float* SS, int row, int fq) {
    const f32x4 v = *(const f32x4*)(SS + (size_t)row * 16 + fq * 4);
    const int lane = fq * 16 + (row & 15);
    float s = (v[0] + v[1]) + (v[2] + v[3]); s += sx(s, 16, lane); s += sx(s, 32, lane);
    return __builtin_amdgcn_rsqf(s * (1.0f / 1024.0f) + NORM_EPS);
}
__device__ __forceinline__ void row_rstd8(const float* SS, int row0, int fr, int fq, float (&rs)[8]) {
    f32x4 v[8];
#pragma unroll
    for (int i = 0; i < 8; ++i) v[i] = *(const f32x4*)(SS + (size_t)(row0 + (i >> 2) * HALF + (i & 3) * 16) * 16 + fq * 4);
    const int lane = fq * 16 + fr; float s[8];
#pragma unroll
    for (int i = 0; i < 8; ++i) s[i] = (v[i][0] + v[i][1]) + (v[i][2] + v[i][3]);
#pragma unroll
    for (int i = 0; i < 8; ++i) s[i] += sx(s[i], 16, lane);
#pragma unroll
    for (int i = 0; i < 8; ++i) s[i] += sx(s[i], 32, lane);
#pragma unroll
    for (int i = 0; i < 8; ++i) rs[i] = __builtin_amdgcn_rsqf(s[i] * (1.0f / 1024.0f) + NORM_EPS);
    asm volatile("" : "+v"(rs[0]), "+v"(rs[1]), "+v"(rs[2]), "+v"(rs[3]), "+v"(rs[4]), "+v"(rs[5]), "+v"(rs[6]), "+v"(rs[7]));
    __builtin_amdgcn_sched_barrier(0);
}
__device__ __forceinline__ float logsig(float z) { return fminf(z, 0.f) - __logf(1.0f + __expf(-fabsf(z))); }
__device__ __forceinline__ float sigm(float z) { return __builtin_amdgcn_rcpf(1.0f + __expf(-z)); }

__device__ __forceinline__ f32x4 sel_acc(const f32x4 (&acc)[2][2][4][2], int ai, int bj, int m, int n) {
    f32x4 r = acc[0][bj][0][n];
#pragma unroll
    for (int a = 0; a < 2; ++a)
#pragma unroll
        for (int mm = 0; mm < 4; ++mm) if (a == ai && mm == m) r = acc[a][bj][mm][n];
    return r;
}
constexpr int MTOK = 16384;
constexpr size_t SL_MIB = 1u << 20, SLAB = 53 * (SL_MIB / 2);
constexpr size_t SL_GT = 14 * SL_MIB, SL_LF = SL_GT + SL_MIB / 4, SL_OF = SL_LF + 4 * SL_MIB, SL_OB = SL_OF + 4 * SL_MIB;
template <bool LT> struct TabPtr { typedef const float* type; };
template <> struct TabPtr<true> { typedef const PG8_LAS float* type; };
__device__ __forceinline__ f32x4 ld4(const float* p) { return *(const f32x4*)p; }
__device__ __forceinline__ f32x4 ld4(const PG8_LAS float* p) { return *(const PG8_LAS f32x4*)p; }
__device__ __forceinline__ void rstd8x(const float* SS, int pm, int row0, int fr, int fq, float (&rs)[8]) { (void)pm; row_rstd8(SS, row0, fr, fq, rs); }
__device__ __forceinline__ void rstd8x(const PG8_LAS float* RS, int pm, int row0, int fr, int fq, float (&rs)[8]) { (void)fr; (void)fq; const int lr0 = row0 - pm * BM;
#pragma unroll
    for (int i = 0; i < 8; ++i) rs[i] = RS[lr0 + (i >> 2) * HALF + (i & 3) * 16]; }
template <bool LT> struct EpiInProjT {
    static constexpr bool PERM = true, AFTER_DRAIN = false;
    static __device__ __forceinline__ bool stores16(const Unit& u) { return (u.pn >> 1) != 9; }
    typename TabPtr<LT>::type SS, bias, lb;
    unsigned char* RB;
    __device__ __forceinline__ void operator()(const f32x4 (&acc)[2][2][4][2], const Unit& u, int wr, int wc, int fr, int fq) const {
        const int seg = u.pn >> 1;
        const int row0 = u.pm * BM + wr * 64 + fr, lrow0 = (u.pm & 7) * BM + wr * 64 + fr;
        unsigned char* const SLB = RB + (size_t)(u.pm >> 3) * SLAB;
        const int cs0 = (u.pn & 1) * 256 + wc * WCS + 8 * fq;
        const int gc0 = u.pn * BM + wc * WCS + 8 * fq;
        if (seg == 9) {
            if (wc != 0) return;
            float rs8[8]; rstd8x(SS, u.pm, row0, fr, fq, rs8);
            f32x4 b0 = (f32x4){0.f, 0.f, 0.f, 0.f}, b1 = b0;
            if (fq < 2) { b0 = ld4(bias + gc0); b1 = ld4(bias + gc0 + 4); }
#pragma unroll
            for (int am = 0; am < 8; ++am) { const int ai = am >> 2, m = am & 3; const int lrow = lrow0 + ai * HALF + m * 16; const float rs = rs8[am]; float* const GATES = (float*)(SLB + SL_GT);
                f32x4 v0 = acc[ai][0][m][0] * rs + b0, v1 = acc[ai][0][m][1] * rs + b1;
                if (fq == 1) {
#pragma unroll
                    for (int j = 0; j < 4; ++j) { v0[j] = logsig(v0[j]); v1[j] = logsig(v1[j]); } }
                if (fq < 2) { *(f32x4*)(GATES + (size_t)lrow * 16 + 8 * fq) = v0; *(f32x4*)(GATES + (size_t)lrow * 16 + 8 * fq + 4) = v1; } }
            return;
        }
        f32x4 bv[2][2];
#pragma unroll
        for (int bj = 0; bj < 2; ++bj)
#pragma unroll
            for (int n = 0; n < 2; ++n) bv[bj][n] = ld4(bias + gc0 + bj * BJS + 4 * n);
        float rs8[8];
        if (seg == 1 || seg == 2) {
            f32x4 lv[2][2];
#pragma unroll
            for (int bj = 0; bj < 2; ++bj)
#pragma unroll
                for (int n = 0; n < 2; ++n) lv[bj][n] = ld4(lb + (seg - 1) * 512 + cs0 + bj * BJS + 4 * n);
            unsigned short* LFd = (unsigned short*)(SLB + SL_LF) + (size_t)(seg - 1) * 2048 * 512 + cs0;
            rstd8x(SS, u.pm, row0, fr, fq, rs8);
#pragma unroll
            for (int ai = 0; ai < 2; ++ai)
#pragma unroll
                for (int m = 0; m < 4; ++m) { const int row = row0 + ai * HALF + m * 16; const float rs = rs8[ai * 4 + m];
#pragma unroll
                    for (int bj = 0; bj < 2; ++bj) { f32x4 v0 = acc[ai][bj][m][0] * rs + bv[bj][0], v1 = acc[ai][bj][m][1] * rs + bv[bj][1];
#pragma unroll
                        for (int j = 0; j < 4; ++j) { const float a0 = lv[bj][0][j], a1 = lv[bj][1][j];
                            v0[j] = a0 + (1.f - a0) * sigm(fmaxf(v0[j], -80.f)); v1[j] = a1 + (1.f - a1) * sigm(fmaxf(v1[j], -80.f)); }
                        typedef _Float16 h2_t __attribute__((ext_vector_type(2))); u32x4 w;
                        w.x = __builtin_bit_cast(unsigned, (h2_t){(_Float16)v0[0], (_Float16)v0[1]}); w.y = __builtin_bit_cast(unsigned, (h2_t){(_Float16)v0[2], (_Float16)v0[3]});
                        w.z = __builtin_bit_cast(unsigned, (h2_t){(_Float16)v1[0], (_Float16)v1[1]}); w.w = __builtin_bit_cast(unsigned, (h2_t){(_Float16)v1[2], (_Float16)v1[3]});
                        *(u32x4*)(LFd + (size_t)(row - row0 + lrow0) * 512 + bj * BJS) = w; } }
            return;
        }
        const float ca = seg == 0 ? 0.f : 1.f, cb = 0.f, cc = seg == 0 ? 1.f : 0.f;
        bf16_t* dst = (bf16_t*)(SLB + ((size_t)(seg == 0 ? 0 : seg - 2) << 21)) + cs0;
        rstd8x(SS, u.pm, row0, fr, fq, rs8);
#pragma unroll
        for (int ai = 0; ai < 2; ++ai)
#pragma unroll
            for (int m = 0; m < 4; ++m) { const int row = row0 + ai * HALF + m * 16; const float rs = rs8[ai * 4 + m];
#pragma unroll
                for (int bj = 0; bj < 2; ++bj) { f32x4 v0 = acc[ai][bj][m][0] * rs + bv[bj][0], v1 = acc[ai][bj][m][1] * rs + bv[bj][1];
                    if (ca == 0.f) {
#pragma unroll
                        for (int j = 0; j < 4; ++j) { const float s0 = sigm(v0[j]), s1 = sigm(v1[j]); v0[j] = v0[j] * (cc * s0) + cb * s0; v1[j] = v1[j] * (cc * s1) + cb * s1; } }
                    *(u32x4*)(dst + (size_t)(row - row0 + lrow0) * 512 + bj * BJS) = pack8(v0, v1); } }
    }
};
typedef EpiInProjT<false> EpiInProj; typedef EpiInProjT<true> EpiInProjL;
struct EpiResid {
    static constexpr bool PERM = true, AFTER_DRAIN = false;
    static __device__ __forceinline__ bool stores16(const Unit&) { return false; }
    bf16_t* xb; float* SS;
    __device__ __forceinline__ void operator()(const f32x4 (&acc)[2][2][4][2], const Unit& u, int wr, int wc, int fr, int fq) const {
        const int row0 = u.pm * BM + wr * 64 + fr, col0 = u.pn * BM + wc * WCS + 8 * fq;
        u32x4 xo[2][4][2];
#pragma unroll
        for (int ai = 0; ai < 2; ++ai)
#pragma unroll
            for (int m = 0; m < 4; ++m)
#pragma unroll
                for (int bj = 0; bj < 2; ++bj) xo[ai][m][bj] = *(const u32x4*)(xb + (size_t)(row0 + ai * HALF + m * 16) * 1024 + col0 + bj * BJS);
        __builtin_amdgcn_sched_barrier(0);
        float sq8[8];
#pragma unroll
        for (int ai = 0; ai < 2; ++ai)
#pragma unroll
            for (int m = 0; m < 4; ++m) { const int row = row0 + ai * HALF + m * 16; float sq = 0.f;
#pragma unroll
                for (int bj = 0; bj < 2; ++bj) { const size_t o = (size_t)row * 1024 + col0 + bj * BJS;
                    const u32x4 xw = xo[ai][m][bj];
                    f32x4 a = (f32x4){__builtin_bit_cast(float, xw.x << 16), __builtin_bit_cast(float, xw.x & 0xffff0000u), __builtin_bit_cast(float, xw.y << 16), __builtin_bit_cast(float, xw.y & 0xffff0000u)};
                    f32x4 b = (f32x4){__builtin_bit_cast(float, xw.z << 16), __builtin_bit_cast(float, xw.z & 0xffff0000u), __builtin_bit_cast(float, xw.w << 16), __builtin_bit_cast(float, xw.w & 0xffff0000u)};
                    a = a + acc[ai][bj][m][0]; b = b + acc[ai][bj][m][1];
                    *(u32x4*)(xb + o) = pack8(a, b);
                    sq += (a[0] * a[0] + a[1] * a[1]) + (a[2] * a[2] + a[3] * a[3]) + (b[0] * b[0] + b[1] * b[1]) + (b[2] * b[2] + b[3] * b[3]); }
                sq8[ai * 4 + m] = sq; }
        const int lane = fq * 16 + fr;
#pragma unroll
        for (int i = 0; i < 8; ++i) sq8[i] += sx(sq8[i], 16, lane);
#pragma unroll
        for (int i = 0; i < 8; ++i) sq8[i] += sx(sq8[i], 32, lane);
#pragma unroll
        for (int i = 0; i < 8; ++i) if (fq == 0) SS[(size_t)(row0 + (i >> 2) * HALF + (i & 3) * 16) * 16 + u.pn * 4 + wc] = sq8[i];
    }
};
template <int ACT, bool LT = false> struct EpiRowBf16 {
    static constexpr bool PERM = true, AFTER_DRAIN = false;
    static __device__ __forceinline__ bool stores16(const Unit&) { return true; }
    typename TabPtr<LT>::type SS; bf16_t* O; int ldc; int bshift; size_t corr;
    __device__ __forceinline__ void operator()(const f32x4 (&acc)[2][2][4][2], const Unit& u, int wr, int wc, int fr, int fq) const {
        const int row0 = u.pm * BM + wr * 64 + fr, col0 = u.pn * BM + wc * WCS + 8 * fq;
        float rs8[8]; if (ACT != 2) rstd8x(SS, u.pm, row0, fr, fq, rs8);
#pragma unroll
        for (int ai = 0; ai < 2; ++ai)
#pragma unroll
            for (int m = 0; m < 4; ++m) { const int row = row0 + ai * HALF + m * 16; const float rs = ACT == 2 ? 1.f : rs8[ai * 4 + m];
#pragma unroll
                for (int bj = 0; bj < 2; ++bj) { f32x4 v0 = acc[ai][bj][m][0] * rs, v1 = acc[ai][bj][m][1] * rs;
                    if (ACT == 1) {
#pragma unroll
                        for (int j = 0; j < 4; ++j) { const float t0 = fmaxf(v0[j], 0.f), t1 = fmaxf(v1[j], 0.f); v0[j] = t0 * t0; v1[j] = t1 * t1; } }
                    *(u32x4*)(O + (size_t)row * ldc + (size_t)(u.pm >> bshift) * corr + col0 + bj * BJS) = pack8(v0, v1); } }
    }
};
struct EpiKV {
    static constexpr bool PERM = true, AFTER_DRAIN = false;
    static __device__ __forceinline__ bool stores16(const Unit&) { return false; }
    bf16_t* OK; bf16_t* OV;
    __device__ __forceinline__ void operator()(const f32x4 (&acc)[2][2][4][2], const Unit& u, int wr, int wc, int fr, int fq) const {
        const int pn = u.pn & 15; const int tile = ((pn >> 2) * 8 + u.pm) * 4 + (pn & 3);
        bf16_t* base = (u.pn >= 16 ? OV : OK) + (size_t)tile * 65536; const int r0 = wr * 64 + fr, c0 = wc * WCS + 8 * fq;
#pragma unroll
        for (int ai = 0; ai < 2; ++ai)
#pragma unroll
            for (int m = 0; m < 4; ++m)
#pragma unroll
                for (int bj = 0; bj < 2; ++bj) *(u32x4*)(base + (size_t)(r0 + ai * HALF + m * 16) * 256 + c0 + bj * BJS) = pack8(acc[ai][bj][m][0], acc[ai][bj][m][1]);
    }
};
struct EpiNt {
    static constexpr bool PERM = true, AFTER_DRAIN = false;
    static __device__ __forceinline__ bool stores16(const Unit&) { return false; }
    bf16_t* O;
    __device__ __forceinline__ void operator()(const f32x4 (&acc)[2][2][4][2], const Unit& u, int wr, int wc, int fr, int fq) const {
        bf16_t* base = O + (size_t)(u.pn >> 2) * (SLAB / 2) + (size_t)u.pm * 256 * 1024 + (u.pn & 3) * 256; const int r0 = wr * 64 + fr, c0 = wc * WCS + 8 * fq;
#pragma unroll
        for (int ai = 0; ai < 2; ++ai)
#pragma unroll
            for (int m = 0; m < 4; ++m)
#pragma unroll
                for (int bj = 0; bj < 2; ++bj) *(u32x4*)(base + (size_t)(r0 + ai * HALF + m * 16) * 1024 + c0 + bj * BJS) = pack8(acc[ai][bj][m][0], acc[ai][bj][m][1]);
    }
};
template <bool LT> struct EpiSoftmaxT {
    static constexpr bool PERM = true, AFTER_DRAIN = true;
    static __device__ __forceinline__ bool stores16(const Unit&) { return false; }
    typename TabPtr<LT>::type SS; bf16_t* P;
    __device__ __forceinline__ void fused(f32x4 (&acc)[2][2][4][2], const Unit& u, int wr, int wc, int fr, int fq, PG8_LAS unsigned char* lds, int wid, int lane) const {
        PG8_LAS f32x2* T = (PG8_LAS f32x2*)lds;
        float rs8[8]; rstd8x(SS, u.pm, u.pm * BM + wr * 64 + fr, fr, fq, rs8);
#pragma unroll
        for (int ai = 0; ai < 2; ++ai)
#pragma unroll
            for (int m = 0; m < 4; ++m) { const float rs = rs8[ai * 4 + m];
#pragma unroll
                for (int bj = 0; bj < 2; ++bj)
#pragma unroll
                    for (int n = 0; n < 2; ++n) acc[ai][bj][m][n] = acc[ai][bj][m][n] * rs;
                float mx = -3.0e38f;
#pragma unroll
                for (int bj = 0; bj < 2; ++bj)
#pragma unroll
                    for (int n = 0; n < 2; ++n) { const f32x4 x = acc[ai][bj][m][n]; mx = fmaxf(mx, fmaxf(fmaxf(x[0], x[1]), fmaxf(x[2], x[3]))); }
                mx = fmaxf(mx, sx(mx, 16, lane)); mx = fmaxf(mx, sx(mx, 32, lane));
                float s = 0.f;
#pragma unroll
                for (int bj = 0; bj < 2; ++bj)
#pragma unroll
                    for (int n = 0; n < 2; ++n) { const f32x4 x = acc[ai][bj][m][n]; s += (__expf(x[0] - mx) + __expf(x[1] - mx)) + (__expf(x[2] - mx) + __expf(x[3] - mx)); }
                s += sx(s, 16, lane); s += sx(s, 32, lane);
                if (fq == 0) T[(ai * HALF + wr * 64 + m * 16 + fr) * 4 + wc] = (f32x2){mx, s}; }
        asm volatile("s_waitcnt lgkmcnt(0)" ::: "memory"); __builtin_amdgcn_s_barrier(); asm volatile("" ::: "memory");
        const int row0 = u.pm * BM + wr * 64 + fr, col0 = u.pn * BM + wc * WCS + 8 * fq;
#pragma unroll
        for (int ai = 0; ai < 2; ++ai)
#pragma unroll
            for (int m = 0; m < 4; ++m) { const int r = ai * HALF + wr * 64 + m * 16 + fr;
                const f32x2 t0 = T[r * 4 + 0], t1 = T[r * 4 + 1], t2 = T[r * 4 + 2], t3 = T[r * 4 + 3];
                const float M = fmaxf(fmaxf(t0.x, t1.x), fmaxf(t2.x, t3.x));
                const float L = (t0.y * __expf(t0.x - M) + t1.y * __expf(t1.x - M)) + (t2.y * __expf(t2.x - M) + t3.y * __expf(t3.x - M));
                const float inv = __builtin_amdgcn_rcpf(L);
#pragma unroll
                for (int bj = 0; bj < 2; ++bj) { f32x4 v0 = acc[ai][bj][m][0], v1 = acc[ai][bj][m][1];
#pragma unroll
                    for (int j = 0; j < 4; ++j) { v0[j] = __expf(v0[j] - M) * inv; v1[j] = __expf(v1[j] - M) * inv; }
                    *(u32x4*)(P + (size_t)(u.pm >> 3) * ((SLAB - 4 * SL_MIB) / 2) + (size_t)(row0 + ai * HALF + m * 16) * 1024 + col0 + bj * BJS) = pack8(v0, v1); } }
    }
};
typedef EpiSoftmaxT<false> EpiSoftmax; typedef EpiSoftmaxT<true> EpiSoftmaxL;

template <class Epi, class Sched, bool ALIGN_EPI, bool SP2, int MODE>
__device__ __forceinline__ void gemm_phase(PG8_LAS unsigned char* lds, const Gemm g, const Sched& S, const Epi& E, const int tid) {
    const int wid = __builtin_amdgcn_readfirstlane(tid >> 6), lane = tid & 63, wr = wid >> 2, wc = wid & 3, fr = lane & 15, fq = lane >> 4;
    const int K = g.K, nt = K / BK;
    unsigned voffA[2], voffB[2];
#pragma unroll
    for (int i = 0; i < 2; ++i) { int R, C; stage_rc(tid * 16 + i * 8192, R, C); const int Rb = Epi::PERM ? ((R >> 5) * WCS + perm32(R & 31)) : R;
        voffA[i] = (unsigned)(R * g.lda + C) * 2u; voffB[i] = (unsigned)(Rb * g.ldb + C) * 2u; }
    const size_t kstep = (size_t)(BK * 2);
    const size_t hstepA = (size_t)HALF * g.lda * 2, hstepB = (size_t)(Epi::PERM ? BJS : HALF) * g.ldb * 2;
    const unsigned ldsw = (unsigned)wid * 1024u;
    const int aoff = lds_byte(wr * 64 + fr, fq * 8), boff = lds_byte(wc * 32 + fr, fq * 8);
#define PG8_SA(b, h) (((b) * 2 + (h)) * HTB)
#define PG8_SB(b, h) ((4 + (b) * 2 + (h)) * HTB)
#define PG8_STAGE(bufoff, gbase, voff) do { _Pragma("unroll") for (int _i = 0; _i < 2; ++_i) \
        __builtin_amdgcn_global_load_lds((const unsigned*)((const char*)(gbase) + (voff)[_i]), (PG8_LAS unsigned*)(lds + (bufoff) + ldsw + _i * 8192), 16, 0, 0); } while (0)
#define PG8_LDA(dst, b, h) do { _Pragma("unroll") for (int m = 0; m < 4; ++m) _Pragma("unroll") for (int k = 0; k < 2; ++k) dst[m][k] = *(const PG8_LAS bf16x8*)(lds + PG8_SA(b, h) + aoff + m * 2048 + k * 1024); } while (0)
#define PG8_LDB(dst, b, h) do { _Pragma("unroll") for (int n = 0; n < 2; ++n) _Pragma("unroll") for (int k = 0; k < 2; ++k) dst[n][k] = *(const PG8_LAS bf16x8*)(lds + PG8_SB(b, h) + boff + n * 2048 + k * 1024); } while (0)
#define PG8_MMA(ai, bj, At, Bt) do { __builtin_amdgcn_s_setprio(1); _Pragma("unroll") for (int m = 0; m < 4; ++m) _Pragma("unroll") for (int n = 0; n < 2; ++n) _Pragma("unroll") for (int k = 0; k < 2; ++k) \
        acc[ai][bj][m][n] = __builtin_amdgcn_mfma_f32_16x16x32_bf16(Bt[n][k], At[m][k], acc[ai][bj][m][n], 0, 0, 0); __builtin_amdgcn_s_setprio(0); } while (0)
#define PG8_WAIT_V(n) asm volatile("s_waitcnt vmcnt(" #n ")" ::: "memory")
#define PG8_WAIT_L(n) asm volatile("s_waitcnt lgkmcnt(" #n ")" ::: "memory")
#define PG8_WAIT_V8R(rx) asm volatile("s_cmp_eq_u32 %0, 0\n\ts_cbranch_scc1 .Lrxa%=\n\ts_waitcnt vmcnt(24)\n\ts_branch .Lrxb%=\n.Lrxa%=:\n\ts_waitcnt vmcnt(8)\n.Lrxb%=:" :: "s"(rx) : "memory", "scc")
#define PG8_BAR __builtin_amdgcn_s_barrier()
#define PG8_SCHED __builtin_amdgcn_sched_barrier(0)
    Unit cur, nxt; int ui = 0; bool relax = false;
    if (!S.next(0, cur)) return;
    f32x4 acc[2][2][4][2];
#pragma unroll
    for (int a = 0; a < 2; ++a)
#pragma unroll
        for (int b = 0; b < 2; ++b)
#pragma unroll
            for (int m = 0; m < 4; ++m)
#pragma unroll
                for (int n = 0; n < 2; ++n) acc[a][b][m][n] = (f32x4){0.f, 0.f, 0.f, 0.f};
    bf16x8 At[4][2], B0[2][2], B1[2][2];
    const char* cA = a_base<MODE>(g, cur); const char* cB = b_base<MODE>(g, cur);
    S.a_ready(cur);
    if constexpr (SP2) {
        PG8_STAGE(PG8_SB(0, 0), cB, voffB); PG8_STAGE(PG8_SB(0, 1), cB + hstepB, voffB); PG8_STAGE(PG8_SA(0, 0), cA, voffA); PG8_STAGE(PG8_SA(0, 1), cA + hstepA, voffA);
        if (wr == 1) PG8_BAR;
        PG8_WAIT_V(2); PG8_BAR;
        PG8_STAGE(PG8_SB(1, 0), cB + kstep, voffB); PG8_STAGE(PG8_SA(1, 0), cA + kstep, voffA); PG8_STAGE(PG8_SB(1, 1), cB + hstepB + kstep, voffB);
        PG8_WAIT_V(6); PG8_BAR;
    } else {
        PG8_STAGE(PG8_SB(0, 0), cB, voffB); PG8_STAGE(PG8_SA(0, 0), cA, voffA); PG8_STAGE(PG8_SB(0, 1), cB + hstepB, voffB); PG8_STAGE(PG8_SA(0, 1), cA + hstepA, voffA);
        if (wr == 1) PG8_BAR;
        PG8_WAIT_V(4); PG8_BAR;
        PG8_STAGE(PG8_SB(1, 0), cB + kstep, voffB); PG8_STAGE(PG8_SA(1, 0), cA + kstep, voffA); PG8_STAGE(PG8_SB(1, 1), cB + hstepB + kstep, voffB);
        PG8_WAIT_V(6); PG8_BAR;
    }
    for (;;) {
        const bool has_next = S.next(ui + 1, nxt);
        const char* nA = has_next ? a_base<MODE>(g, nxt) : cA; const char* nB = has_next ? b_base<MODE>(g, nxt) : cB;
        for (int t = 0; t < nt; t += 2) {
            const bool last = (t == nt - 2); const int rx = __builtin_amdgcn_readfirstlane((relax && t == 0) ? 1 : 0);
            const char* a1 = cA + (size_t)(t + 1) * kstep + ((MODE == 2 && t + 1 >= 8) ? g.ajump : (size_t)0);
            const char* a2 = last ? nA : cA + (size_t)(t + 2) * kstep + ((MODE == 2 && t + 2 >= 8) ? g.ajump : (size_t)0); const char* b2 = last ? nB : cB + (size_t)(t + 2) * kstep;
            const char* a3 = (MODE == 2 && !last) ? cA + (size_t)(t + 3) * kstep + ((t + 3 >= 8) ? g.ajump : (size_t)0) : a2 + kstep; const char* b3 = b2 + kstep;
            if (last && has_next) S.a_ready(nxt);
            if constexpr (SP2) {
            PG8_LDB(B0, 0, 0); PG8_LDB(B1, 0, 1); PG8_SCHED; PG8_LDA(At, 0, 0); PG8_STAGE(PG8_SA(1, 1), a1 + hstepA, voffA);
            PG8_WAIT_V8R(rx); PG8_WAIT_L(0); PG8_BAR; PG8_MMA(0, 0, At, B0); PG8_MMA(0, 1, At, B1); PG8_BAR; PG8_SCHED;
            PG8_LDA(At, 0, 1); PG8_STAGE(PG8_SB(0, 0), b2, voffB); PG8_STAGE(PG8_SB(0, 1), b2 + hstepB, voffB); PG8_STAGE(PG8_SA(0, 0), a2, voffA);
            PG8_WAIT_V8R(rx); PG8_WAIT_L(0); PG8_BAR; PG8_MMA(1, 0, At, B0); PG8_MMA(1, 1, At, B1); PG8_BAR; PG8_SCHED;
            PG8_LDB(B0, 1, 0); PG8_LDB(B1, 1, 1); PG8_SCHED; PG8_LDA(At, 1, 0); PG8_STAGE(PG8_SA(0, 1), a2 + hstepA, voffA);
            PG8_WAIT_V(8); PG8_WAIT_L(0); PG8_BAR; PG8_MMA(0, 0, At, B0); PG8_MMA(0, 1, At, B1); PG8_BAR; PG8_SCHED;
            PG8_LDA(At, 1, 1); PG8_STAGE(PG8_SB(1, 0), b3, voffB); PG8_STAGE(PG8_SB(1, 1), b3 + hstepB, voffB); PG8_STAGE(PG8_SA(1, 0), a3, voffA);
            PG8_WAIT_V(8); PG8_WAIT_L(0); PG8_BAR; PG8_MMA(1, 0, At, B0); PG8_MMA(1, 1, At, B1); PG8_BAR; PG8_SCHED;
            } else {
            PG8_LDB(B0, 0, 0); PG8_SCHED; PG8_LDA(At, 0, 0); PG8_STAGE(PG8_SA(1, 1), a1 + hstepA, voffA);
            PG8_WAIT_L(8); PG8_BAR; PG8_WAIT_L(0); PG8_MMA(0, 0, At, B0); PG8_BAR; PG8_SCHED;
            PG8_LDB(B1, 0, 1); PG8_STAGE(PG8_SB(0, 0), b2, voffB);
            PG8_BAR; PG8_WAIT_L(0); PG8_MMA(0, 1, At, B1); PG8_BAR;
            PG8_LDA(At, 0, 1); PG8_STAGE(PG8_SA(0, 0), a2, voffA);
            PG8_BAR; PG8_WAIT_L(0); PG8_MMA(1, 0, At, B0); PG8_BAR; PG8_SCHED;
            PG8_STAGE(PG8_SB(0, 1), b2 + hstepB, voffB);
            PG8_WAIT_V(6); PG8_BAR; PG8_MMA(1, 1, At, B1); PG8_BAR;
            PG8_LDB(B0, 1, 0); PG8_SCHED; PG8_LDA(At, 1, 0); PG8_STAGE(PG8_SA(0, 1), a2 + hstepA, voffA);
            PG8_WAIT_L(8); PG8_BAR; PG8_WAIT_L(0); PG8_MMA(0, 0, At, B0); PG8_BAR; PG8_SCHED;
            PG8_LDB(B1, 1, 1); PG8_STAGE(PG8_SB(1, 0), b3, voffB);
            PG8_BAR; PG8_WAIT_L(0); PG8_MMA(0, 1, At, B1); PG8_BAR;
            PG8_LDA(At, 1, 1); PG8_STAGE(PG8_SA(1, 0), a3, voffA);
            PG8_BAR; PG8_WAIT_L(0); PG8_MMA(1, 0, At, B0); PG8_BAR; PG8_SCHED;
            PG8_STAGE(PG8_SB(1, 1), b3 + hstepB, voffB);
            PG8_WAIT_V(6); PG8_BAR; PG8_MMA(1, 1, At, B1); PG8_BAR;
            }
        }
        if constexpr (ALIGN_EPI) { if (wr == 0) PG8_BAR; }
        if constexpr (!Epi::AFTER_DRAIN) { int l2; asm volatile("v_mbcnt_lo_u32_b32 %0, -1, 0\n\tv_mbcnt_hi_u32_b32 %0, -1, %0" : "=v"(l2));
            E(acc, cur, wr, wc, l2 & 15, l2 >> 4); S.done(cur); relax = SP2 && Epi::stores16(cur); }
        if (!has_next) break;
#pragma unroll
        for (int a = 0; a < 2; ++a)
#pragma unroll
            for (int b = 0; b < 2; ++b)
#pragma unroll
                for (int m = 0; m < 4; ++m)
#pragma unroll
                    for (int n = 0; n < 2; ++n) acc[a][b][m][n] = (f32x4){0.f, 0.f, 0.f, 0.f};
        cur = nxt; cA = nA; cB = nB; ++ui;
        if constexpr (ALIGN_EPI) { if (wr == 1) PG8_BAR; }
    }
    PG8_WAIT_V(0);
    if constexpr (!ALIGN_EPI) { if (wr == 0) PG8_BAR; }
    PG8_BAR;
    if constexpr (Epi::AFTER_DRAIN) { int l2; asm volatile("v_mbcnt_lo_u32_b32 %0, -1, 0\n\tv_mbcnt_hi_u32_b32 %0, -1, %0" : "=v"(l2)); E.fused(acc, cur, wr, wc, l2 & 15, l2 >> 4, lds, wid, l2); S.done(cur); }
#undef PG8_SA
#undef PG8_SB
#undef PG8_STAGE
#undef PG8_LDA
#undef PG8_LDB
#undef PG8_MMA
#undef PG8_WAIT_V
#undef PG8_WAIT_V8R
#undef PG8_WAIT_L
#undef PG8_BAR
#undef PG8_SCHED
}
}

constexpr int NWAVES = 8, NTHREADS = 512;
constexpr int DM = 1024, NB = 8, SEQ = 2048, DEPTH = 4, MEMLEN = 256, DIN = 4624, DINP = 4864, DFF = 4096;
constexpr int M = NB * SEQ;
constexpr int MMEM = NB * MEMLEN;

constexpr size_t MiB = 1u << 20;
constexpr size_t WS_CTL = 0, CTL_ZERO_BYTES = 1 * MiB;
constexpr size_t WS_SS = 2 * MiB;
constexpr size_t WS_LB = 3 * MiB;
constexpr size_t WS_W = 4 * MiB;
constexpr size_t WO_IN = 0, WO_OUT = 10 * MiB, WO_XQ = 12 * MiB, WO_XO = 14 * MiB, WO_UP = 16 * MiB, WO_DOWN = 24 * MiB;
constexpr size_t WS_KX = 36 * MiB, WS_VT = 52 * MiB;
constexpr size_t WS_XB = 68 * MiB;
constexpr size_t WS_R = 100 * MiB;
constexpr size_t SLAB = pg8::SLAB;
constexpr size_t S_QH = 0, S_VH = 2 * MiB, S_GG = 4 * MiB, S_MQ = 6 * MiB, S_MK = 8 * MiB, S_MV = 10 * MiB, S_MO = 12 * MiB,
                 S_GT = pg8::SL_GT, S_LF = pg8::SL_LF, S_OF = pg8::SL_OF, S_OB = pg8::SL_OB;
constexpr size_t S_P = 0, S_MT = S_MQ, S_NT = S_MK;
constexpr size_t S_H = 0;
constexpr size_t R_END = 8 * SLAB;
constexpr size_t OT_MEMB = 32 * MiB, OT_WKT = 36 * MiB, OT_WVT = 44 * MiB;
constexpr size_t WS_W2 = WS_R + R_END;
constexpr size_t WS_END = WS_W2 + 32 * MiB;
constexpr int CW_BAR = 4096;
constexpr int RING_BYTES = 131072, LDSCTL_OFF = 161792, MISC_OFF = LDSCTL_OFF + 320, LDS_BYTES = 163840;

#define GAS __attribute__((address_space(1)))
#define LAS __attribute__((address_space(3)))
typedef unsigned short bf16;
typedef unsigned v4u __attribute__((ext_vector_type(4)));
typedef float f32x4 __attribute__((ext_vector_type(4)));
#define LDS_WAIT() asm volatile("s_waitcnt lgkmcnt(0)" ::: "memory")
#define VM_WAIT() asm volatile("s_waitcnt vmcnt(0)" ::: "memory")
__device__ __forceinline__ unsigned f2bf(float f) { unsigned u = __builtin_bit_cast(unsigned, f); return (u + 0x7fffu + ((u >> 16) & 1u)) >> 16; }
__device__ __forceinline__ unsigned pk2(float lo, float hi) { return f2bf(lo) | (f2bf(hi) << 16); }
__device__ __forceinline__ float bf2f(unsigned short b) { return __builtin_bit_cast(float, (unsigned)b << 16); }
__device__ __forceinline__ float bflo(unsigned w) { return __builtin_bit_cast(float, w << 16); }
__device__ __forceinline__ float bfhi(unsigned w) { return __builtin_bit_cast(float, w & 0xffff0000u); }

#define XB_TMO      128
#define XB_XCNT(j)  (256  + 64 * (j))
#define XB_XSUB(j)  (1280 + 64 * (j))
#define XB_XGEN(j)  (2304 + 64 * (j))
#define XB_TOP      3328
#define XB_TOPGEN   3392
#define XCD_BAR_WORDS 3456
#define XB_LFLAG(j) (3456 + 64 * (j))
#define XB_SPIN_CAP (1u << 18)

__device__ __forceinline__ unsigned xb_ld(unsigned* p)              { return __hip_atomic_load(p, __ATOMIC_RELAXED, __HIP_MEMORY_SCOPE_AGENT); }
__device__ __forceinline__ unsigned xb_add(unsigned* p, unsigned v) { return __hip_atomic_fetch_add(p, v, __ATOMIC_RELAXED, __HIP_MEMORY_SCOPE_AGENT); }
__device__ __forceinline__ unsigned xb_xcc_id() { return (unsigned)__builtin_amdgcn_s_getreg((3 << 11) | 20) & 0xFu; }
#define XB_SPIN(cond, bar) do { unsigned _sp = 0; while (cond) { __builtin_amdgcn_s_sleep(1); \
    if ((++_sp & 255u) == 0u) { if (xb_ld(&(bar)[XB_TMO])) break; if (_sp > XB_SPIN_CAP) { atomicAdd(&(bar)[XB_TMO], 1u); break; } } } } while (0)

struct XcdBarrier {
    unsigned* bar; unsigned x;
    volatile LAS unsigned* st;
};

__device__ __forceinline__ XcdBarrier xcd_barrier_post(unsigned* bar, volatile LAS unsigned* st, int tid) {
    XcdBarrier b; b.bar = bar; b.x = xb_xcc_id(); b.st = st;
    if (tid == 0) st[3] = xb_add(&bar[XB_XCNT(b.x)], 1u);
    return b;
}
__device__ __forceinline__ void xcd_barrier_complete(unsigned* bar, unsigned x, unsigned& nloc, unsigned& nx, unsigned& uni) {
    const unsigned G = gridDim.x * gridDim.y * gridDim.z;
    unsigned sum, cnt, mine, sp = 0u;
    for (;;) {
        sum = 0u; cnt = 0u; mine = 0u; uni = 1u;
#pragma unroll
        for (unsigned j = 0; j < 16; ++j) { const unsigned c = xb_ld(&bar[XB_XCNT(j)]); sum += c; cnt += (c > 0u) ? 1u : 0u; mine = (j == x) ? c : mine; uni &= (c == (j < 8u ? 32u : 0u)) ? 1u : 0u; }
        if (sum == G) break;
        __builtin_amdgcn_s_sleep(1);
        if ((++sp & 255u) == 0u) { if (xb_ld(&bar[XB_TMO])) break; if (sp > XB_SPIN_CAP) { atomicAdd(&bar[XB_TMO], 1u); break; } }
    }
    nloc = mine > 0u ? mine : 1u; nx = cnt > 0u ? cnt : 1u; if (sum != G || G != 256u) uni = 0u;
}

template <bool LOCAL> __device__ __forceinline__ void xcd_barrier(const XcdBarrier& b, int tid) {
    if (LOCAL) {
        asm volatile("s_waitcnt vmcnt(0)" ::: "memory");
        __syncthreads();
        if (tid < 64) {
            unsigned* fl = b.bar + XB_LFLAG(b.x);
            const unsigned n = __builtin_amdgcn_readfirstlane(b.st[4]) + 1u;
            if (tid == 0) { b.st[4] = n; __hip_atomic_store(fl + b.st[3], n, __ATOMIC_RELAXED, __HIP_MEMORY_SCOPE_WORKGROUP); }
            unsigned sp = 0u;
            for (;;) { const unsigned v = tid < 32 ? xb_ld(fl + tid) : n;
                if (__builtin_amdgcn_ballot_w64(v < n) == 0ull) break;
                __builtin_amdgcn_s_sleep(1);
                if ((++sp & 255u) == 0u) { if (xb_ld(&b.bar[XB_TMO])) break; if (sp > XB_SPIN_CAP) { if (tid == 0) atomicAdd(&b.bar[XB_TMO], 1u); break; } } }
            __builtin_amdgcn_fence(__ATOMIC_ACQUIRE, "agent");
            asm volatile("s_waitcnt vmcnt(0)" ::: "memory");
        }
        __syncthreads();
        return;
    }
    asm volatile("s_waitcnt vmcnt(0)" ::: "memory");
    __syncthreads();
    if (tid == 0) {
        unsigned* bar = b.bar;
        __builtin_amdgcn_s_waitcnt(0);
        unsigned nloc = b.st[0], nx = b.st[1];
        if (nloc == 0u) { unsigned uni_; xcd_barrier_complete(bar, b.x, nloc, nx, uni_); b.st[0] = nloc; b.st[1] = nx; b.st[2] = uni_; }
        const unsigned old = xb_add(&bar[XB_XSUB(b.x)], 1u);
        const unsigned gen = old / nloc;
        if (old + 1u == (gen + 1u) * nloc) {
            __builtin_amdgcn_fence(__ATOMIC_RELEASE, "agent");
            asm volatile("s_waitcnt vmcnt(0)" ::: "memory");
            const unsigned og = xb_add(&bar[XB_TOP], 1u);
            const unsigned tg = og / nx;
            if (og + 1u == (tg + 1u) * nx) xb_add(&bar[XB_TOPGEN], 1u);
            else XB_SPIN(xb_ld(&bar[XB_TOPGEN]) == tg, bar);
            __builtin_amdgcn_fence(__ATOMIC_ACQUIRE, "agent");
            xb_add(&bar[XB_XGEN(b.x)], 1u);
            asm volatile("s_waitcnt vmcnt(0)" ::: "memory");
        } else {
            XB_SPIN(xb_ld(&bar[XB_XGEN(b.x)]) == gen, bar);
            __builtin_amdgcn_fence(__ATOMIC_ACQUIRE, "agent");
            asm volatile("s_waitcnt vmcnt(0)" ::: "memory");
        }
    }
    __syncthreads();
}

struct Args { const float* in[20]; float* out; unsigned char* ws; };
typedef const __attribute__((address_space(4))) Args* KArgs;
__device__ __forceinline__ KArgs fresh_args() { KArgs p = (KArgs)__builtin_amdgcn_kernarg_segment_ptr(); asm volatile("" : "+s"(p)); return p; }
__device__ __forceinline__ int fresh_tid(int wave_s) { int t; asm volatile("v_mbcnt_lo_u32_b32 %0, -1, 0\n\tv_mbcnt_hi_u32_b32 %0, -1, %0" : "=v"(t)); return (wave_s << 6) | t; }
enum { I_X = 0, I_MEM, I_NMIX, I_NXATTN, I_NMEM, I_NMLP, I_NFINAL, I_WIN, I_BIN, I_LBLOG, I_HNORM, I_CONVW, I_CONVB, I_MNORM, I_WOUT, I_WXQ, I_WXKV, I_WXO, I_WUP, I_WDOWN };

__device__ __forceinline__ float wave_sum(float v, int lane) {
#pragma unroll
    for (int o = 1; o < 64; o <<= 1) v += pg8::sx(v, o, lane);
    return v;
}
struct TDesc { const float* W; int ldw, nvalid; bf16* WT; int ldt; const float* g; float scale; int item, nblk; int useg; };
__device__ __forceinline__ void titem_load(const TDesc& d, int lane, float (&vv_)[32], f32x4 (&gv)[2]) {
    const int kb = d.item / d.nblk, nb = d.item % d.nblk, k0 = 64 * kb, n0 = 32 * nb; const int n = n0 + (lane & 31);
    const bool ok_ = n < d.nvalid; const float* wp_ = d.W + (size_t)(k0 + (lane >> 5)) * d.ldw + (ok_ ? n : 0);
#pragma unroll
    for (int i = 0; i < 32; ++i) vv_[i] = wp_[(size_t)(2 * i) * d.ldw];
    const float* gp = d.g + (k0 & 1023) + 8 * (lane & 7);
    gv[0] = *(const f32x4*)gp; gv[1] = *(const f32x4*)(gp + 4);
}
__device__ __forceinline__ void titem_store(const TDesc& d, float* scr, int lane, float (&vv_)[32], const f32x4 (&gv)[2]) {
    const int kb = d.item / d.nblk, nb = d.item % d.nblk, k0 = 64 * kb, n0 = 32 * nb; const int n = n0 + (lane & 31);
    const bool ok_ = n < d.nvalid;
#pragma unroll
    for (int i = 0; i < 32; ++i) { const int kk = 2 * i + (lane >> 5); const float v = ok_ ? vv_[i] * d.scale : 0.f;
        scr[kk * 33 + (lane & 31)] = v; }
    LDS_WAIT(); asm volatile("" ::: "memory");
    const int c = lane & 7; const f32x4 one4 = (f32x4){1.f, 1.f, 1.f, 1.f}; const f32x4 g0_ = d.useg ? gv[0] : one4, g1_ = d.useg ? gv[1] : one4;
#pragma unroll
    for (int j = 0; j < 4; ++j) { const int nn = (lane >> 3) + 8 * j; const float* s = scr + (8 * c) * 33 + nn;
        v4u o; o.x = pk2(s[0 * 33] * g0_[0], s[1 * 33] * g0_[1]); o.y = pk2(s[2 * 33] * g0_[2], s[3 * 33] * g0_[3]); o.z = pk2(s[4 * 33] * g1_[0], s[5 * 33] * g1_[1]); o.w = pk2(s[6 * 33] * g1_[2], s[7 * 33] * g1_[3]);
        *(v4u*)(d.WT + (size_t)(n0 + nn) * d.ldt + k0 + 8 * c) = o; }
    LDS_WAIT(); asm volatile("" ::: "memory");
}
template <class DF> __device__ __forceinline__ void titem_pipeline(DF df, int first, int step, int nit, float* scr, int lane) {
    float va[32], vb[32]; f32x4 ga[2], gb[2]; TDesc da, db; int it = first;
    if (it >= nit) return;
    da = df(it); titem_load(da, lane, va, ga);
    for (;;) {
        int nx = it + step; const bool hb = nx < nit;
        if (hb) { db = df(nx); titem_load(db, lane, vb, gb); }
        titem_store(da, scr, lane, va, ga);
        if (!hb) break;
        it = nx; nx = it + step; const bool ha = nx < nit;
        if (ha) { da = df(nx); titem_load(da, lane, va, ga); }
        titem_store(db, scr, lane, vb, gb);
        if (!ha) break;
        it = nx;
    }
}
__device__ __forceinline__ void convert_layer(KArgs a, int l, unsigned char* lds, int gw, int ngw, int wave, int lane) {
    float* scr = (float*)(lds + wave * 16384);
    bf16* W = (bf16*)(a->ws + ((l & 1) ? WS_W2 : WS_W));
    constexpr int I_A = 16 * (DINP / 32), I_B = 16 * 32, I_U = 16 * (DFF / 32), I_D = 64 * 32;
    constexpr int NIT = I_A + 2 * I_B + I_U + I_D;
    auto df = [=](int it) -> TDesc { int r = it; TDesc d;
        if (r < I_A) { d = TDesc{a->in[I_WIN] + (size_t)l * DM * DIN, DIN, DIN, W + WO_IN / 2, DM, a->in[I_NMIX] + l * DM, 1.f, r, DINP / 32, 1}; return d; } r -= I_A;
        if (r < I_B) { d = TDesc{a->in[I_WOUT] + (size_t)l * DM * DM, DM, DM, W + WO_OUT / 2, DM, a->in[I_NFINAL], 1.f, r, 32, 0}; return d; } r -= I_B;
        if (r < I_B) { d = TDesc{a->in[I_WXO] + (size_t)l * DM * DM, DM, DM, W + WO_XO / 2, DM, a->in[I_NFINAL], 1.f, r, 32, 0}; return d; } r -= I_B;
        if (r < I_U) { d = TDesc{a->in[I_WUP] + (size_t)l * DM * DFF, DFF, DFF, W + WO_UP / 2, DM, a->in[I_NMLP] + l * DM, 1.f, r, DFF / 32, 1}; return d; } r -= I_U;
        d = TDesc{a->in[I_WDOWN] + (size_t)l * DFF * DM, DM, DM, W + WO_DOWN / 2, DFF, a->in[I_NFINAL], 1.f, r, 32, 0}; return d; };
    titem_pipeline(df, gw, ngw, NIT, scr, lane);
    { const float* Wq = a->in[I_WXQ] + (size_t)l * DM * DM; const float* gq = a->in[I_NXATTN] + l * DM; bf16* O = W + WO_XQ / 2;
      for (int k = gw; k < DM; k += 2 * ngw) { const int k2 = k + ngw; const bool h2 = k2 < DM;
          f32x4 v0[4], v1[4];
#pragma unroll
          for (int j = 0; j < 4; ++j) { v0[j] = ((const f32x4*)(Wq + (size_t)k * DM) + lane)[64 * j]; v1[j] = h2 ? ((const f32x4*)(Wq + (size_t)k2 * DM) + lane)[64 * j] : (f32x4){0.f, 0.f, 0.f, 0.f}; }
          const float sc0 = gq[k] * 0.0625f, sc1 = h2 ? gq[k2] * 0.0625f : 0.f;
          unsigned long long* o0 = (unsigned long long*)(O + (size_t)k * DM) + lane; unsigned long long* o1 = (unsigned long long*)(O + (size_t)k2 * DM) + lane;
#pragma unroll
          for (int j = 0; j < 4; ++j) { const f32x4 v = v0[j] * sc0; o0[64 * j] = (unsigned long long)pk2(v[0], v[1]) | ((unsigned long long)pk2(v[2], v[3]) << 32); }
          if (h2) {
#pragma unroll
              for (int j = 0; j < 4; ++j) { const f32x4 v = v1[j] * sc1; o1[64 * j] = (unsigned long long)pk2(v[0], v[1]) | ((unsigned long long)pk2(v[2], v[3]) << 32); } } } }
}
__device__ __forceinline__ void prologue(KArgs a, unsigned char* lds, int gw, int ngw, int wave, int lane, int tid) {
    if (blockIdx.x == 0) { float* LB = (float*)(a->ws + WS_LB);
        for (int i = tid; i < 2 * 512; i += NTHREADS) { const int dir = i >> 9, c = i & 511; const float* lg = a->in[I_LBLOG] + (size_t)dir * DEPTH * 512 + c;
            const float l0 = lg[0], l1 = lg[512], l2 = lg[1024], l3 = lg[1536]; const float mx = fmaxf(fmaxf(l0, l1), fmaxf(l2, l3));
            const float e0 = expf(l0 - mx), e1 = expf(l1 - mx), e2 = expf(l2 - mx), e3 = expf(l3 - mx); const float inv = 1.f / (e0 + e1 + e2 + e3);
            LB[(0 * 2 + dir) * 512 + c] = 0.f; LB[(1 * 2 + dir) * 512 + c] = e1 * inv; LB[(2 * 2 + dir) * 512 + c] = (e1 + e2) * inv; LB[(3 * 2 + dir) * 512 + c] = (e1 + e2 + e3) * inv; } }
    { bf16* XB = (bf16*)(a->ws + WS_XB); float* SS = (float*)(a->ws + WS_SS); const float* x = a->in[I_X];
      for (int m0 = gw; m0 < M; m0 += 4 * ngw) { f32x4 v[4][4]; float s4[4];
#pragma unroll
          for (int r = 0; r < 4; ++r) { const int m = m0 + r * ngw; const int mm = m < M ? m : gw; const f32x4* xr = (const f32x4*)(x + (size_t)mm * DM) + lane;
#pragma unroll
              for (int j = 0; j < 4; ++j) v[r][j] = xr[64 * j]; }
#pragma unroll
          for (int r = 0; r < 4; ++r) { float s = 0.f;
#pragma unroll
              for (int j = 0; j < 4; ++j) s += (v[r][j][0] * v[r][j][0] + v[r][j][1] * v[r][j][1]) + (v[r][j][2] * v[r][j][2] + v[r][j][3] * v[r][j][3]);
              s4[r] = s; }
#pragma unroll
          for (int o_ = 1; o_ < 64; o_ <<= 1) {
#pragma unroll
              for (int r = 0; r < 4; ++r) s4[r] += pg8::sx(s4[r], o_, lane); }
          __builtin_amdgcn_sched_barrier(0);
#pragma unroll
          for (int r = 0; r < 4; ++r) { const int m = m0 + r * ngw; if (m >= M) break;
              unsigned long long* o8 = (unsigned long long*)(XB + (size_t)m * DM) + lane;
#pragma unroll
              for (int j = 0; j < 4; ++j) o8[64 * j] = (unsigned long long)pk2(v[r][j][0], v[r][j][1]) | ((unsigned long long)pk2(v[r][j][2], v[r][j][3]) << 32);
              if (lane < 16) SS[(size_t)m * 16 + lane] = lane == 0 ? s4[r] : 0.f; } } }
    { bf16* MB = (bf16*)((unsigned char*)a->out + OT_MEMB); const float* x = a->in[I_MEM];
      for (int m = gw; m < MMEM; m += ngw) { const f32x4* xr = (const f32x4*)(x + (size_t)m * DM) + lane; f32x4 v[4]; float s = 0.f;
#pragma unroll
          for (int j = 0; j < 4; ++j) { v[j] = xr[64 * j]; s += (v[j][0] * v[j][0] + v[j][1] * v[j][1]) + (v[j][2] * v[j][2] + v[j][3] * v[j][3]); }
          const float rs = 1.0f / sqrtf(wave_sum(s, lane) * (1.0f / DM) + 1e-6f);
          unsigned long long* o8 = (unsigned long long*)(MB + (size_t)m * DM) + lane;
#pragma unroll
          for (int j = 0; j < 4; ++j) o8[64 * j] = (unsigned long long)pk2(v[j][0] * rs, v[j][1] * rs) | ((unsigned long long)pk2(v[j][2] * rs, v[j][3] * rs) << 32); } }
    { float* scr = (float*)(lds + wave * 16384); bf16* WKT = (bf16*)((unsigned char*)a->out + OT_WKT); bf16* WVT = (bf16*)((unsigned char*)a->out + OT_WVT);
      auto df = [=](int it) -> TDesc { const int l = it >> 10, part = (it >> 9) & 1, r = it & 511;
          return TDesc{a->in[I_WXKV] + (size_t)l * DM * 2048 + part * 1024, 2048, 1024, (part ? WVT : WKT) + (size_t)l * 1024 * DM, DM, a->in[I_NMEM] + l * DM, 1.f, r, 32, 1}; };
      titem_pipeline(df, gw, ngw, DEPTH * 2 * 512, scr, lane); }
    convert_layer(a, 0, lds, gw, ngw, wave, lane);
}
__device__ __forceinline__ void final_phase(KArgs a, int gw, int ngw, int lane) {
    const float* g = a->in[I_NFINAL] + lane * 16; const bf16* XB = (const bf16*)(a->ws + WS_XB);
    f32x4 gg[4];
#pragma unroll
    for (int j = 0; j < 4; ++j) gg[j] = *(const f32x4*)(g + 4 * j);
    for (int m0 = gw; m0 < M; m0 += 8 * ngw) {
        v4u w0[8], w1[8]; float s8[8];
#pragma unroll
        for (int r = 0; r < 8; ++r) { const int m = m0 + r * ngw; const int mm = m < M ? m : gw;
            w0[r] = *(const v4u*)(XB + (size_t)mm * DM + lane * 16); w1[r] = *(const v4u*)(XB + (size_t)mm * DM + lane * 16 + 8); }
#pragma unroll
        for (int r = 0; r < 8; ++r) { float s = 0.f;
#pragma unroll
            for (int j = 0; j < 4; ++j) { const float a0 = bflo(w0[r][j]), a1 = bfhi(w0[r][j]), a2 = bflo(w1[r][j]), a3 = bfhi(w1[r][j]); s += (a0 * a0 + a1 * a1) + (a2 * a2 + a3 * a3); }
            s8[r] = s; }
#pragma unroll
        for (int o_ = 1; o_ < 64; o_ <<= 1) {
#pragma unroll
            for (int r = 0; r < 8; ++r) s8[r] += pg8::sx(s8[r], o_, lane); }
        __builtin_amdgcn_sched_barrier(0);
#pragma unroll
        for (int r = 0; r < 8; ++r) { const int m = m0 + r * ngw; if (m >= M) break;
            const float rs = 1.0f / sqrtf(s8[r] * (1.0f / DM) + 1e-6f);
            float x[16];
#pragma unroll
            for (int j = 0; j < 4; ++j) { x[2 * j] = bflo(w0[r][j]); x[2 * j + 1] = bfhi(w0[r][j]); x[8 + 2 * j] = bflo(w1[r][j]); x[8 + 2 * j + 1] = bfhi(w1[r][j]); }
            f32x4* o = (f32x4*)(a->out + (size_t)m * DM + lane * 16);
#pragma unroll
            for (int j = 0; j < 4; ++j) o[j] = (f32x4){x[4 * j] * rs * gg[j][0], x[4 * j + 1] * rs * gg[j][1], x[4 * j + 2] * rs * gg[j][2], x[4 * j + 3] * rs * gg[j][3]}; } }
}
namespace sc {
typedef short bf16x8 __attribute__((ext_vector_type(8)));
typedef float f32x4 __attribute__((ext_vector_type(4)));
typedef float f32x2 __attribute__((ext_vector_type(2)));
typedef unsigned u32x2 __attribute__((ext_vector_type(2)));
constexpr int LQ = 272, LS = 144;
constexpr int O_QS = 0, O_KS = O_QS + 64 * LQ, O_KDT = O_KS + 64 * LQ, O_VT = O_KDT + 128 * LS, O_KDT1 = O_VT + 64 * LS, O_VT1 = O_KDT1 + 128 * LS, O_P = O_VT1 + 64 * LS, O_ST = O_P + 64 * LS, O_SEG = O_ST + 80 * LQ,
              O_DEC = O_SEG + 4096, O_SCAL = O_DEC + 1024, O_NV = O_SCAL + 3072, O_PRE = O_NV + 1024, O_END = O_PRE + 3 * 32 * 64 * 4;
static_assert(O_END <= LDSCTL_OFF, "scan LDS map");
#define SC_BAR() do { __builtin_amdgcn_sched_barrier(0); asm volatile("s_waitcnt lgkmcnt(0)" ::: "memory"); __builtin_amdgcn_s_barrier(); asm volatile("" ::: "memory"); __builtin_amdgcn_sched_barrier(0); } while (0)
__device__ __forceinline__ bf16x8 frag(const unsigned char* base, int row, int pitch, int kbyte) { return *(const bf16x8*)(base + row * pitch + kbyte); }
__device__ __forceinline__ unsigned cvt2(float lo, float hi) { return pg8::cvt_pk_bf16(lo, hi); }
typedef _Float16 h2_t __attribute__((ext_vector_type(2)));
__device__ __forceinline__ f32x2 h2f(unsigned w) { return __builtin_convertvector(__builtin_bit_cast(h2_t, w), f32x2); }

constexpr int CW_CONV = 8192;
template <int NF> __device__ __forceinline__ void head_sync(unsigned* cnt, unsigned want, int slot, unsigned n, int mode, int tid, int uni);
__device__ __forceinline__ void mlstm_conv_part(KArgs a, int l, int b, int h, int part, int tid, int uni) {
    const int pair = tid & 127, which = pair >> 6, dp = pair & 63, rr = tid >> 7;
    unsigned char* R = a->ws + WS_R;
    const unsigned* src = (const unsigned*)((const bf16*)(R + (size_t)b * SLAB + (which ? S_MK : S_MQ)) + h * 128);
    unsigned* dst = (unsigned*)((bf16*)((unsigned char*)a->out + (which ? 16 * MiB : 0)) + h * 128) + (size_t)b * SEQ * 256;
    const float* cw = a->in[I_CONVW] + (size_t)l * 5 * 1024 + which * 512 + h * 128 + 2 * dp; const float* cb = a->in[I_CONVB] + (size_t)l * 1024 + which * 512 + h * 128 + 2 * dp;
    f32x2 w[5]; const f32x2 bias = *(const f32x2*)cb; const float sc = which ? 0.08838834764831845f : 1.0f;
#pragma unroll
    for (int j = 0; j < 5; ++j) w[j] = *(const f32x2*)(cw + j * 1024);
    const int t0 = 256 * part + 64 * rr;
    f32x2 x0, x1, x2, x3;
    { const unsigned z = 0u; const unsigned a0 = t0 >= 2 ? src[(size_t)(t0 - 2) * 256 + dp] : z, a1 = t0 >= 1 ? src[(size_t)(t0 - 1) * 256 + dp] : z, a2 = src[(size_t)t0 * 256 + dp], a3 = src[(size_t)(t0 + 1) * 256 + dp];
      x0 = (f32x2){bflo(a0), bfhi(a0)}; x1 = (f32x2){bflo(a1), bfhi(a1)}; x2 = (f32x2){bflo(a2), bfhi(a2)}; x3 = (f32x2){bflo(a3), bfhi(a3)}; }
    unsigned rawA[8], rawB[8];
#define CONV_LOAD(tb, raw) do { _Pragma("unroll") for (int i = 0; i < 8; ++i) { const int tn = t0 + (tb) + i + 2; raw[i] = src[(size_t)(tn < SEQ ? tn : SEQ - 1) * 256 + dp]; } } while (0)
#define CONV_FINISH(tb, raw) do { _Pragma("unroll") for (int i = 0; i < 8; ++i) { const int t = t0 + (tb) + i; const f32x2 x4 = (t + 2 < SEQ) ? (f32x2){bflo(raw[i]), bfhi(raw[i])} : (f32x2){0.f, 0.f}; \
            const f32x2 y = bias + w[0] * x0 + w[1] * x1 + w[2] * x2 + w[3] * x3 + w[4] * x4; \
            dst[(size_t)t * 256 + dp] = cvt2(y.x * pg8::sigm(y.x) * sc, y.y * pg8::sigm(y.y) * sc); \
            x0 = x1; x1 = x2; x2 = x3; x3 = x4; } } while (0)
    CONV_LOAD(0, rawA);
#pragma unroll
    for (int tb = 0; tb < 64; tb += 16) {
        CONV_LOAD(tb + 8, rawB); __builtin_amdgcn_sched_barrier(0);
        CONV_FINISH(tb, rawA); __builtin_amdgcn_sched_barrier(0);
        if (tb + 16 < 64) CONV_LOAD(tb + 16, rawA);
        __builtin_amdgcn_sched_barrier(0);
        CONV_FINISH(tb + 8, rawB); __builtin_amdgcn_sched_barrier(0);
    }
#undef CONV_LOAD
#undef CONV_FINISH
    head_sync<8>((unsigned*)(a->ws + WS_CTL) + CW_CONV + 64 * (4 * b + h), 8u * (unsigned)(l + 1), part, (unsigned)(l + 1), 0, tid, uni);
}

constexpr int CW_MIX = 12288;
template <int NF> __device__ __forceinline__ void head_sync(unsigned* cnt, unsigned want, int slot, unsigned n, int mode, int tid, int uni) {
    const bool post = mode != 2, wait = mode != 0;
    if (post) { asm volatile("s_waitcnt vmcnt(0)" ::: "memory"); __syncthreads(); }
    if (uni) {
        if (tid < 64) { unsigned* fl = cnt + 8;
            if (tid == 0 && post) __hip_atomic_store(fl + slot, n, __ATOMIC_RELAXED, __HIP_MEMORY_SCOPE_WORKGROUP);
            unsigned spins = 0;
            if (wait) for (;;) { const unsigned v = tid < NF ? __hip_atomic_load(fl + tid, __ATOMIC_RELAXED, __HIP_MEMORY_SCOPE_AGENT) : n;
                if (__builtin_amdgcn_ballot_w64(v < n) == 0ull) break;
                __builtin_amdgcn_s_sleep(1); if (++spins > (1u << 22)) break; }
            if (wait) { __builtin_amdgcn_fence(__ATOMIC_ACQUIRE, "agent"); asm volatile("s_waitcnt vmcnt(0)" ::: "memory"); } }
    } else if (tid == 0) { if (post) { __builtin_amdgcn_fence(__ATOMIC_RELEASE, "agent"); asm volatile("s_waitcnt vmcnt(0)" ::: "memory");
        __hip_atomic_fetch_add(cnt, 1u, __ATOMIC_RELAXED, __HIP_MEMORY_SCOPE_AGENT); } unsigned spins = 0;
        if (wait) { while (__hip_atomic_load(cnt, __ATOMIC_RELAXED, __HIP_MEMORY_SCOPE_AGENT) < want) { __builtin_amdgcn_s_sleep(2); if (++spins > (1u << 22)) break; }
            __builtin_amdgcn_fence(__ATOMIC_ACQUIRE, "agent"); asm volatile("s_waitcnt vmcnt(0)" ::: "memory"); } }
    __syncthreads();
}
__device__ __forceinline__ void mix_quarter(KArgs a, int l, int type, int b, int h, int qi, int tid, int uni) {
    head_sync<4>((unsigned*)(a->ws + WS_CTL) + CW_MIX + 64 * (32 * type + 4 * b + h), 4u * (unsigned)(l + 1), qi, (unsigned)(l + 1), 1, tid, uni);
    const int lane = tid & 63, wave = tid >> 6, c16 = (lane & 7) * 16;
    unsigned char* R = a->ws + WS_R;
    unsigned char* SLB = R + (size_t)b * SLAB;
    const bf16* OF = (const bf16*)(SLB + S_OF) + type * 512 + h * 128 + c16; const bf16* OB = (const bf16*)(SLB + S_OB) + type * 512 + h * 128 + c16;
    bf16* GD = (bf16*)(SLB + (type ? S_MO : S_GG)) + h * 128 + c16;
    const float* gn = a->in[type ? I_MNORM : I_HNORM] + l * 512 + h * 128 + c16;
    float g[16];
#pragma unroll
    for (int j = 0; j < 16; ++j) g[j] = gn[j];
    const size_t m0 = (size_t)(512 * qi + 8 * wave + (lane >> 3));
    v4u L[2][2][6];
#define MIX_LOAD(ps, d) do { const size_t m_ = m0 + 64 * (ps); d[0] = *(const v4u*)(OF + m_ * 1024); d[1] = *(const v4u*)(OF + m_ * 1024 + 8); d[2] = *(const v4u*)(OB + m_ * 1024); d[3] = *(const v4u*)(OB + m_ * 1024 + 8); \
        d[4] = *(const v4u*)(GD + m_ * 512); d[5] = *(const v4u*)(GD + m_ * 512 + 8); } while (0)
#define MIX_FINISH(ps, d) do { const size_t m_ = m0 + 64 * (ps); float o[16]; float s_ = 0.f; \
        _Pragma("unroll") for (int j = 0; j < 16; ++j) { const unsigned fw = j < 8 ? d[0][(j >> 1) & 3] : d[1][(j >> 1) & 3], bw = j < 8 ? d[2][(j >> 1) & 3] : d[3][(j >> 1) & 3]; \
            o[j] = ((j & 1) ? bfhi(fw) : bflo(fw)) + ((j & 1) ? bfhi(bw) : bflo(bw)); s_ += o[j] * o[j]; } \
        s_ += pg8::sx(s_, 1, lane); s_ += pg8::sx(s_, 2, lane); s_ += pg8::sx(s_, 4, lane); \
        const float rs = __builtin_amdgcn_rsqf(s_ * (1.0f / 128.0f) + 1e-6f); \
        v4u w0, w1; \
        _Pragma("unroll") for (int j = 0; j < 16; j += 2) { const unsigned gw2 = j < 8 ? d[4][(j >> 1) & 3] : d[5][(j >> 1) & 3]; \
            const float z0 = bflo(gw2), z1 = bfhi(gw2), s0_ = pg8::sigm(z0), s1_ = pg8::sigm(z1);                  \
            const unsigned pk = cvt2(o[j] * rs * g[j] * (type ? s0_ : z0 * s0_), o[j + 1] * rs * g[j + 1] * (type ? s1_ : z1 * s1_)); \
            if (j < 8) w0[(j >> 1) & 3] = pk; else w1[(j >> 1) & 3] = pk; } \
        *(v4u*)(GD + m_ * 512) = w0; *(v4u*)(GD + m_ * 512 + 8) = w1; } while (0)
    MIX_LOAD(0, L[0][0]); MIX_LOAD(1, L[0][1]);
#pragma unroll
    for (int p = 0; p < 4; ++p) {
        if (p + 1 < 4) { MIX_LOAD(2 * p + 2, L[(p + 1) & 1][0]); MIX_LOAD(2 * p + 3, L[(p + 1) & 1][1]); }
        __builtin_amdgcn_sched_barrier(0);
        MIX_FINISH(2 * p, L[p & 1][0]); MIX_FINISH(2 * p + 1, L[p & 1][1]);
        __builtin_amdgcn_sched_barrier(0);
    }
#undef MIX_LOAD
#undef MIX_FINISH
}

template <int TYPE> __device__ __forceinline__ void scan_s1b(unsigned char* lds, const int par, unsigned (&lfh)[8], unsigned (&qv)[8], unsigned (&kv)[8], unsigned (&vv)[4], const f32x2 cl7,
                                                        const int dp, const int rg, const int ep, const int sv, const f32x2* SEG, const float* SWKp) {
    const int okdt = par ? O_KDT1 : O_KDT, ovt = par ? O_VT1 : O_VT; float* DECp = (float*)(lds + O_DEC) + par * 128; (void)DECp; (void)SWKp; (void)cl7; (void)SEG;
    { asm volatile("" : "+v"(vv[0]), "+v"(vv[1]), "+v"(vv[2]), "+v"(vv[3]));
#pragma unroll
      for (int i = 0; i < 8; i += 4) { asm volatile("" : "+v"(qv[i]), "+v"(qv[i + 1]), "+v"(qv[i + 2]), "+v"(qv[i + 3])); if (TYPE == 1) asm volatile("" : "+v"(kv[i]), "+v"(kv[i + 1]), "+v"(kv[i + 2]), "+v"(kv[i + 3])); }
      unsigned kd0[4], kd1[4];
      if (TYPE == 0) { f32x2 pre = (f32x2){0.f, 0.f}, tot = pre;
#pragma unroll
          for (int j = 0; j < 8; ++j) { const f32x2 s_ = SEG[j * 64 + dp]; tot += s_; if (j < rg) pre += s_; }
          f32x2 f[8], kk[8];
#pragma unroll
          for (int i = 0; i < 8; ++i) { f[i] = h2f(lfh[i]); kk[i] = 1.0f - f[i]; }
          f32x2 E; E.x = __expf(pre.x); E.y = __expf(pre.y);
          f32x2 G; { const f32x2 ex = tot - (pre + cl7); G.x = __expf(ex.x); G.y = __expf(ex.y); }
          float kdx[8], kdy[8];
#pragma unroll
          for (int i = 7; i >= 0; --i) { const f32x2 kd = kk[i] * G; kdx[i] = kd.x; kdy[i] = kd.y; G = G * f[i]; }
#pragma unroll
          for (int i = 0; i < 8; ++i) { const int p = 8 * rg + i; E = E * f[i];
              const f32x2 qs = (f32x2){bflo(qv[i]), bfhi(qv[i])} * E;
              f32x2 ks; ks.x = kk[i].x * __builtin_amdgcn_rcpf(fmaxf(E.x, 1e-35f)); ks.y = kk[i].y * __builtin_amdgcn_rcpf(fmaxf(E.y, 1e-35f));
              *(unsigned*)(lds + O_QS + p * LQ + dp * 4) = cvt2(qs.x, qs.y);
              *(unsigned*)(lds + O_KS + p * LQ + dp * 4) = cvt2(ks.x, ks.y); }
#pragma unroll
          for (int i = 0; i < 4; ++i) { kd0[i] = cvt2(kdx[2 * i], kdx[2 * i + 1]); kd1[i] = cvt2(kdy[2 * i], kdy[2 * i + 1]); }
          if (rg == 0) { f32x2 dd; dd.x = __expf(tot.x); dd.y = __expf(tot.y); *(f32x2*)(DECp + 2 * dp) = dd; }
      } else {
          const f32x4 wk0 = *(const f32x4*)(SWKp + 8 * rg), wk1 = *(const f32x4*)(SWKp + 8 * rg + 4);
          float kdx[8], kdy[8];
#pragma unroll
          for (int i = 0; i < 8; ++i) { const int p = 8 * rg + i;
              *(unsigned*)(lds + O_QS + p * LQ + dp * 4) = qv[i];
              *(unsigned*)(lds + O_KS + p * LQ + dp * 4) = kv[i];
              const float w_ = i < 4 ? wk0[i & 3] : wk1[i & 3]; kdx[i] = bflo(kv[i]) * w_; kdy[i] = bfhi(kv[i]) * w_; }
#pragma unroll
          for (int i = 0; i < 4; ++i) { kd0[i] = cvt2(kdx[2 * i], kdx[2 * i + 1]); kd1[i] = cvt2(kdy[2 * i], kdy[2 * i + 1]); }
      }
      *(v4u*)(lds + okdt + (2 * dp) * LS + 16 * rg) = (v4u){kd0[0], kd0[1], kd0[2], kd0[3]};
      *(v4u*)(lds + okdt + (2 * dp + 1) * LS + 16 * rg) = (v4u){kd1[0], kd1[1], kd1[2], kd1[3]};
      u32x2 w0, w1; w0.x = (vv[0] & 0xffffu) | (vv[1] << 16); w0.y = (vv[2] & 0xffffu) | (vv[3] << 16); w1.x = (vv[0] >> 16) | (vv[1] & 0xffff0000u); w1.y = (vv[2] >> 16) | (vv[3] & 0xffff0000u);
      *(u32x2*)(lds + ovt + (2 * ep) * LS + 8 * sv) = w0; *(u32x2*)(lds + ovt + (2 * ep + 1) * LS + 8 * sv) = w1; }
}

template <int TYPE> __device__ __forceinline__ void scan_item(KArgs a, int l, int item, unsigned char* lds, int tid, int uni) {
    const int lane = tid & 63, wave = __builtin_amdgcn_readfirstlane(tid >> 6), fr = lane & 15, fq = lane >> 4;
    const int dir = (item >> 6) & 1, b = (item >> 3) & 7, h = (item >> 1) & 3, half = item & 1;
    unsigned char* R = a->ws + WS_R + (size_t)b * SLAB;
    bf16* OUT = (bf16*)(R + (dir ? S_OB : S_OF)) + TYPE * 512 + h * 128 + half * 64;
    const int dp = lane, rg = wave;
    const int ep = tid & 31, sv = tid >> 5;
    const int rstep = dir ? -1 : 1;
    const int row00 = dir ? SEQ - 1 : 0;
#define SC_RLO(c) (dir ? row00 - ((c) * 64 + 63) : row00 + (c) * 64)
#define SC_LR(p) (dir ? 63 - (p) : (p))
    unsigned lfh[2][8], qv[2][8], kv[2][8], vv[2][4];
    const unsigned* Qb = (const unsigned*)((const bf16*)(TYPE == 0 ? R + S_QH : (unsigned char*)a->out + (size_t)b * SEQ * 1024) + h * 128);
    const unsigned* Kb = (const unsigned*)((const bf16*)((unsigned char*)a->out + 16 * MiB + (size_t)b * SEQ * 1024) + h * 128);
    const unsigned* Vb = (const unsigned*)((const bf16*)(R + (TYPE == 0 ? S_VH : S_MV)) + h * 128 + half * 64);
    const unsigned* Lb = (const unsigned*)((const unsigned short*)(R + S_LF) + (size_t)dir * SEQ * 512 + h * 128);
    const float* GT = (const float*)(R + S_GT) + dir * 4 + h;
    const unsigned voffv = (unsigned)(SC_LR(4 * sv) * 256 + ep);
    const unsigned voffg = (unsigned)(SC_LR(lane) * 16);
    const __amdgpu_buffer_rsrc_t RQ_ = __builtin_amdgcn_make_buffer_rsrc((void*)Qb, 0, 0x7fffffff, 0x00020000), RK_ = __builtin_amdgcn_make_buffer_rsrc((void*)Kb, 0, 0x7fffffff, 0x00020000),
                                 RV_ = __builtin_amdgcn_make_buffer_rsrc((void*)Vb, 0, 0x7fffffff, 0x00020000), RL_ = __builtin_amdgcn_make_buffer_rsrc((void*)Lb, 0, 0x7fffffff, 0x00020000);
    const int dp4 = dp * 4, voffv4 = (int)voffv * 4;
#define SC_LOAD(c, u) do { int rlo_ = (int)SC_RLO(c); asm volatile("" : "+s"(rlo_));     \
        if (TYPE == 0) { _Pragma("unroll") for (int i = 0; i < 8; ++i) { const int so_ = (rlo_ + SC_LR(8 * rg + i)) * 1024; lfh[u][i] = __builtin_amdgcn_raw_buffer_load_b32(RL_, dp4, so_, 0); qv[u][i] = __builtin_amdgcn_raw_buffer_load_b32(RQ_, dp4, so_, 0); } } \
        else { _Pragma("unroll") for (int i = 0; i < 8; ++i) { const int so_ = (rlo_ + SC_LR(8 * rg + i)) * 1024; qv[u][i] = __builtin_amdgcn_raw_buffer_load_b32(RQ_, dp4, so_, 0); kv[u][i] = __builtin_amdgcn_raw_buffer_load_b32(RK_, dp4, so_, 0); } \
        } \
        _Pragma("unroll") for (int i = 0; i < 4; ++i) vv[u][i] = __builtin_amdgcn_raw_buffer_load_b32(RV_, voffv4 + rstep * i * 1024, rlo_ * 1024, 0); } while (0)
    f32x4 Sacc[4], Sx = (f32x4){0.f, 0.f, 0.f, 0.f};
#pragma unroll
    for (int et = 0; et < 4; ++et) Sacc[et] = (f32x4){0.f, 0.f, 0.f, 0.f};
    bf16x8 ONES; { const short o_ = (fr & 3) == 0 ? (short)0x3F80 : (short)0; ONES = (bf16x8){o_, o_, o_, o_, o_, o_, o_, o_}; }
    float m_prev = 0.f;
    for (int i = tid; i < 80 * LQ / 4; i += NTHREADS) ((unsigned*)(lds + O_ST))[i] = 0u;
    f32x2* SEG = (f32x2*)(lds + O_SEG); float* DEC = (float*)(lds + O_DEC); float* SCL = (float*)(lds + O_SCAL);
    float* PRE = (float*)(lds + O_PRE);
    if (TYPE == 1) {
        for (int cc = wave; cc < SEQ / 64; cc += NWAVES) { const long rl = SC_RLO(cc); const float gi_ = GT[rl * 16 + voffg], gf_ = GT[rl * 16 + voffg + 8];
            float cum = gf_;
#pragma unroll
            for (int o = 1; o < 64; o <<= 1) { const float t_ = pg8::sx_up(cum, o, lane); if (lane >= o) cum += t_; }
            const float bb = gi_ - cum; float pm = bb;
#pragma unroll
            for (int o = 1; o < 64; o <<= 1) { const float t_ = pg8::sx_up(pm, o, lane); if (lane >= o) pm = fmaxf(pm, t_); }
            PRE[cc * 64 + lane] = cum; PRE[2048 + cc * 64 + lane] = bb; PRE[4096 + cc * 64 + lane] = pm; } }
    if (TYPE == 1) head_sync<8>((unsigned*)(a->ws + WS_CTL) + CW_CONV + 64 * (4 * b + h), 8u * (unsigned)(l + 1), 0, (unsigned)(l + 1), 2, tid, uni);
    SC_LOAD(0, 0); SC_LOAD(1, 1);
    SC_BAR();
    f32x2 cl7 = (f32x2){0.f, 0.f};
#define SC_S1A(cn, u) do { if (TYPE == 0) { f32x2 p_ = (f32x2){1.f, 1.f}; _Pragma("unroll") for (int i = 0; i < 8; ++i) p_ = p_ * h2f(lfh[u][i]); f32x2 c_; c_.x = __logf(fmaxf(p_.x, 1e-37f)); c_.y = __logf(fmaxf(p_.y, 1e-37f)); cl7 = c_; SEG[rg * 64 + dp] = c_; } \
        else if (wave == 0) { const float cum = PRE[(cn) * 64 + lane], bb = PRE[2048 + (cn) * 64 + lane], pm = PRE[4096 + (cn) * 64 + lane], cum_last = PRE[(cn) * 64 + 63], pm_last = PRE[4096 + (cn) * 64 + 63]; \
            const float li = cum + m_prev, mt = fmaxf(cum + pm, li); \
            const float m_new = fmaxf(cum_last + m_prev, cum_last + pm_last); \
            float* W_ = SCL + ((cn) & 1) * 384; W_[lane] = cum - mt; W_[64 + lane] = bb; W_[128 + lane] = __expf(li - mt); W_[192 + lane] = __expf(-mt); W_[256 + lane] = __expf(cum_last + bb - m_new); if (lane == 0) W_[320] = __expf(cum_last + m_prev - m_new); \
            m_prev = m_new; } } while (0)
    SC_S1A(0, 0);
    SC_BAR();
    scan_s1b<TYPE>(lds, 0, lfh[0], qv[0], kv[0], vv[0], cl7, dp, rg, ep, sv, SEG, SCL + 256);
    SC_LOAD(2, 0);
    SC_BAR();
#pragma unroll 1
    for (int c0 = 0; c0 < SEQ / 64; c0 += 2)
#pragma unroll
    for (int u = 0; u < 2; ++u) { const int c = c0 + u;
        const float* SA = SCL + (c & 1) * 384; const float* SB = SA + 64; const float* SWI = SA + 128; const float* SEM = SA + 192; const float* SWK = SA + 256; const float* SCAR = SA + 320;
        (void)SB; (void)SWI; (void)SEM; (void)SWK; (void)SCAR;
        const int tt = wave >> 1, c2 = (wave & 1) * 2;
        f32x4 oacc[2]; float dqv = 0.f;
        const bool hi2 = tt >= 2;
        { f32x4 sacc[2]; sacc[0] = sacc[1] = oacc[0] = oacc[1] = (f32x4){0.f, 0.f, 0.f, 0.f};
          bf16x8 Bq[4], Ak[2][4], As[2][4], Ax[4];
#pragma unroll
          for (int ks = 0; ks < 4; ++ks) { const int kb = (32 * ks + 8 * fq) * 2; Bq[ks] = frag(lds + O_QS, 16 * tt + fr, LQ, kb);
#pragma unroll
              for (int j = 0; j < 2; ++j) { Ak[j][ks] = frag(lds + O_KS, 16 * (c2 + j) + fr, LQ, kb); As[j][ks] = frag(lds + O_ST, 16 * (c2 + j) + fr, LQ, kb); }
              if (TYPE == 1) Ax[ks] = frag(lds + O_ST, 64 + fr, LQ, kb); }
#pragma unroll
          for (int ks = 0; ks < 4; ++ks)
#pragma unroll
              for (int j = 0; j < 2; ++j) { sacc[j] = __builtin_amdgcn_mfma_f32_16x16x32_bf16(Ak[j][ks], Bq[ks], sacc[j], 0, 0, 0);
                                            oacc[j] = __builtin_amdgcn_mfma_f32_16x16x32_bf16(As[j][ks], Bq[ks], oacc[j], 0, 0, 0); }
          if (TYPE == 1) { f32x4 ox = (f32x4){0.f, 0.f, 0.f, 0.f};
#pragma unroll
              for (int ks = 0; ks < 4; ++ks) ox = __builtin_amdgcn_mfma_f32_16x16x32_bf16(Ax[ks], Bq[ks], ox, 0, 0, 0);
              dqv = ox[0]; }
          const int t_ = 16 * tt + fr; const float sa = TYPE == 1 ? SA[t_] : 0.f;
#pragma unroll
          for (int j = 0; j < 2; ++j) { const int s0 = 16 * (c2 + j) + 4 * fq; f32x4 pv = sacc[j];
              if (TYPE == 1) { const f32x4 sb = *(const f32x4*)(SB + s0);
#pragma unroll
                  for (int r = 0; r < 4; ++r) pv[r] *= __expf(fminf(sa + sb[r], 0.f)); }
#pragma unroll
              for (int r = 0; r < 4; ++r) pv[r] = (s0 + r <= t_) ? pv[r] : 0.f;
              u32x2 w; w.x = cvt2(pv[0], pv[1]); w.y = cvt2(pv[2], pv[3]);
              *(u32x2*)(lds + O_P + t_ * LS + s0 * 2) = w; } }
        if (c + 1 < SEQ / 64) SC_S1A(c + 1, u ^ 1);
        SC_BAR();
        { const int t_ = 16 * tt + fr;
          bf16x8 Bp[2], Vf[2][2], Vs[4][2], Kd[2];
#pragma unroll
          for (int ks = 0; ks < 2; ++ks) { const int kb = (32 * ks + 8 * fq) * 2; if (ks == 0 || hi2) { Bp[ks] = frag(lds + O_P, t_, LS, kb);
#pragma unroll
              for (int j = 0; j < 2; ++j) Vf[j][ks] = frag(lds + (u ? O_VT1 : O_VT), 16 * (c2 + j) + fr, LS, kb); } }
#pragma unroll
          for (int ks = 0; ks < 2; ++ks) { const int kb = (32 * ks + 8 * fq) * 2; Kd[ks] = frag(lds + (u ? O_KDT1 : O_KDT), 16 * wave + fr, LS, kb);
#pragma unroll
              for (int et = 0; et < 4; ++et) Vs[et][ks] = frag(lds + (u ? O_VT1 : O_VT), 16 * et + fr, LS, kb); }
          float wi = 1.f, sem = 0.f; f32x4 dv;
          if (TYPE == 0) dv = *(const f32x4*)(DEC + u * 128 + 16 * wave + 4 * fq); else { wi = SWI[t_]; sem = SEM[t_]; const float cr = SCAR[0]; dv = (f32x4){cr, cr, cr, cr}; }
          if (c + 1 < SEQ / 64) { scan_s1b<TYPE>(lds, u ^ 1, lfh[u ^ 1], qv[u ^ 1], kv[u ^ 1], vv[u ^ 1], cl7, dp, rg, ep, sv, SEG, SCL + (u ^ 1) * 384 + 256);
              if (c + 3 < SEQ / 64) SC_LOAD(c + 3, u ^ 1); }
          f32x4 pacc[2], px; pacc[0] = pacc[1] = px = (f32x4){0.f, 0.f, 0.f, 0.f};
#pragma unroll
          for (int ks = 0; ks < 2; ++ks) if (ks == 0 || hi2) {
              pacc[0] = __builtin_amdgcn_mfma_f32_16x16x32_bf16(Vf[0][ks], Bp[ks], pacc[0], 0, 0, 0);
              pacc[1] = __builtin_amdgcn_mfma_f32_16x16x32_bf16(Vf[1][ks], Bp[ks], pacc[1], 0, 0, 0);
              if (TYPE == 1) px = __builtin_amdgcn_mfma_f32_16x16x32_bf16(ONES, Bp[ks], px, 0, 0, 0); }
#pragma unroll
          for (int et = 0; et < 4; ++et) Sacc[et] = Sacc[et] * dv;
          if (TYPE == 1) Sx = Sx * dv;
#pragma unroll
          for (int ks = 0; ks < 2; ++ks) {
#pragma unroll
              for (int et = 0; et < 4; ++et) Sacc[et] = __builtin_amdgcn_mfma_f32_16x16x32_bf16(Kd[ks], Vs[et][ks], Sacc[et], 0, 0, 0);
              if (TYPE == 1) Sx = __builtin_amdgcn_mfma_f32_16x16x32_bf16(Kd[ks], ONES, Sx, 0, 0, 0); }
          float rden = 1.f;
          if (TYPE == 1) { const float dn = px[0] + wi * dqv;
              rden = __builtin_amdgcn_rcpf(fmaxf(fabsf(dn), sem)); }
          bf16* orow = OUT + (size_t)SC_RLO(c) * 1024 + (unsigned)(SC_LR(t_) * 1024 + 4 * fq);
#pragma unroll
          for (int j = 0; j < 2; ++j) { f32x4 o;
              if (TYPE == 0) o = pacc[j] + oacc[j]; else o = (pacc[j] + oacc[j] * wi) * rden;
              u32x2 w; w.x = cvt2(o[0], o[1]); w.y = cvt2(o[2], o[3]);
              *(u32x2*)(orow + 16 * (c2 + j)) = w; }
#pragma unroll
          for (int et = 0; et < 4; ++et) { u32x2 w; w.x = cvt2(Sacc[et][0], Sacc[et][1]); w.y = cvt2(Sacc[et][2], Sacc[et][3]);
              *(u32x2*)(lds + O_ST + (16 * et + fr) * LQ + (16 * wave + 4 * fq) * 2) = w; }
          if (TYPE == 1) { u32x2 w; w.x = cvt2(Sx[0], Sx[1]); w.y = cvt2(Sx[2], Sx[3]);
              *(u32x2*)(lds + O_ST + (64 + fr) * LQ + (16 * wave + 4 * fq) * 2) = w; } }
        SC_BAR();
    }
#undef SC_LOAD
#undef SC_RLO
#undef SC_LR
#undef SC_S1A
}
}
constexpr int TAB_RS = 131072, TAB_LB = TAB_RS + 1024, TAB_BI = TAB_LB + 4096;
static_assert(TAB_BI + DIN * 4 <= LDSCTL_OFF, "epilogue tables");
__device__ __forceinline__ void stage_rstd(LAS unsigned char* lds, const float* SS, int pm, int tid) {
    if (tid < 256) { const float* p = SS + (size_t)(pm * 256 + tid) * 16;
        const f32x4 a0 = *(const f32x4*)p, a1 = *(const f32x4*)(p + 4), a2 = *(const f32x4*)(p + 8), a3 = *(const f32x4*)(p + 12);
        const f32x4 t = (a0 + a1) + (a2 + a3); const float sm = (t[0] + t[1]) + (t[2] + t[3]);
        ((LAS float*)(lds + TAB_RS))[tid] = __builtin_amdgcn_rsqf(sm * (1.0f / 1024.0f) + pg8::NORM_EPS); }
}
__device__ __forceinline__ void stage_bias_lb(LAS unsigned char* lds, const float* bias, const float* lb, int tid) {
    for (int i = tid; i < DIN / 4; i += NTHREADS) ((LAS f32x4*)(lds + TAB_BI))[i] = ((const f32x4*)bias)[i];
    if (tid < 256) ((LAS f32x4*)(lds + TAB_LB))[tid] = ((const f32x4*)lb)[tid];
}
#define PH_BEGIN KArgs ap = fresh_args(); const int tid = fresh_tid(wave_s), lane = tid & 63, wave = __builtin_amdgcn_readfirstlane(tid >> 6); \
    const int gw = (int)blockIdx.x * NWAVES + wave, ngw = G * NWAVES; unsigned char* ws = ap->ws; unsigned char* R = ws + WS_R; \
    (void)lane; (void)gw; (void)ngw; (void)R;
__global__ void __launch_bounds__(NTHREADS, 2) fwd_kernel(Args args_unused) {
    extern __shared__ __attribute__((aligned(16))) unsigned char lds[];
    const int G = gridDim.x;
    const int wave_s = __builtin_amdgcn_readfirstlane(threadIdx.x >> 6);
    { PH_BEGIN
      for (int u = tid; u < (LDS_BYTES - LDSCTL_OFF) / 4; u += NTHREADS) ((unsigned*)(lds + LDSCTL_OFF))[u] = 0u;
      __syncthreads();
      (void)xcd_barrier_post((unsigned*)(ws + WS_CTL) + CW_BAR, (volatile LAS unsigned*)(lds + MISC_OFF) + 8, tid);
      prologue(ap, lds, gw, ngw, wave, lane, tid);
      }
#define BAR_OBJ() XcdBarrier b_; b_.bar = (unsigned*)(fresh_args()->ws + WS_CTL) + CW_BAR; b_.x = xb_xcc_id(); b_.st = (volatile LAS unsigned*)(lds + MISC_OFF) + 8
#define GRID_BAR() do { BAR_OBJ(); xcd_barrier<false>(b_, fresh_tid(wave_s)); } while (0)
#define BATCH_BAR() do { BAR_OBJ(); if (uni) xcd_barrier<true>(b_, fresh_tid(wave_s)); else xcd_barrier<false>(b_, fresh_tid(wave_s)); } while (0)
#define RING ((PG8_LAS unsigned char*)lds)
constexpr int CW_GRP = 16384;
#define GROUP_SYNC(k) do { if (uni) { const int rk_ = vb >> 3; sc::head_sync<4>((unsigned*)(fresh_args()->ws + WS_CTL) + CW_GRP + 64 * ((((vb & 7) * 8 + (rk_ & 7)) * 2) + (k)), 0u, rk_ >> 3, (unsigned)(l + 1), 1, fresh_tid(wave_s), 1); } \
                           else BATCH_BAR(); } while (0)
    typedef pg8::bf16_t bt;
    GRID_BAR();
    int vb, uni;
    { volatile LAS unsigned* st_ = (volatile LAS unsigned*)(lds + MISC_OFF) + 8;
      uni = __builtin_amdgcn_readfirstlane((int)st_[2]);
      vb = uni ? __builtin_amdgcn_readfirstlane((int)(st_[3] * 8u + xb_xcc_id())) : (int)blockIdx.x; }
#pragma unroll 1
    for (int l = 0; l < DEPTH; ++l) {
        const size_t WOFF = (l & 1) ? WS_W2 : WS_W;
        { PH_BEGIN
          pg8::Gemm g = pg8::plain_gemm((const bt*)(ws + WS_XB), (const bt*)(ws + WOFF + WO_IN), DM, DM, DM); pg8::StaticOrder S; S.init(M / 256, DINP / 256, G, vb);
          {
              pg8::Unit u0; (void)S.next(0, u0);
              stage_rstd((LAS unsigned char*)lds, (const float*)(ws + WS_SS), u0.pm, tid); stage_bias_lb((LAS unsigned char*)lds, ap->in[I_BIN] + (size_t)l * DIN, (const float*)(ws + WS_LB) + l * 1024, tid);
              __syncthreads();
              pg8::EpiInProjL E{(const LAS float*)((LAS unsigned char*)lds + TAB_RS), (const LAS float*)((LAS unsigned char*)lds + TAB_BI), (const LAS float*)((LAS unsigned char*)lds + TAB_LB), R};
              pg8::gemm_phase<pg8::EpiInProjL, pg8::StaticOrder, true, true, 0>(RING, g, S, E, tid);
          } }
        if (l + 1 < DEPTH && G == 256 && vb >= 192) { PH_BEGIN convert_layer(ap, l + 1, lds, (vb - 192) * NWAVES + wave, 64 * NWAVES, wave, lane); }
        else if (l + 1 < DEPTH && G != 256) { PH_BEGIN convert_layer(ap, l + 1, lds, gw, ngw, wave, lane); }
        if (l == 0) {
            __syncthreads();
            if (uni) { PH_BEGIN
              pg8::Gemm g = pg8::plain_gemm((const bt*)((unsigned char*)ap->out + OT_MEMB), (const bt*)((unsigned char*)ap->out + OT_WKT), DM, DM, DM);
              pg8::OneUnit S; S.has = true; S.u.pm = vb & 7; S.u.pn = vb >> 3;
              pg8::EpiKV E{(bt*)(ws + WS_KX), (bt*)(ws + WS_VT)};
              pg8::gemm_phase<pg8::EpiKV, pg8::OneUnit, true, true, 0>(RING, g, S, E, tid); }
            else { PH_BEGIN
              pg8::Gemm g = pg8::plain_gemm((const bt*)((unsigned char*)ap->out + OT_MEMB), (const bt*)((unsigned char*)ap->out + OT_WKT), DM, DM, DM); pg8::StaticOrder S; S.init(MMEM / 256, 2 * DEPTH * DM / 256, G, (int)blockIdx.x);
              pg8::EpiKV E{(bt*)(ws + WS_KX), (bt*)(ws + WS_VT)};
              pg8::gemm_phase<pg8::EpiKV, pg8::StaticOrder, true, true, 0>(RING, g, S, E, tid); }
        }
        BATCH_BAR();
        { const int y_ = vb & 127, r_ = y_ >> 3; const int it_ = (r_ >> 3) * 64 + (y_ & 7) * 8 + ((r_ >> 1) & 3) * 2 + (r_ & 1);
          const int bb_ = (it_ >> 3) & 7, hh_ = (it_ >> 1) & 3, qi_ = ((it_ >> 6) & 1) * 2 + (it_ & 1);
          if (vb < 128) { { PH_BEGIN sc::mlstm_conv_part(ap, l, bb_, hh_, qi_, tid, uni); }
                 { PH_BEGIN sc::scan_item<0>(ap, l, it_, lds, tid, uni); }
                 { PH_BEGIN sc::mix_quarter(ap, l, 0, bb_, hh_, qi_, tid, uni); } }
          else { { PH_BEGIN sc::mlstm_conv_part(ap, l, bb_, hh_, 4 + qi_, tid, uni); }
                 { PH_BEGIN sc::scan_item<1>(ap, l, it_, lds, tid, uni); }
                 { PH_BEGIN sc::mix_quarter(ap, l, 1, bb_, hh_, qi_, tid, uni); } } }
        BATCH_BAR();
        { PH_BEGIN
          pg8::Gemm g; g.A = (const bt*)(ws + WS_KX) + (size_t)l * 32 * 65536; g.Bt = (const bt*)(ws + WOFF + WO_XQ); g.lda = 256; g.ldb = DM; g.K = 256; g.ajump = 0;
          g.am = (size_t)65536 * 2; g.am8 = 0; g.an3 = 0; g.bn = (size_t)256 * DM * 2; g.bm3 = 512; g.bm8 = 0;
          pg8::OneUnit S; S.has = (vb >> 3) < 16; S.u.pm = (vb & 7) * 4 + ((vb >> 5) & 3); S.u.pn = (vb >> 3) & 3;
          pg8::EpiRowBf16<2> E{nullptr, (bt*)(R + S_MT), DM, 2, (SLAB - 2 * MiB) / 2};
          pg8::gemm_phase<pg8::EpiRowBf16<2>, pg8::OneUnit, true, true, 0>(RING, g, S, E, tid); }
        { PH_BEGIN
          pg8::Gemm g; g.A = (const bt*)(ws + WOFF + WO_XO); g.Bt = (const bt*)(ws + WS_VT) + (size_t)l * 32 * 65536; g.lda = DM; g.ldb = 256; g.K = 256; g.ajump = 0;
          g.am = (size_t)256 * DM * 2; g.am8 = 0; g.an3 = 512; g.bn = (size_t)65536 * 2; g.bm3 = 0; g.bm8 = 0;
          pg8::OneUnit S; S.has = (vb >> 3) >= 16; S.u.pm = ((vb >> 3) - 16) >> 2; S.u.pn = (vb & 7) * 4 + ((vb >> 3) & 3);
          pg8::EpiNt E{(bt*)(R + S_NT)};
          pg8::gemm_phase<pg8::EpiNt, pg8::OneUnit, true, true, 0>(RING, g, S, E, tid); }
        { PH_BEGIN
          pg8::Gemm g = pg8::plain_gemm((const bt*)(R + S_GG), (const bt*)(ws + WOFF + WO_OUT), 512, DM, DM); g.ajump = (size_t)(S_MO - S_GG) - 1024; g.am8 = SLAB - 2 * MiB; pg8::StaticOrder S; S.init(M / 256, DM / 256, G, vb);
          pg8::EpiResid E{(bt*)(ws + WS_XB), (float*)(ws + WS_SS)};
          pg8::gemm_phase<pg8::EpiResid, pg8::StaticOrder, true, true, 2>(RING, g, S, E, tid); }
        BATCH_BAR();
        { PH_BEGIN
          pg8::Gemm g = pg8::plain_gemm((const bt*)(ws + WS_XB), (const bt*)(R + S_MT), DM, DM, DM); g.bm8 = SLAB; pg8::StaticOrder S; S.init(M / 256, 4, G, vb);
          { pg8::Unit u0; (void)S.next(0, u0);
              stage_rstd((LAS unsigned char*)lds, (const float*)(ws + WS_SS), u0.pm, tid); __syncthreads();
              pg8::EpiSoftmaxL E{(const LAS float*)((LAS unsigned char*)lds + TAB_RS), (bt*)(R + S_P)};
              pg8::gemm_phase<pg8::EpiSoftmaxL, pg8::StaticOrder, false, true, 0>(RING, g, S, E, tid);
          } }
        GROUP_SYNC(0);
        { PH_BEGIN
          pg8::Gemm g = pg8::plain_gemm((const bt*)(R + S_P), (const bt*)(R + S_NT), DM, DM, DM); g.am8 = SLAB - 4 * MiB; g.bm8 = SLAB; pg8::StaticOrder S; S.init(M / 256, DM / 256, G, vb);
          pg8::EpiResid E{(bt*)(ws + WS_XB), (float*)(ws + WS_SS)};
          pg8::gemm_phase<pg8::EpiResid, pg8::StaticOrder, true, true, 0>(RING, g, S, E, tid); }
        BATCH_BAR();
        { PH_BEGIN
          pg8::Gemm g = pg8::plain_gemm((const bt*)(ws + WS_XB), (const bt*)(ws + WOFF + WO_UP), DM, DM, DM); pg8::StaticOrder S; S.init(M / 256, DFF / 256, G, vb);
          { pg8::Unit u0; (void)S.next(0, u0);
              stage_rstd((LAS unsigned char*)lds, (const float*)(ws + WS_SS), u0.pm, tid); __syncthreads();
              pg8::EpiRowBf16<1, true> E{(const LAS float*)((LAS unsigned char*)lds + TAB_RS), (bt*)(R + S_H), DFF, 3, (SLAB - 16 * MiB) / 2};
              pg8::gemm_phase<pg8::EpiRowBf16<1, true>, pg8::StaticOrder, true, true, 0>(RING, g, S, E, tid);
          } }
        GROUP_SYNC(1);
        { PH_BEGIN
          pg8::Gemm g = pg8::plain_gemm((const bt*)(R + S_H), (const bt*)(ws + WOFF + WO_DOWN), DFF, DFF, DFF); g.am8 = SLAB - 16 * MiB; pg8::StaticOrder S; S.init(M / 256, DM / 256, G, vb);
          pg8::EpiResid E{(bt*)(ws + WS_XB), (float*)(ws + WS_SS)};
          pg8::gemm_phase<pg8::EpiResid, pg8::StaticOrder, true, true, 0>(RING, g, S, E, tid); }
        GRID_BAR();
    }
    { PH_BEGIN final_phase(ap, gw, ngw, lane); }
}

extern "C" void kernel_launch(void* const* d_in, const int* in_sizes, int n_in, void* d_out, int out_size, void* d_ws, size_t ws_size, hipStream_t stream) {
    static int grid = 0;
    if (grid == 0) {
        if (n_in != 20 || out_size != M * DM || ws_size < WS_END) { fprintf(stderr, "kernel_launch: unexpected shapes (n_in %d, out %d, ws %zu < %zu); nothing launched\n", n_in, out_size, ws_size, (size_t)WS_END); grid = -1; return; }
        int dev = 0, cus = 0;
        if (hipGetDevice(&dev) != hipSuccess || hipDeviceGetAttribute(&cus, hipDeviceAttributeMultiprocessorCount, dev) != hipSuccess) { grid = -1; return; }
        if (hipFuncSetAttribute((const void*)fwd_kernel, hipFuncAttributeMaxDynamicSharedMemorySize, LDS_BYTES) != hipSuccess) { fprintf(stderr, "kernel_launch: hipFuncSetAttribute failed\n"); grid = -1; return; }
        int occ = 0;
        if (hipOccupancyMaxActiveBlocksPerMultiprocessor(&occ, (const void*)fwd_kernel, NTHREADS, LDS_BYTES) != hipSuccess || occ < 1) { fprintf(stderr, "kernel_launch: occupancy query failed or zero\n"); grid = -1; return; }
        (void)hipGetLastError();
        grid = cus;
        if (grid != 256) { fprintf(stderr, "kernel_launch: %d CUs; this kernel is built for exactly 256 (one workgroup per CU); nothing launched\n", grid); grid = -1; return; }
    }
    if (grid < 0) return;
    if (hipMemsetAsync((char*)d_ws + WS_CTL, 0, CTL_ZERO_BYTES, stream) != hipSuccess) return;
    Args a{};
    for (int i = 0; i < 20; ++i) a.in[i] = (const float*)d_in[i];
    a.out = (float*)d_out; a.ws = (unsigned char*)d_ws;
    hipLaunchKernelGGL(fwd_kernel, dim3(grid), dim3(NTHREADS), LDS_BYTES, stream, a);
}
```
